# Optimizing an MI355X kernel written in HIP

```python
import math
import jax, jax.numpy as jnp
from jax import lax
import numpy as np

D_MODEL = 1024
BATCH = 1
SEQ = 16384
DEPTH = 2

HEAD_DIM = 64
A_HEADS = 4
A_KEY_DIM = 64
A_VAL_DIM = 64
A_CHUNK = 16
B_CHANNELS = 256
B_KERNEL = 31
C_HEADS = 4
C_PATTERNS = ((128, 1), (512, 4), (2048, 16))
C_BLOCK = 64
D_HEADS = 4
D_KV_HEADS = 2
D_HALF_WINDOW = 128
ROPE_THETA = 500000.0
ROPE_DIM = HEAD_DIM // 4
FFN_DIM = 2816
N_EXPERTS = 8
TOP_K = 2
EXPERT_DIM = 3584
MOE_BLOCK = 128
A_WIDTH = A_HEADS * A_VAL_DIM
B_WIDTH = B_CHANNELS
C_WIDTH = C_HEADS * HEAD_DIM
D_WIDTH = D_HEADS * HEAD_DIM
MIX_WIDTH = A_WIDTH + B_WIDTH + C_WIDTH + D_WIDTH
IN_SIZES = (A_HEADS * A_KEY_DIM, A_HEADS * A_KEY_DIM, A_HEADS * A_KEY_DIM, A_WIDTH, A_WIDTH,
            B_CHANNELS, B_CHANNELS,
            C_WIDTH, C_WIDTH, C_WIDTH,
            D_WIDTH, D_KV_HEADS * HEAD_DIM, D_KV_HEADS * HEAD_DIM)
IN_WIDTH = sum(IN_SIZES)
DEEPNORM_ALPHA = (2 * DEPTH) ** 0.25
DEEPNORM_BETA = (8 * DEPTH) ** -0.25
LN_EPS = 1e-5
RMS_EPS = 1e-6
NEG_INF = -1e30

kernel_name = "hybrid_parallel_groups_deepnorm_encoder"


def layer_norm(x, w, b):
    xf = x.astype(jnp.float32)
    mu = jnp.mean(xf, -1, keepdims=True)
    var = jnp.mean(jnp.square(xf - mu), -1, keepdims=True)
    return ((xf - mu) * lax.rsqrt(var + LN_EPS) * w.astype(jnp.float32) + b.astype(jnp.float32)).astype(x.dtype)


def rms_norm(x, w):
    xf = x.astype(jnp.float32)
    return xf * lax.rsqrt(jnp.mean(xf * xf, -1, keepdims=True) + RMS_EPS) * w.astype(jnp.float32)


def split_heads(t, n_heads):
    b, s, w = t.shape
    return t.reshape(b, s, n_heads, w // n_heads).transpose(0, 2, 1, 3)


def merge_heads(t):
    b, h, s, d = t.shape
    return t.transpose(0, 2, 1, 3).reshape(b, s, h * d)


def partial_rotary(x, positions):
    half = ROPE_DIM // 2
    inv_freq = ROPE_THETA ** (-jnp.arange(half, dtype=jnp.float32) * (2.0 / ROPE_DIM))
    ang = positions.astype(jnp.float32)[:, None, :, None] * inv_freq
    cos, sin = jnp.cos(ang), jnp.sin(ang)
    xr = x[..., :ROPE_DIM].astype(jnp.float32)
    x1, x2 = xr[..., :half], xr[..., half:]
    rot = jnp.concatenate([x1 * cos - x2 * sin, x2 * cos + x1 * sin], -1).astype(x.dtype)
    return jnp.concatenate([rot, x[..., ROPE_DIM:]], -1)


def banded_attention(q, k, v, half_window, block):
    n, g, length, hd = q.shape
    nb = -(-length // block)
    lp = nb * block
    pad = lp - length
    qb = jnp.pad(q, ((0, 0), (0, 0), (0, pad), (0, 0))).reshape(n, g, nb, block, hd)
    kp = jnp.pad(k, ((0, 0), (block, pad + block), (0, 0)))
    vp = jnp.pad(v, ((0, 0), (block, pad + block), (0, 0)))

    def windows(t):
        return jnp.concatenate([t[:, j * block: j * block + lp].reshape(n, nb, block, hd) for j in range(3)], axis=2)

    kw, vw = windows(kp), windows(vp)
    s = jnp.einsum('ngiqd,nikd->ngiqk', qb, kw, preferred_element_type=jnp.float32) * (hd ** -0.5)
    qpos = jnp.arange(lp).reshape(nb, block)
    kpos = (jnp.arange(nb)[:, None] - 1) * block + jnp.arange(3 * block)[None, :]
    rel = kpos[:, None, :] - qpos[:, :, None]
    mask = (jnp.abs(rel) <= half_window) & (kpos[:, None, :] >= 0) & (kpos[:, None, :] < length)
    s = jnp.where(mask, s, NEG_INF)
    m = jnp.max(s, -1)
    p = jnp.exp(s - m[..., None])
    l = jnp.sum(p, -1)
    o = jnp.einsum('ngiqk,nikd->ngiqd', p, vw.astype(jnp.float32))
    return (o.reshape(n, g, lp, hd)[:, :, :length],
            m.reshape(n, g, lp)[:, :, :length],
            l.reshape(n, g, lp)[:, :, :length])


def hgrn2_direction(q, k, v, logf):
    b_, h_, s_, dk = q.shape
    dv = v.shape[-1]
    n = s_ // A_CHUNK
    q, k, v, logf = [t.reshape(b_, h_, n, A_CHUNK, t.shape[-1]) for t in (q, k, v, logf)]
    cum = jnp.cumsum(logf, axis=3)
    lower = jnp.tril(jnp.ones((A_CHUNK, A_CHUNK), bool))
    diff = cum[:, :, :, :, None, :] - cum[:, :, :, None, :, :]
    decay = jnp.where(lower[:, :, None], jnp.exp(jnp.minimum(diff, 0.0)), 0.0)
    scores = jnp.einsum('bhntk,bhnsk,bhntsk->bhnts', q, k, decay)
    o_intra = jnp.einsum('bhnts,bhnsv->bhntv', scores, v)
    last = cum[:, :, :, -1:, :]
    chunk_kv = jnp.einsum('bhnsk,bhnsv->bhnkv', k * jnp.exp(last - cum), v)
    chunk_decay = jnp.exp(last[:, :, :, 0, :])

    def step(state, inp):
        dec, kv = inp
        return dec[..., None] * state + kv, state

    _, states = lax.scan(step, jnp.zeros((b_, h_, dk, dv), jnp.float32),
                         (jnp.moveaxis(chunk_decay, 2, 0), jnp.moveaxis(chunk_kv, 2, 0)))
    o_inter = jnp.einsum('bhntk,nbhkv->bhntv', q * jnp.exp(cum), states)
    return (o_intra + o_inter).reshape(b_, h_, s_, dv)


def hgrn2_mixer(q_raw, ffwd_raw, fbwd_raw, i_raw, g_raw, lb, norm_w):
    f32 = jnp.float32
    q = jax.nn.silu(split_heads(q_raw, A_HEADS).astype(f32))
    v = split_heads(i_raw, A_HEADS).astype(f32)
    lb = lb.astype(f32).reshape(A_HEADS, 1, A_KEY_DIM)

    def gates(z_raw):
        z = split_heads(z_raw, A_HEADS).astype(f32)
        logf = jnp.logaddexp(jnp.log(lb), jnp.log1p(-lb) + jax.nn.log_sigmoid(z))
        return logf, (1.0 - lb) * jax.nn.sigmoid(-z)

    logf_f, k_f = gates(ffwd_raw)
    logf_b, k_b = gates(fbwd_raw)
    flip = lambda t: jnp.flip(t, axis=2)
    o = hgrn2_direction(q, k_f, v, logf_f) + flip(hgrn2_direction(flip(q), flip(k_b), flip(v), flip(logf_b)))
    o = rms_norm(o, norm_w) * jax.nn.silu(split_heads(g_raw, A_HEADS).astype(f32))
    return merge_heads(o)


def conv_module(val, gate, conv_w, conv_b, norm_w, norm_b):
    u = val * jax.nn.sigmoid(gate)
    pad = B_KERNEL // 2
    y = lax.conv_general_dilated(u, conv_w[:, None, :].astype(u.dtype), window_strides=(1,),
                                 padding=((pad, pad),), dimension_numbers=('NWC', 'WIO', 'NWC'),
                                 feature_group_count=B_CHANNELS) + conv_b
    return jax.nn.silu(layer_norm(y, norm_w, norm_b))


def stride_split(t, dil):
    b, h, s, d = t.shape
    return t.reshape(b, h, s // dil, dil, d).transpose(0, 1, 3, 2, 4).reshape(b * h * dil, s // dil, d)


def stride_merge(t, b, h, dil):
    rest = t.shape[2:]
    t = t.reshape((b, h, dil) + t.shape[1:])
    t = jnp.swapaxes(t, 2, 3)
    return t.reshape((b, h, t.shape[2] * dil) + rest)


def dilated_attention(q, k, v):
    b, h, s, hd = q.shape
    nums, maxes, dens = [], [], []
    for window, dil in C_PATTERNS:
        o, m, l = banded_attention(stride_split(q, dil)[:, None], stride_split(k, dil), stride_split(v, dil),
                                   window // (2 * dil), C_BLOCK)
        nums.append(stride_merge(o[:, 0], b, h, dil))
        maxes.append(stride_merge(m[:, 0], b, h, dil))
        dens.append(stride_merge(l[:, 0], b, h, dil))
    m_all = jnp.stack(maxes)
    w = jnp.exp(m_all - jnp.max(m_all, 0))
    den = jnp.sum(w * jnp.stack(dens), 0)
    num = jnp.sum(w[..., None] * jnp.stack(nums), 0)
    return num / den[..., None]


def window_gqa_with_sink(q, k, v, sink):
    b, hq, s, hd = q.shape
    hkv = k.shape[1]
    g = hq // hkv
    o, m, l = banded_attention(q.reshape(b * hkv, g, s, hd), k.reshape(b * hkv, s, hd),
                               v.reshape(b * hkv, s, hd), D_HALF_WINDOW, D_HALF_WINDOW)
    o = o.reshape(b, hq, s, hd)
    m = m.reshape(b, hq, s)
    l = l.reshape(b, hq, s)
    sk = sink.astype(jnp.float32)[None, :, None]
    m_tot = jnp.maximum(m, sk)
    w = jnp.exp(m - m_tot)
    den = l * w + jnp.exp(sk - m_tot)
    return o * (w / den)[..., None]


def hybrid_mixer(h, positions, w_in, w_out, lb, a_norm_w, conv_w, conv_b, cn_w, cn_b, sink):
    proj = h @ w_in
    cuts = np.cumsum(IN_SIZES)[:-1].tolist()
    aq, aff, afb, ai, ag, bv, bg, cq, ck, cv, dq, dk, dv = jnp.split(proj, cuts, axis=-1)
    ya = hgrn2_mixer(aq, aff, afb, ai, ag, lb, a_norm_w)
    yb = conv_module(bv, bg, conv_w, conv_b, cn_w, cn_b)
    yc = merge_heads(dilated_attention(partial_rotary(split_heads(cq, C_HEADS), positions),
                                       partial_rotary(split_heads(ck, C_HEADS), positions),
                                       split_heads(cv, C_HEADS)))
    yd = merge_heads(window_gqa_with_sink(partial_rotary(split_heads(dq, D_HEADS), positions),
                                          partial_rotary(split_heads(dk, D_KV_HEADS), positions),
                                          split_heads(dv, D_KV_HEADS), sink))
    y = jnp.concatenate([ya.astype(h.dtype), yb.astype(h.dtype), yc.astype(h.dtype), yd.astype(h.dtype)], -1)
    return y @ w_out


def swiglu(h, w_up, w_down):
    gate, up = jnp.split(h @ w_up, 2, axis=-1)
    return (jax.nn.silu(gate) * up) @ w_down


def moe_swiglu(h, w_router, w_up, w_down):
    b, s, d = h.shape
    t = b * s
    hf = h.reshape(t, d)
    logits = jnp.einsum('td,de->te', hf, w_router, preferred_element_type=jnp.float32)
    top_logit, top_e = lax.top_k(logits, TOP_K)
    top_gate = jax.nn.softmax(top_logit, axis=-1)
    flat_e = top_e.reshape(-1).astype(jnp.int32)
    flat_tok = jnp.repeat(jnp.arange(t, dtype=jnp.int32), TOP_K)
    flat_gate = top_gate.reshape(-1)
    n_assign = t * TOP_K
    n_blocks = -(-n_assign // MOE_BLOCK) + N_EXPERTS
    counts = jnp.zeros((N_EXPERTS,), jnp.int32).at[flat_e].add(1)
    padded = (counts + MOE_BLOCK - 1) // MOE_BLOCK * MOE_BLOCK
    padded_end = jnp.cumsum(padded)
    padded_start = padded_end - padded
    start = jnp.cumsum(counts) - counts
    order = jnp.argsort(flat_e)
    sorted_e = flat_e[order]
    slot = padded_start[sorted_e] + jnp.arange(n_assign, dtype=jnp.int32) - start[sorted_e]
    slot_tok = jnp.full((n_blocks * MOE_BLOCK,), t, jnp.int32).at[slot].set(flat_tok[order])
    slot_gate = jnp.zeros((n_blocks * MOE_BLOCK,), jnp.float32).at[slot].set(flat_gate[order])
    block_e = jnp.minimum(jnp.searchsorted(padded_end, jnp.arange(n_blocks, dtype=jnp.int32) * MOE_BLOCK,
                                           side='right'), N_EXPERTS - 1)
    h_pad = jnp.concatenate([hf, jnp.zeros((1, d), hf.dtype)], 0)

    def expert_block(args):
        tok, e = args
        gate, up = jnp.split(h_pad[tok] @ w_up[e], 2, axis=-1)
        return (jax.nn.silu(gate) * up) @ w_down[e]

    y = lax.map(expert_block, (slot_tok.reshape(n_blocks, MOE_BLOCK), block_e))
    out = jnp.zeros((t + 1, d), jnp.float32).at[slot_tok].add(
        slot_gate[:, None] * y.reshape(-1, d).astype(jnp.float32))
    return out[:t].reshape(b, s, d).astype(h.dtype)


def setup_inputs(seed: int = 0) -> dict:
    key = jax.random.key(seed)
    ks = jax.random.split(key, 24)
    nrm = lambda k, shape, scale: jax.random.normal(k, shape, jnp.float32) * scale
    n_dense = (DEPTH + 1) // 2
    n_moe = DEPTH // 2
    return {
        "x": nrm(ks[0], (BATCH, SEQ, D_MODEL), 1.0),
        "c": nrm(ks[1], (BATCH, D_MODEL), 1.0),
        "positions": jnp.broadcast_to(jnp.arange(SEQ, dtype=jnp.int32), (BATCH, SEQ)),
        "w_ada": nrm(ks[2], (DEPTH, D_MODEL, 6 * D_MODEL), 0.1 * D_MODEL ** -0.5),
        "b_ada": nrm(ks[3], (DEPTH, 6 * D_MODEL), 0.01),
        "w_in": nrm(ks[4], (DEPTH, D_MODEL, IN_WIDTH), D_MODEL ** -0.5),
        "w_out": nrm(ks[5], (DEPTH, MIX_WIDTH, D_MODEL), DEEPNORM_BETA * MIX_WIDTH ** -0.5),
        "a_lower_bound": nrm(ks[6], (DEPTH, A_HEADS * A_KEY_DIM), 0.5),
        "a_norm_w": 1.0 + nrm(ks[7], (DEPTH, A_VAL_DIM), 0.02),
        "b_conv_w": nrm(ks[8], (DEPTH, B_KERNEL, B_CHANNELS), B_KERNEL ** -0.5),
        "b_conv_b": nrm(ks[9], (DEPTH, B_CHANNELS), 0.02),
        "b_norm_w": 1.0 + nrm(ks[10], (DEPTH, B_CHANNELS), 0.02),
        "b_norm_b": nrm(ks[11], (DEPTH, B_CHANNELS), 0.02),
        "d_sink": nrm(ks[12], (DEPTH, D_HEADS), 1.0),
        "ln_w": 1.0 + nrm(ks[13], (DEPTH, 2, D_MODEL), 0.02),
        "ln_b": nrm(ks[14], (DEPTH, 2, D_MODEL), 0.02),
        "ffn_w_up": nrm(ks[15], (n_dense, D_MODEL, 2 * FFN_DIM), D_MODEL ** -0.5),
        "ffn_w_down": nrm(ks[16], (n_dense, FFN_DIM, D_MODEL), DEEPNORM_BETA * FFN_DIM ** -0.5),
        "moe_router": nrm(ks[17], (n_moe, D_MODEL, N_EXPERTS), D_MODEL ** -0.5),
        "moe_w_up": nrm(ks[18], (n_moe, N_EXPERTS, D_MODEL, 2 * EXPERT_DIM), D_MODEL ** -0.5),
        "moe_w_down": nrm(ks[19], (n_moe, N_EXPERTS, EXPERT_DIM, D_MODEL), DEEPNORM_BETA * EXPERT_DIM ** -0.5),
    }


def reference(x, c, positions, w_ada, b_ada, w_in, w_out, a_lower_bound, a_norm_w, b_conv_w, b_conv_b,
              b_norm_w, b_norm_b, d_sink, ln_w, ln_b, ffn_w_up, ffn_w_down, moe_router, moe_w_up, moe_w_down):
    mod = jnp.einsum('bd,lde->lbe', jax.nn.silu(c), w_ada) + b_ada[:, None, :]
    lb_cum = jnp.cumsum(jax.nn.softmax(a_lower_bound.astype(jnp.float32), axis=0), axis=0)
    lb_all = lb_cum - lb_cum[0]
    for layer in range(DEPTH):
        shift1, scale1, gate1, shift2, scale2, gate2 = jnp.split(mod[layer][:, None, :], 6, axis=-1)
        h = x * (1.0 + scale1) + shift1
        y = hybrid_mixer(h, positions, w_in[layer], w_out[layer], lb_all[layer], a_norm_w[layer],
                         b_conv_w[layer], b_conv_b[layer], b_norm_w[layer], b_norm_b[layer], d_sink[layer])
        x = layer_norm(DEEPNORM_ALPHA * x + (1.0 + gate1) * y, ln_w[layer, 0], ln_b[layer, 0])
        h = x * (1.0 + scale2) + shift2
        if layer % 2 == 0:
            f = swiglu(h, ffn_w_up[layer // 2], ffn_w_down[layer // 2])
        else:
            f = moe_swiglu(h, moe_router[layer // 2], moe_w_up[layer // 2], moe_w_down[layer // 2])
        x = layer_norm(DEEPNORM_ALPHA * x + (1.0 + gate2) * f, ln_w[layer, 1], ln_b[layer, 1])
    return x
```

```cpp
#include <hip/hip_runtime.h>
#include <hip/hip_cooperative_groups.h>
#include <cstdio>
#include <cstdint>
namespace cg = cooperative_groups;

#ifndef MK_ONE_LAUNCH
#define MK_ONE_LAUNCH 0
#endif

#define LAS __attribute__((address_space(3)))
typedef _Float16 h16;
typedef h16 h16x8 __attribute__((ext_vector_type(8)));
typedef h16 h16x4 __attribute__((ext_vector_type(4)));
typedef h16 h16x2 __attribute__((ext_vector_type(2)));
typedef float f32x4 __attribute__((ext_vector_type(4)));
typedef float f32x2 __attribute__((ext_vector_type(2)));
typedef unsigned u32x4 __attribute__((ext_vector_type(4)));
typedef unsigned u32x2 __attribute__((ext_vector_type(2)));

constexpr int M = 16384, D = 1024, INW = 3072, FFN = 2816, NE = 8, EDIM = 3584;
constexpr int MOE_ROWS = 2 * M + NE * 256;
constexpr float ALPHA = 1.41421356237309515f;
constexpr float LN_EPS = 1e-5f, RMS_EPS = 1e-6f;
constexpr int NTHREADS = 512, NWAVES = 8;
constexpr int LDS_BYTES = 139264;

constexpr int PA_Q = 0, PA_FF = 256, PA_FB = 512, PA_I = 768, PA_G = 1024, PB_V = 1280, PB_G = 1536;
constexpr int PC_Q = 1792, PC_K = 2048, PC_V = 2304, PD_Q = 2560, PD_K = 2816, PD_V = 2944;

constexpr size_t MiB = 1u << 20;
constexpr size_t OFF_CTL = 0, CTL_BYTES = 1 * MiB;
constexpr size_t OFF_TAB = 1 * MiB;
constexpr size_t OFF_TOK = 2 * MiB;
constexpr size_t OFF_WT_IN = 4 * MiB;
constexpr size_t OFF_WT_OUT = 16 * MiB;
constexpr size_t OFF_WT_UP = 20 * MiB;
constexpr size_t OFF_WT_DOWN = 31 * MiB;
constexpr size_t OFF_WT_MUP = 37 * MiB;
constexpr size_t OFF_WT_MDOWN = 149 * MiB;
constexpr size_t OFF_X = 205 * MiB;
constexpr size_t OFF_H = 269 * MiB;
constexpr size_t OFF_Y = 301 * MiB;
constexpr size_t OFF_Z = 333 * MiB;
constexpr size_t OFF_PROJ = 397 * MiB;
constexpr size_t OFF_BIG = 533 * MiB;
constexpr size_t OFF_END = 775 * MiB;
constexpr int CW_MOD = 1024;
constexpr int CW_CNT = 64;
constexpr int CW_CUR = 128;

struct Params {
    const float* x; const float* c; const int* pos; const float* w_ada; const float* b_ada; const float* w_in; const float* w_out;
    const float* alb; const float* anw; const float* cw; const float* cb; const float* cnw; const float* cnb; const float* sink;
    const float* lnw; const float* lnb; const float* fup; const float* fdown; const float* rout; const float* mup; const float* mdown;
    float* out; unsigned char* ws; int lo, hi;
};

__device__ __forceinline__ unsigned pk2(float lo, float hi) { h16x2 v; v.x = (h16)lo; v.y = (h16)hi; return __builtin_bit_cast(unsigned, v); }
__device__ __forceinline__ float sigmoidf_(float v) { return 1.0f / (1.0f + __expf(-v)); }
__device__ __forceinline__ float siluf_(float v) { return v / (1.0f + __expf(-v)); }
__device__ __forceinline__ float wave_sum(float v) {
#pragma unroll
    for (int o = 1; o < 64; o <<= 1) v += __shfl_xor(v, o);
    return v;
}
#define LDS_WAIT() asm volatile("s_waitcnt lgkmcnt(0)" ::: "memory")

namespace g8 {
constexpr int BM = 256, BK = 64, HALF = 128, HTB = HALF * BK * 2, STAGE_BYTES = 8 * HTB, NXCD = 8, WGM = 8;
__device__ __forceinline__ int lds_byte(int r, int c) { const int st = (r >> 4) * 2 + (c >> 5), rr = r & 15, cc = c & 31, ob = rr * 64 + cc * 2; return st * 1024 + (ob ^ (((ob >> 9) & 1) << 5)); }
__device__ __forceinline__ void stage_rc(int b, int& R, int& C) { const int st = b / 1024, sb = b % 1024, swz = sb ^ (((sb >> 9) & 1) << 5); R = (st >> 1) * 16 + swz / 64; C = (st & 1) * 32 + (swz % 64) / 2; }
__device__ __forceinline__ int perm32(int rho) { const int n = rho >> 4, i = rho & 15; return 8 * (i >> 2) + 4 * n + (i & 3); }

struct Unit { const char* A; const char* B; int pm, pn; };

__device__ __forceinline__ void tile_of(int L, int nM, int nN, int& pm, int& pn) {
    const int nwg = nM * nN; int wgid = L;
    { const int q = nwg / NXCD, r = nwg % NXCD, xcd = wgid % NXCD, off = wgid / NXCD; wgid = (xcd < r ? xcd * (q + 1) : r * (q + 1) + (xcd - r) * q) + off; }
    const int nig = WGM * nN, gid = wgid / nig, fm = gid * WGM, gsz = (nM - fm) < WGM ? (nM - fm) : WGM;
    pm = fm + ((wgid % nig) % gsz); pn = (wgid % nig) / gsz;
}
struct DenseOrder {
    const char* A; const char* B; int K, nM, nN, G, c;
    __device__ void init(const void* A_, const void* B_, int Mr, int N, int K_, int G_, int c_) { A = (const char*)A_; B = (const char*)B_; K = K_; nM = Mr / BM; nN = N / BM; G = G_; c = c_; }
    __device__ __forceinline__ bool next(int i, Unit& u) const {
        const long L = (long)i * G + c; if (L >= (long)nM * nN) return false;
        tile_of((int)L, nM, nN, u.pm, u.pn);
        u.A = A + (size_t)u.pm * BM * K * 2; u.B = B + (size_t)u.pn * BM * K * 2; return true;
    }
};
struct MoeOrder {
    const char* A; const char* B; size_t bstride; int K, nM, nN, G, c; int t1, t2, t3, t4, t5, t6, t7;
    __device__ void init(const void* A_, const void* B_, size_t bstride_, int N, int K_, int G_, int c_, const unsigned* cnt) {
        A = (const char*)A_; B = (const char*)B_; bstride = bstride_; K = K_; nN = N / BM; G = G_; c = c_;
        int t = 0;
#define RT_(e) ((int)((__builtin_amdgcn_readfirstlane((int)cnt[e]) + 255) >> 8))
        t += RT_(0); t1 = t; t += RT_(1); t2 = t; t += RT_(2); t3 = t; t += RT_(3); t4 = t; t += RT_(4); t5 = t; t += RT_(5); t6 = t; t += RT_(6); t7 = t; t += RT_(7); nM = t;
#undef RT_
    }
    __device__ __forceinline__ bool next(int i, Unit& u) const {
        const long L = (long)i * G + c; if (L >= (long)nM * nN) return false;
        tile_of((int)L, nM, nN, u.pm, u.pn);
        const int e = (u.pm >= t1) + (u.pm >= t2) + (u.pm >= t3) + (u.pm >= t4) + (u.pm >= t5) + (u.pm >= t6) + (u.pm >= t7);
        u.A = A + (size_t)u.pm * BM * K * 2; u.B = B + (size_t)e * bstride + (size_t)u.pn * BM * K * 2; return true;
    }
};

struct EpiF16 {
    static constexpr bool PERM = true;
    h16* O; int ldc;
    __device__ __forceinline__ void operator()(const f32x4 (&acc)[2][2][4][2], const Unit& u, int wr, int wc, int fr, int fq) const {
        const int row0 = u.pm * BM + wr * 64 + fr, col0 = u.pn * BM + wc * 32 + 8 * fq;
#pragma unroll
        for (int ai = 0; ai < 2; ++ai)
#pragma unroll
            for (int m = 0; m < 4; ++m) { h16* rowp = O + (size_t)(row0 + ai * HALF + m * 16) * ldc + col0;
#pragma unroll
                for (int bj = 0; bj < 2; ++bj) { const f32x4 v0 = acc[ai][bj][m][0], v1 = acc[ai][bj][m][1];
                    u32x4 w; w.x = pk2(v0[0], v0[1]); w.y = pk2(v0[2], v0[3]); w.z = pk2(v1[0], v1[1]); w.w = pk2(v1[2], v1[3]);
                    *(u32x4*)(rowp + bj * HALF) = w; } }
    }
};
struct EpiSwiGLU {
    static constexpr bool PERM = true;
    h16* O; int ldh;
    __device__ __forceinline__ void operator()(const f32x4 (&acc)[2][2][4][2], const Unit& u, int wr, int wc, int fr, int fq) const {
        const int row0 = u.pm * BM + wr * 64 + fr, col0 = u.pn * (BM / 2) + wc * 16 + 4 * fq;
#pragma unroll
        for (int ai = 0; ai < 2; ++ai)
#pragma unroll
            for (int m = 0; m < 4; ++m) { h16* rowp = O + (size_t)(row0 + ai * HALF + m * 16) * ldh + col0;
#pragma unroll
                for (int bj = 0; bj < 2; ++bj) { const f32x4 g = acc[ai][bj][m][0], up = acc[ai][bj][m][1];
                    u32x2 w; w.x = pk2(siluf_(g[0]) * up[0], siluf_(g[1]) * up[1]); w.y = pk2(siluf_(g[2]) * up[2], siluf_(g[3]) * up[3]);
                    *(u32x2*)(rowp + bj * (HALF / 2)) = w; } }
    }
};
struct EpiF32 {
    static constexpr bool PERM = false;
    float* C; int ldc;
    __device__ __forceinline__ void operator()(const f32x4 (&acc)[2][2][4][2], const Unit& u, int wr, int wc, int fr, int fq) const {
        const int row0 = u.pm * BM + wr * 64 + fr, col0 = u.pn * BM + wc * 32 + 4 * fq;
#pragma unroll
        for (int ai = 0; ai < 2; ++ai)
#pragma unroll
            for (int m = 0; m < 4; ++m) { float* rowp = C + (size_t)(row0 + ai * HALF + m * 16) * ldc + col0;
#pragma unroll
                for (int bj = 0; bj < 2; ++bj)
#pragma unroll
                    for (int n = 0; n < 2; ++n) *(f32x4*)(rowp + bj * HALF + n * 16) = acc[ai][bj][m][n]; }
    }
};

template <class Epi, class Sched>
__device__ __forceinline__ void gemm_phase(LAS unsigned char* lds, const int tid, const int K, const Sched& S, const Epi& E) {
    const int wid = __builtin_amdgcn_readfirstlane(tid >> 6), lane = tid & 63, wr = wid >> 2, wc = wid & 3, fr = lane & 15, fq = lane >> 4;
    const int nt = K / BK;
    unsigned voffA[2], voffB[2];
#pragma unroll
    for (int i = 0; i < 2; ++i) { int R, C; stage_rc(tid * 16 + i * 8192, R, C); const int Rb = Epi::PERM ? ((R & ~31) + perm32(R & 31)) : R;
        voffA[i] = (unsigned)(R * K + C) * 2u; voffB[i] = (unsigned)(Rb * K + C) * 2u; }
    const size_t kstep = (size_t)(BK * 2);
    const size_t hstep = (size_t)HALF * K * 2;
    const unsigned ldsw = (unsigned)wid * 1024u;
    const int aoff = lds_byte(wr * 64 + fr, fq * 8), boff = lds_byte(wc * 32 + fr, fq * 8);
#define G8_SA(b, h) (((b) * 2 + (h)) * HTB)
#define G8_SB(b, h) ((4 + (b) * 2 + (h)) * HTB)
#define G8_STAGE(bufoff, gbase, voff) do { _Pragma("unroll") for (int _i = 0; _i < 2; ++_i) \
        __builtin_amdgcn_global_load_lds((const unsigned*)((const char*)(gbase) + (voff)[_i]), (LAS unsigned*)(lds + (bufoff) + ldsw + _i * 8192), 16, 0, 0); } while (0)
#define G8_LDA(dst, b, h) do { _Pragma("unroll") for (int m = 0; m < 4; ++m) _Pragma("unroll") for (int k = 0; k < 2; ++k) dst[m][k] = *(const LAS h16x8*)(lds + G8_SA(b, h) + aoff + m * 2048 + k * 1024); } while (0)
#define G8_LDB(dst, b, h) do { _Pragma("unroll") for (int n = 0; n < 2; ++n) _Pragma("unroll") for (int k = 0; k < 2; ++k) dst[n][k] = *(const LAS h16x8*)(lds + G8_SB(b, h) + boff + n * 2048 + k * 1024); } while (0)
#define G8_MMA(ai, bj, At, Bt) do { __builtin_amdgcn_s_setprio(1); _Pragma("unroll") for (int m = 0; m < 4; ++m) _Pragma("unroll") for (int n = 0; n < 2; ++n) _Pragma("unroll") for (int k = 0; k < 2; ++k) \
        acc[ai][bj][m][n] = __builtin_amdgcn_mfma_f32_16x16x32_f16(Bt[n][k], At[m][k], acc[ai][bj][m][n], 0, 0, 0); __builtin_amdgcn_s_setprio(0); } while (0)
#define G8_WAIT_V(n) asm volatile("s_waitcnt vmcnt(" #n ")" ::: "memory")
#define G8_WAIT_L(n) asm volatile("s_waitcnt lgkmcnt(" #n ")" ::: "memory")
#define G8_BAR __builtin_amdgcn_s_barrier()
#define G8_SCHED __builtin_amdgcn_sched_barrier(0)
    Unit cur, nxt; int ui = 0;
    if (!S.next(0, cur)) return;
    f32x4 acc[2][2][4][2];
#pragma unroll
    for (int a = 0; a < 2; ++a)
#pragma unroll
        for (int b = 0; b < 2; ++b)
#pragma unroll
            for (int m = 0; m < 4; ++m)
#pragma unroll
                for (int n = 0; n < 2; ++n) acc[a][b][m][n] = (f32x4){0.f, 0.f, 0.f, 0.f};
    h16x8 At[4][2], B0[2][2], B1[2][2];
    const char* cA = cur.A; const char* cB = cur.B;
    G8_STAGE(G8_SB(0, 0), cB, voffB); G8_STAGE(G8_SB(0, 1), cB + hstep, voffB); G8_STAGE(G8_SA(0, 0), cA, voffA); G8_STAGE(G8_SA(0, 1), cA + hstep, voffA);
    if (wr == 1) G8_BAR;
    G8_WAIT_V(2); G8_BAR;
    G8_STAGE(G8_SB(1, 0), cB + kstep, voffB); G8_STAGE(G8_SA(1, 0), cA + kstep, voffA); G8_STAGE(G8_SB(1, 1), cB + hstep + kstep, voffB);
    G8_WAIT_V(6); G8_BAR;
    for (;;) {
        const bool has_next = S.next(ui + 1, nxt);
        const char* nA = has_next ? nxt.A : cA; const char* nB = has_next ? nxt.B : cB;
        for (int t = 0; t < nt; t += 2) {
            const bool last = (t == nt - 2);
            const char* a1 = cA + (size_t)(t + 1) * kstep;
            const char* a2 = last ? nA : cA + (size_t)(t + 2) * kstep; const char* b2 = last ? nB : cB + (size_t)(t + 2) * kstep;
            const char* a3 = a2 + kstep; const char* b3 = b2 + kstep;
            G8_LDB(B0, 0, 0); G8_LDB(B1, 0, 1); G8_SCHED; G8_LDA(At, 0, 0); G8_STAGE(G8_SA(1, 1), a1 + hstep, voffA);
            G8_WAIT_V(8); G8_WAIT_L(0); G8_BAR; G8_MMA(0, 0, At, B0); G8_MMA(0, 1, At, B1); G8_BAR; G8_SCHED;
            G8_LDA(At, 0, 1); G8_STAGE(G8_SB(0, 0), b2, voffB); G8_STAGE(G8_SB(0, 1), b2 + hstep, voffB); G8_STAGE(G8_SA(0, 0), a2, voffA);
            G8_WAIT_V(8); G8_WAIT_L(0); G8_BAR; G8_MMA(1, 0, At, B0); G8_MMA(1, 1, At, B1); G8_BAR; G8_SCHED;
            G8_LDB(B0, 1, 0); G8_LDB(B1, 1, 1); G8_SCHED; G8_LDA(At, 1, 0); G8_STAGE(G8_SA(0, 1), a2 + hstep, voffA);
            G8_WAIT_V(8); G8_WAIT_L(0); G8_BAR; G8_MMA(0, 0, At, B0); G8_MMA(0, 1, At, B1); G8_BAR; G8_SCHED;
            G8_LDA(At, 1, 1); G8_STAGE(G8_SB(1, 0), b3, voffB); G8_STAGE(G8_SB(1, 1), b3 + hstep, voffB); G8_STAGE(G8_SA(1, 0), a3, voffA);
            G8_WAIT_V(8); G8_WAIT_L(0); G8_BAR; G8_MMA(1, 0, At, B0); G8_MMA(1, 1, At, B1); G8_BAR; G8_SCHED;
        }
        if (wr == 0) G8_BAR;
        E(acc, cur, wr, wc, fr, fq);
        if (!has_next) break;
#pragma unroll
        for (int a = 0; a < 2; ++a)
#pragma unroll
            for (int b = 0; b < 2; ++b)
#pragma unroll
                for (int m = 0; m < 4; ++m)
#pragma unroll
                    for (int n = 0; n < 2; ++n) acc[a][b][m][n] = (f32x4){0.f, 0.f, 0.f, 0.f};
        cur = nxt; cA = nA; cB = nB; ++ui;
        if (wr == 1) G8_BAR;
    }
    G8_WAIT_V(0);
    G8_BAR;
#undef G8_SA
#undef G8_SB
#undef G8_STAGE
#undef G8_LDA
#undef G8_LDB
#undef G8_MMA
#undef G8_WAIT_V
#undef G8_WAIT_L
#undef G8_BAR
#undef G8_SCHED
}
}

struct Frame {
    unsigned char* lds; int tid, lane, wave, G, bid;
    const Params* pp;
    unsigned char* ws;
};
#define WSP(T, off) ((T*)(F.ws + (off)))

struct MapId { __device__ __forceinline__ int operator()(int n) const { return n; } };
struct MapGU { int half; __device__ __forceinline__ int operator()(int n) const { const int up = n >= half, j = up ? n - half : n; return 8 * (j >> 2) + 4 * up + (j & 3); } };

template <class RowMap>
__device__ __forceinline__ void xpose_tile(const float* __restrict__ W, int N, h16* __restrict__ WT, int K, int k0, int n0, float* scr, int lane, RowMap rm) {
    f32x4 v[16];
    const int r4 = lane >> 4, c4 = (lane & 15) * 4;
#pragma unroll
    for (int i = 0; i < 16; ++i) v[i] = *(const f32x4*)(W + (size_t)(k0 + i * 4 + r4) * N + n0 + c4);
#pragma unroll
    for (int i = 0; i < 16; ++i) { float* s = scr + (i * 4 + r4) * 65 + c4; s[0] = v[i].x; s[1] = v[i].y; s[2] = v[i].z; s[3] = v[i].w; }
    LDS_WAIT();
    const int c = lane & 7;
#pragma unroll
    for (int j = 0; j < 8; ++j) { const int n = (lane >> 3) + 8 * j; const float* s = scr + (8 * c) * 65 + n;
        u32x4 o; o.x = pk2(s[0], s[65]); o.y = pk2(s[130], s[195]); o.z = pk2(s[260], s[325]); o.w = pk2(s[390], s[455]);
        *(u32x4*)(WT + (size_t)rm(n0 + n) * K + k0 + 8 * c) = o; }
    LDS_WAIT();
}
template <class RowMap>
__device__ __forceinline__ void xpose_matrix(Frame& F, const float* W, int K, int N, h16* WT, RowMap rm, int& tbase) {
    const int gw = F.bid * NWAVES + F.wave, NGW = F.G * NWAVES;
    const int nkt = K / 64, nnt = N / 64, ntile = nkt * nnt;
    float* scr = (float*)(F.lds) + F.wave * (64 * 65);
    int first = gw - (tbase % NGW); if (first < 0) first += NGW;
    for (int t = first; t < ntile; t += NGW) { const int kt = t / nnt, ntt = t % nnt; xpose_tile(W, N, WT, K, kt * 64, ntt * 64, scr, F.lane, rm); }
    tbase += ntile;
}
__device__ __forceinline__ void step_pre(Frame& F) {
    const Params& p = *F.pp;
    float* modacc = (float*)(F.ws + OFF_CTL) + CW_MOD;
    for (int it = F.bid; it < 256; it += F.G) {
        const int l = it >> 7, dc = it & 127;
        float sc[8];
#pragma unroll
        for (int i = 0; i < 8; ++i) sc[i] = siluf_(p.c[dc * 8 + i]);
#pragma unroll
        for (int j = 0; j < 3; ++j) { const int col4 = F.tid + 512 * j; f32x4 a = {0.f, 0.f, 0.f, 0.f};
#pragma unroll
            for (int i = 0; i < 8; ++i) { const f32x4 w = *(const f32x4*)(p.w_ada + ((size_t)(l * 1024 + dc * 8 + i)) * 6144 + col4 * 4); a += w * sc[i]; }
            if (dc == 0) a += *(const f32x4*)(p.b_ada + l * 6144 + col4 * 4);
            float* dst = modacc + l * 6144 + col4 * 4;
            atomicAdd(dst + 0, a.x); atomicAdd(dst + 1, a.y); atomicAdd(dst + 2, a.z); atomicAdd(dst + 3, a.w); }
    }
    { f32x2* tab = WSP(f32x2, OFF_TAB);
      for (int idx = F.bid * NTHREADS + F.tid; idx < M * 8; idx += F.G * NTHREADS) { const int t = idx >> 3, i = idx & 7;
          const float fhi = i == 0 ? 1.0f : i == 1 ? 0.1939227432012558f : i == 2 ? 0.03760603070259094f : i == 3 ? 0.007292664609849453f : i == 4 ? 0.0014142135623842478f : i == 5 ? 0.00027424818836152554f : i == 6 ? 5.3182957344688475e-05f : 1.0313385246263351e-05f;
          const float flo = i == 0 ? 0.0f : i == 1 ? 1.5474299619455678e-09f : i == 2 ? 2.2827298384875405e-10f : i == 3 ? 1.2736765808707418e-10f : i == 4 ? -1.115275406748939e-14f : i == 5 ? -1.2685318073746288e-11f : i == 6 ? 1.624761414818765e-12f : 1.309491116886427e-13f;
          const float ps = (float)p.pos[t];
          const float ph = ps * fhi, pe = fmaf(ps, fhi, -ph) + ps * flo;
          const float kk = rintf(ph * 0.15915494309189535f);
          float r = fmaf(-kk, 6.2831854820251465f, ph); r = fmaf(-kk, -1.7484555314695172e-07f, r); r += pe;
          float sn, cs; sincosf(r, &sn, &cs); tab[idx] = (f32x2){(float)cs, (float)sn}; } }
    int tb = 0;
    for (int l = 0; l < 2; ++l) xpose_matrix(F, p.w_in + (size_t)l * D * INW, D, INW, WSP(h16, OFF_WT_IN) + (size_t)l * INW * D, MapId{}, tb);
    for (int l = 0; l < 2; ++l) xpose_matrix(F, p.w_out + (size_t)l * D * D, D, D, WSP(h16, OFF_WT_OUT) + (size_t)l * D * D, MapId{}, tb);
    xpose_matrix(F, p.fup, D, 2 * FFN, WSP(h16, OFF_WT_UP), MapGU{FFN}, tb);
    xpose_matrix(F, p.fdown, FFN, D, WSP(h16, OFF_WT_DOWN), MapId{}, tb);
    for (int e = 0; e < NE; ++e) xpose_matrix(F, p.mup + (size_t)e * D * 2 * EDIM, D, 2 * EDIM, WSP(h16, OFF_WT_MUP) + (size_t)e * 2 * EDIM * D, MapGU{EDIM}, tb);
    for (int e = 0; e < NE; ++e) xpose_matrix(F, p.mdown + (size_t)e * EDIM * D, EDIM, D, WSP(h16, OFF_WT_MDOWN) + (size_t)e * D * EDIM, MapId{}, tb);
}

__device__ __forceinline__ void step_h0(Frame& F) {
    const float* mod = (const float*)(F.ws + OFF_CTL) + CW_MOD;
    h16* H = WSP(h16, OFF_H);
    for (size_t i = (size_t)F.bid * NTHREADS + F.tid; i < (size_t)M * D / 8; i += (size_t)F.G * NTHREADS) {
        const int col = (int)(i & 127) * 8;
        const f32x4 a = *(const f32x4*)(F.pp->x + i * 8), b = *(const f32x4*)(F.pp->x + i * 8 + 4);
        const f32x4 sh0 = *(const f32x4*)(mod + col), sh1 = *(const f32x4*)(mod + col + 4), sc0 = *(const f32x4*)(mod + 1024 + col), sc1 = *(const f32x4*)(mod + 1024 + col + 4);
        const f32x4 r0 = a * (sc0 + 1.0f) + sh0, r1 = b * (sc1 + 1.0f) + sh1;
        u32x4 w; w.x = pk2(r0[0], r0[1]); w.y = pk2(r0[2], r0[3]); w.z = pk2(r1[0], r1[1]); w.w = pk2(r1[2], r1[3]);
        *(u32x4*)(H + i * 8) = w;
    }
}

constexpr size_t SCR_QS = OFF_BIG, SCR_FF = OFF_BIG + 16 * MiB, SCR_KF = OFF_BIG + 32 * MiB, SCR_FB = OFF_BIG + 48 * MiB, SCR_KB = OFF_BIG + 64 * MiB, SCR_OA = OFF_BIG + 80 * MiB;
__device__ __forceinline__ void step_rot(Frame& F, int layer) {
    h16* P = WSP(h16, OFF_PROJ); const f32x2* tab = WSP(f32x2, OFF_TAB);
    for (int idx = F.bid * NTHREADS + F.tid; idx < M * 14; idx += F.G * NTHREADS) {
        const int t = idx / 14, hh = idx % 14;
        const int cb = hh < 4 ? PC_Q + hh * 64 : hh < 8 ? PC_K + (hh - 4) * 64 : hh < 12 ? PD_Q + (hh - 8) * 64 : PD_K + (hh - 12) * 64;
        h16* ptr = P + (size_t)t * INW + cb;
        const h16x8 x1 = *(const h16x8*)ptr, x2 = *(const h16x8*)(ptr + 8);
        h16x8 o1, o2;
#pragma unroll
        for (int i = 0; i < 8; ++i) { const f32x2 cs = tab[t * 8 + i]; const float a = (float)x1[i], b = (float)x2[i]; o1[i] = (h16)(a * cs.x - b * cs.y); o2[i] = (h16)(b * cs.x + a * cs.y); }
        *(h16x8*)ptr = o1; *(h16x8*)(ptr + 8) = o2;
    }
    float* QS = WSP(float, SCR_QS); float* FF = WSP(float, SCR_FF); float* KF = WSP(float, SCR_KF); float* FB = WSP(float, SCR_FB); float* KB = WSP(float, SCR_KB);
    for (int idx = F.bid * NTHREADS + F.tid; idx < M * 256; idx += F.G * NTHREADS) {
        const int t = idx >> 8, c = idx & 255;
        const h16* row = P + (size_t)t * INW;
        const float lb = layer == 0 ? 0.f : sigmoidf_(F.pp->alb[256 + c] - F.pp->alb[c]);
        const float q = (float)row[PA_Q + c], zf = (float)row[PA_FF + c], zb = (float)row[PA_FB + c];
        QS[idx] = siluf_(q);
        FF[idx] = lb + (1.f - lb) * sigmoidf_(zf); KF[idx] = (1.f - lb) * sigmoidf_(-zf);
        FB[idx] = lb + (1.f - lb) * sigmoidf_(zb); KB[idx] = (1.f - lb) * sigmoidf_(-zb);
    }
}

__device__ __forceinline__ void hgrn_seq_item(Frame& F, int item) {
    const int vs = item & 7, dir = (item >> 3) & 1, h = item >> 4;
    const int v = vs * 8 + F.wave, k = F.lane;
    const float* QS = WSP(float, SCR_QS) + h * 64 + k; const float* FG = WSP(float, dir ? SCR_FB : SCR_FF) + h * 64 + k; const float* KG = WSP(float, dir ? SCR_KB : SCR_KF) + h * 64 + k;
    const h16* VV = WSP(h16, OFF_PROJ) + PA_I + h * 64 + v;
    float* OA = WSP(float, SCR_OA) + (size_t)dir * M * 256 + h * 64 + v;
    float S = 0.f;
    constexpr int U = 8;
    for (int s0 = 0; s0 < M; s0 += U) {
        float f[U], kk[U], qs[U], vv[U];
#pragma unroll
        for (int u = 0; u < U; ++u) { const int t = dir ? (M - 1 - (s0 + u)) : (s0 + u); f[u] = FG[(size_t)t * 256]; kk[u] = KG[(size_t)t * 256]; qs[u] = QS[(size_t)t * 256]; vv[u] = (float)VV[(size_t)t * INW]; }
#pragma unroll
        for (int u = 0; u < U; ++u) { const int t = dir ? (M - 1 - (s0 + u)) : (s0 + u); S = f[u] * S + kk[u] * vv[u]; const float o = wave_sum(qs[u] * S); if (F.lane == 0) OA[(size_t)t * 256] = o; }
    }
}
__device__ __forceinline__ void conv_item(Frame& F, int item, int layer) {
    const Params& p = *F.pp;
    float* U = (float*)F.lds;
    float* Yt = U + 62 * 256;
    const h16* P = WSP(h16, OFF_PROJ);
    const int t0 = item * 32;
    for (int i = F.tid; i < 62 * 256; i += NTHREADS) { const int r = i >> 8, c = i & 255, t = t0 - 15 + r; float u = 0.f;
        if (t >= 0 && t < M) { const h16* row = P + (size_t)t * INW; u = (float)row[PB_V + c] * sigmoidf_((float)row[PB_G + c]); }
        U[i] = u; }
    __syncthreads();
    { const int c = F.tid & 255, tg = F.tid >> 8;
      float w[31];
#pragma unroll
      for (int j = 0; j < 31; ++j) w[j] = p.cw[(size_t)layer * 31 * 256 + j * 256 + c];
      const float bias = p.cb[layer * 256 + c];
      for (int tt = tg * 16; tt < tg * 16 + 16; ++tt) { float a = bias;
#pragma unroll
          for (int j = 0; j < 31; ++j) a += w[j] * U[(tt + j) * 256 + c];
          Yt[tt * 256 + c] = a; } }
    __syncthreads();
    { h16* Y = WSP(h16, OFF_Y);
      for (int r = F.wave * 4; r < F.wave * 4 + 4; ++r) {
          const f32x4 v = *(const f32x4*)(Yt + r * 256 + F.lane * 4);
          const float mean = wave_sum((v.x + v.y) + (v.z + v.w)) * (1.f / 256.f);
          const f32x4 d = v - mean;
          const float var = wave_sum((d.x * d.x + d.y * d.y) + (d.z * d.z + d.w * d.w)) * (1.f / 256.f);
          const float rstd = 1.0f / sqrtf(var + LN_EPS);
          const f32x4 nw = *(const f32x4*)(p.cnw + layer * 256 + F.lane * 4), nb = *(const f32x4*)(p.cnb + layer * 256 + F.lane * 4);
          const f32x4 o = d * rstd * nw + nb;
          u32x2 w2; w2.x = pk2(siluf_(o.x), siluf_(o.y)); w2.y = pk2(siluf_(o.z), siluf_(o.w));
          *(u32x2*)(Y + (size_t)(t0 + r) * D + 256 + F.lane * 4) = w2; } }
    __syncthreads();
}
#define ATT_KEY(sidx) do { const int s_ = (sidx); if (s_ >= 0 && s_ < M) { const h16* kr = Pk + (size_t)s_ * INW; const h16* vr = Pv + (size_t)s_ * INW; float sc = 0.f; \
    _Pragma("unroll") for (int c8 = 0; c8 < 8; ++c8) { const h16x8 kk = *(const h16x8*)(kr + 8 * c8); _Pragma("unroll") for (int e = 0; e < 4; ++e) sc = __builtin_amdgcn_fdot2((h16x2){qv[c8][2 * e], qv[c8][2 * e + 1]}, (h16x2){kk[2 * e], kk[2 * e + 1]}, sc, false); } \
    const float mn = fmaxf(m, sc), corr = __expf(m - mn), pw = __expf(sc - mn); l = l * corr + pw; m = mn; \
    _Pragma("unroll") for (int c8 = 0; c8 < 8; ++c8) { const h16x8 vv = *(const h16x8*)(vr + 8 * c8); _Pragma("unroll") for (int e = 0; e < 8; ++e) acc[8 * c8 + e] = acc[8 * c8 + e] * corr + pw * (float)vv[e]; } } } while (0)
__device__ __forceinline__ void attn_naive_item(Frame& F, int item, int layer, int which  ) {
    const int idx = item * NTHREADS + F.tid; const int h = idx >> 14, t = idx & (M - 1);
    const h16* P = WSP(h16, OFF_PROJ);
    const h16* Pq = P + (size_t)t * INW + (which ? PD_Q : PC_Q) + h * 64;
    const h16* Pk = P + (which ? PD_K + (h >> 1) * 64 : PC_K + h * 64);
    const h16* Pv = P + (which ? PD_V + (h >> 1) * 64 : PC_V + h * 64);
    h16x8 qv[8]; float acc[64]; float m = -1e30f, l = 0.f;
#pragma unroll
    for (int c8 = 0; c8 < 8; ++c8) { qv[c8] = *(const h16x8*)(Pq + 8 * c8) * (h16)0.125f;
#pragma unroll
        for (int e = 0; e < 8; ++e) acc[8 * c8 + e] = 0.f; }
    h16* Y = WSP(h16, OFF_Y) + (size_t)t * D + (which ? 768 : 512) + h * 64;
    float scale;
    if (which == 0) {
        for (int j = -64; j <= 64; ++j) ATT_KEY(t + j);
        for (int j = -64; j <= 64; ++j) ATT_KEY(t + 4 * j);
        for (int j = -64; j <= 64; ++j) ATT_KEY(t + 16 * j);
        scale = 1.0f / l;
    } else {
        for (int j = -128; j <= 128; ++j) ATT_KEY(t + j);
        const float sk = F.pp->sink[layer * 4 + h]; const float mt = fmaxf(m, sk), w = __expf(m - mt), den = l * w + __expf(sk - mt);
        scale = w / den;
    }
#pragma unroll
    for (int c8 = 0; c8 < 8; ++c8) { u32x4 w; w.x = pk2(acc[8 * c8] * scale, acc[8 * c8 + 1] * scale); w.y = pk2(acc[8 * c8 + 2] * scale, acc[8 * c8 + 3] * scale);
        w.z = pk2(acc[8 * c8 + 4] * scale, acc[8 * c8 + 5] * scale); w.w = pk2(acc[8 * c8 + 6] * scale, acc[8 * c8 + 7] * scale); *(u32x4*)(Y + 8 * c8) = w; }
}
__device__ __forceinline__ void step_mix(Frame& F, int layer) {
    constexpr int N_HG = 64, N_CONV = M / 32, N_AT = M * 4 / NTHREADS;
    int b = F.bid, G = F.G;
    if (G > 2 * N_HG) { if (b < N_HG) { hgrn_seq_item(F, b); return; } b -= N_HG; G -= N_HG; }
    else { for (int it = b; it < N_HG; it += G) hgrn_seq_item(F, it); }
    for (int it = b; it < N_CONV + 2 * N_AT; it += G) {
        if (it < N_CONV) conv_item(F, it, layer);
        else if (it < N_CONV + N_AT) attn_naive_item(F, it - N_CONV, layer, 0);
        else attn_naive_item(F, it - N_CONV - N_AT, layer, 1);
    }
}
__device__ __forceinline__ void step_afin(Frame& F, int layer) {
    const float* OA = WSP(float, SCR_OA); const h16* P = WSP(h16, OFF_PROJ); h16* Y = WSP(h16, OFF_Y);
    const int gw = F.bid * NWAVES + F.wave, NGW = F.G * NWAVES;
    const float nw = F.pp->anw[layer * 64 + F.lane];
    for (int it = gw; it < M * 4; it += NGW) { const int t = it >> 2, h = it & 3;
        const float o = OA[(size_t)t * 256 + h * 64 + F.lane] + OA[(size_t)M * 256 + (size_t)t * 256 + h * 64 + F.lane];
        const float ms = wave_sum(o * o) * (1.f / 64.f);
        const float g = (float)P[(size_t)t * INW + PA_G + h * 64 + F.lane];
        Y[(size_t)t * D + h * 64 + F.lane] = (h16)(o * (1.0f / sqrtf(ms + RMS_EPS)) * nw * siluf_(g)); }
}

struct LnArgs { const float* xin; const float* gate; const float* lw; const float* lb; const float* nscale; const float* nshift; float* xout; h16* hout; };
__device__ __forceinline__ void ln_core(const Frame& F, const LnArgs& a, int row, const f32x4 (&fv)[4], f32x4 (&hv)[4]) {
    f32x4 tv[4]; float s = 0.f;
#pragma unroll
    for (int j = 0; j < 4; ++j) { const int col = F.lane * 4 + 256 * j; const f32x4 xi = *(const f32x4*)(a.xin + (size_t)row * D + col), g = *(const f32x4*)(a.gate + col);
        tv[j] = xi * ALPHA + (g + 1.0f) * fv[j]; s += (tv[j].x + tv[j].y) + (tv[j].z + tv[j].w); }
    const float mean = wave_sum(s) * (1.f / D); float s2 = 0.f;
#pragma unroll
    for (int j = 0; j < 4; ++j) { tv[j] = tv[j] - mean; s2 += (tv[j].x * tv[j].x + tv[j].y * tv[j].y) + (tv[j].z * tv[j].z + tv[j].w * tv[j].w); }
    const float rstd = 1.0f / sqrtf(wave_sum(s2) * (1.f / D) + LN_EPS);
#pragma unroll
    for (int j = 0; j < 4; ++j) { const int col = F.lane * 4 + 256 * j; const f32x4 w = *(const f32x4*)(a.lw + col), b = *(const f32x4*)(a.lb + col);
        const f32x4 xo = tv[j] * rstd * w + b;
        *(f32x4*)(a.xout + (size_t)row * D + col) = xo;
        if (a.hout) { const f32x4 sc = *(const f32x4*)(a.nscale + col), sh = *(const f32x4*)(a.nshift + col); hv[j] = xo * (sc + 1.0f) + sh;
            u32x2 w2; w2.x = pk2(hv[j].x, hv[j].y); w2.y = pk2(hv[j].z, hv[j].w); *(u32x2*)(a.hout + (size_t)row * D + col) = w2; } }
}
__device__ __forceinline__ void step_ln_dense(Frame& F, const LnArgs& a, const float* Z, bool router) {
    const int gw = F.bid * NWAVES + F.wave, NGW = F.G * NWAVES;
    unsigned* cnt = (unsigned*)(F.ws + OFF_CTL) + CW_CNT; unsigned* tok = WSP(unsigned, OFF_TOK);
    for (int row = gw; row < M; row += NGW) {
        f32x4 fv[4], hv[4];
#pragma unroll
        for (int j = 0; j < 4; ++j) fv[j] = *(const f32x4*)(Z + (size_t)row * D + F.lane * 4 + 256 * j);
        ln_core(F, a, row, fv, hv);
        if (router) {
            float lg[8];
#pragma unroll
            for (int e = 0; e < 8; ++e) lg[e] = 0.f;
#pragma unroll
            for (int j = 0; j < 4; ++j)
#pragma unroll
                for (int i = 0; i < 4; ++i) { const int col = F.lane * 4 + 256 * j + i; const f32x4 w0 = *(const f32x4*)(F.pp->rout + (size_t)col * 8), w1 = *(const f32x4*)(F.pp->rout + (size_t)col * 8 + 4); const float hval = hv[j][i];
                    lg[0] += hval * w0.x; lg[1] += hval * w0.y; lg[2] += hval * w0.z; lg[3] += hval * w0.w; lg[4] += hval * w1.x; lg[5] += hval * w1.y; lg[6] += hval * w1.z; lg[7] += hval * w1.w; }
#pragma unroll
            for (int e = 0; e < 8; ++e) lg[e] = wave_sum(lg[e]);
            int e1 = 0; float l1 = lg[0];
#pragma unroll
            for (int e = 1; e < 8; ++e) if (lg[e] > l1) { l1 = lg[e]; e1 = e; }
            int e2 = -1; float l2 = -3.0e38f;
#pragma unroll
            for (int e = 0; e < 8; ++e) if (e != e1 && lg[e] > l2) { l2 = lg[e]; e2 = e; }
            const float g1 = 1.0f / (1.0f + __expf(l2 - l1)), g2 = 1.0f - g1;
            if (F.lane == 0) { tok[row * 8 + 0] = (unsigned)e1; tok[row * 8 + 1] = (unsigned)e2; tok[row * 8 + 2] = __float_as_uint(g1); tok[row * 8 + 3] = __float_as_uint(g2);
                atomicAdd(cnt + e1, 1u); atomicAdd(cnt + e2, 1u); }
        }
    }
}
__device__ __forceinline__ void step_slot(Frame& F) {
    const unsigned* cnt = (const unsigned*)(F.ws + OFF_CTL) + CW_CNT; unsigned* cur = (unsigned*)(F.ws + OFF_CTL) + CW_CUR; unsigned* tok = WSP(unsigned, OFF_TOK);
    const h16* H = WSP(h16, OFF_H); h16* HG = WSP(h16, OFF_PROJ);
    unsigned off[8]; { unsigned o = 0;
#pragma unroll
        for (int e = 0; e < 8; ++e) { off[e] = o; o += ((cnt[e] + 255u) >> 8) << 8; } }
    const int gw = F.bid * NWAVES + F.wave, NGW = F.G * NWAVES;
    for (int row = gw; row < M; row += NGW) {
        const unsigned e1 = tok[row * 8 + 0], e2 = tok[row * 8 + 1];
        unsigned s1 = 0, s2 = 0;
        if (F.lane == 0) {
            unsigned o1 = 0, o2 = 0;
#pragma unroll
            for (int e = 0; e < 8; ++e) { o1 = (e1 == (unsigned)e) ? off[e] : o1; o2 = (e2 == (unsigned)e) ? off[e] : o2; }
            s1 = o1 + atomicAdd(cur + e1, 1u); s2 = o2 + atomicAdd(cur + e2, 1u); tok[row * 8 + 4] = s1; tok[row * 8 + 5] = s2; }
        s1 = __shfl(s1, 0); s2 = __shfl(s2, 0);
        const u32x4 a = *(const u32x4*)(H + (size_t)row * D + F.lane * 8), b = *(const u32x4*)(H + (size_t)row * D + 512 + F.lane * 8);
        *(u32x4*)(HG + (size_t)s1 * D + F.lane * 8) = a; *(u32x4*)(HG + (size_t)s1 * D + 512 + F.lane * 8) = b;
        *(u32x4*)(HG + (size_t)s2 * D + F.lane * 8) = a; *(u32x4*)(HG + (size_t)s2 * D + 512 + F.lane * 8) = b;
    }
}
__device__ __forceinline__ void step_ln_moe(Frame& F, const LnArgs& a) {
    const int gw = F.bid * NWAVES + F.wave, NGW = F.G * NWAVES;
    const unsigned* tok = WSP(unsigned, OFF_TOK); const float* YS = WSP(float, OFF_PROJ);
    for (int row = gw; row < M; row += NGW) {
        const float g1 = __uint_as_float(tok[row * 8 + 2]), g2 = __uint_as_float(tok[row * 8 + 3]); const unsigned s1 = tok[row * 8 + 4], s2 = tok[row * 8 + 5];
        f32x4 fv[4], hv[4];
#pragma unroll
        for (int j = 0; j < 4; ++j) { const int col = F.lane * 4 + 256 * j; fv[j] = *(const f32x4*)(YS + (size_t)s1 * D + col) * g1 + *(const f32x4*)(YS + (size_t)s2 * D + col) * g2; }
        ln_core(F, a, row, fv, hv);
    }
}

constexpr int N_STEPS = 21;
#ifndef KMASK
#define KMASK 0xFFFF
#endif
#define KON(k) ((KMASK >> (k)) & 1)
__global__ void __launch_bounds__(NTHREADS, 2) fwd_kernel(Params kp) {
    extern __shared__ __attribute__((aligned(16))) unsigned char lds[];
    Frame F; F.lds = lds; F.tid = threadIdx.x; F.lane = F.tid & 63; F.wave = __builtin_amdgcn_readfirstlane(F.tid >> 6); F.G = gridDim.x; F.bid = blockIdx.x; F.ws = kp.ws;
    LAS unsigned char* ldsl = (LAS unsigned char*)lds;
    const int lo = kp.lo, hi = kp.hi;
    for (int s = lo; s < hi; ++s) {
        { const Params* pp_ = (const Params*)__builtin_amdgcn_kernarg_segment_ptr(); asm volatile("" : "+s"(pp_) :: "memory"); F.pp = pp_; unsigned char* ws_ = kp.ws; asm volatile("" : "+s"(ws_)); F.ws = ws_; }
        const Params& p = *F.pp;
        { int tid_ = threadIdx.x; asm volatile("" : "+v"(tid_)); F.tid = tid_; F.lane = tid_ & 63; F.wave = __builtin_amdgcn_readfirstlane(tid_ >> 6); }
        int layer = 0, kind = s;
        if (s >= 11) { layer = 1; kind = s - 9; }
        const float* mod = (const float*)(F.ws + OFF_CTL) + CW_MOD;
        const float* modl = mod + layer * 6144;
        if (KON(0) && s == 0) step_pre(F);
        else if (KON(1) && s == 1) step_h0(F);
        else if (KON(2) && kind == 2) { g8::DenseOrder S; S.init(WSP(h16, OFF_H), WSP(h16, OFF_WT_IN) + (size_t)layer * INW * D, M, INW, D, F.G, F.bid); g8::EpiF16 E{WSP(h16, OFF_PROJ), INW}; g8::gemm_phase(ldsl, F.tid, D, S, E); }
        else if (KON(3) && kind == 3) step_rot(F, layer);
        else if (KON(4) && kind == 4) step_mix(F, layer);
        else if (KON(5) && kind == 5) step_afin(F, layer);
        else if (KON(6) && kind == 6) { g8::DenseOrder S; S.init(WSP(h16, OFF_Y), WSP(h16, OFF_WT_OUT) + (size_t)layer * D * D, M, D, D, F.G, F.bid); g8::EpiF32 E{WSP(float, OFF_Z), D}; g8::gemm_phase(ldsl, F.tid, D, S, E); }
        else if (KON(7) && kind == 7) { LnArgs a{layer == 0 ? p.x : WSP(float, OFF_X), modl + 2048, p.lnw + (size_t)(layer * 2) * D, p.lnb + (size_t)(layer * 2) * D, modl + 4096, modl + 3072, WSP(float, OFF_X), WSP(h16, OFF_H)};
            step_ln_dense(F, a, WSP(float, OFF_Z), layer == 1); }
        else if (KON(8) && layer == 0 && kind == 8) { g8::DenseOrder S; S.init(WSP(h16, OFF_H), WSP(h16, OFF_WT_UP), M, 2 * FFN, D, F.G, F.bid); g8::EpiSwiGLU E{WSP(h16, OFF_PROJ), FFN}; g8::gemm_phase(ldsl, F.tid, D, S, E); }
        else if (KON(9) && layer == 0 && kind == 9) { g8::DenseOrder S; S.init(WSP(h16, OFF_PROJ), WSP(h16, OFF_WT_DOWN), M, D, FFN, F.G, F.bid); g8::EpiF32 E{WSP(float, OFF_Z), D}; g8::gemm_phase(ldsl, F.tid, FFN, S, E); }
        else if (KON(10) && layer == 0 && kind == 10) { LnArgs a{WSP(float, OFF_X), modl + 5120, p.lnw + (size_t)1 * D, p.lnb + (size_t)1 * D, mod + 6144 + 1024, mod + 6144 + 0, WSP(float, OFF_X), WSP(h16, OFF_H)};
            step_ln_dense(F, a, WSP(float, OFF_Z), false); }
        else if (KON(11) && layer == 1 && kind == 8) step_slot(F);
        else if (KON(12) && layer == 1 && kind == 9) { g8::MoeOrder S; S.init(WSP(h16, OFF_PROJ), WSP(h16, OFF_WT_MUP), (size_t)2 * EDIM * D * 2, 2 * EDIM, D, F.G, F.bid, (const unsigned*)(F.ws + OFF_CTL) + CW_CNT);
            g8::EpiSwiGLU E{WSP(h16, OFF_BIG), EDIM}; g8::gemm_phase(ldsl, F.tid, D, S, E); }
        else if (KON(13) && layer == 1 && kind == 10) { g8::MoeOrder S; S.init(WSP(h16, OFF_BIG), WSP(h16, OFF_WT_MDOWN), (size_t)D * EDIM * 2, D, EDIM, F.G, F.bid, (const unsigned*)(F.ws + OFF_CTL) + CW_CNT);
            g8::EpiF32 E{WSP(float, OFF_PROJ), D}; g8::gemm_phase(ldsl, F.tid, EDIM, S, E); }
        else if (KON(14) && layer == 1 && kind == 11) { LnArgs a{WSP(float, OFF_X), modl + 5120, p.lnw + (size_t)3 * D, p.lnb + (size_t)3 * D, nullptr, nullptr, p.out, nullptr}; step_ln_moe(F, a); }
        if (s + 1 < hi) { cg::this_grid().sync(); }
    }
}

extern "C" void kernel_launch(void* const* d_in, const int* in_sizes, int n_in, void* d_out, int out_size, void* d_ws, size_t ws_size, hipStream_t stream) {
    static int grid = 0;
    if (grid == 0) {
        if (n_in != 21 || in_sizes[0] != M * D || out_size != M * D || ws_size < OFF_END) { fprintf(stderr, "kernel_launch: unexpected shapes / workspace (%d inputs, ws %zu, need %zu)\n", n_in, ws_size, (size_t)OFF_END); grid = -1; return; }
        int dev = 0, cus = 0, per_cu = 0;
        hipGetDevice(&dev); hipDeviceGetAttribute(&cus, hipDeviceAttributeMultiprocessorCount, dev);
        hipFuncSetAttribute((const void*)fwd_kernel, hipFuncAttributeMaxDynamicSharedMemorySize, LDS_BYTES);
        hipOccupancyMaxActiveBlocksPerMultiprocessor(&per_cu, (const void*)fwd_kernel, NTHREADS, LDS_BYTES);
        if (per_cu < 1) { fprintf(stderr, "kernel_launch: occupancy query says %d blocks per CU\n", per_cu); per_cu = 1; }
        grid = cus * 1;
        fprintf(stderr, "kernel_launch: grid %d (cus %d, per_cu %d), ws %zu\n", grid, cus, per_cu, ws_size);
    }
    if (grid < 0) return;
    hipMemsetAsync((char*)d_ws + OFF_CTL, 0, CTL_BYTES, stream);
    Params p{};
    p.x = (const float*)d_in[0]; p.c = (const float*)d_in[1]; p.pos = (const int*)d_in[2]; p.w_ada = (const float*)d_in[3]; p.b_ada = (const float*)d_in[4];
    p.w_in = (const float*)d_in[5]; p.w_out = (const float*)d_in[6]; p.alb = (const float*)d_in[7]; p.anw = (const float*)d_in[8]; p.cw = (const float*)d_in[9];
    p.cb = (const float*)d_in[10]; p.cnw = (const float*)d_in[11]; p.cnb = (const float*)d_in[12]; p.sink = (const float*)d_in[13]; p.lnw = (const float*)d_in[14];
    p.lnb = (const float*)d_in[15]; p.fup = (const float*)d_in[16]; p.fdown = (const float*)d_in[17]; p.rout = (const float*)d_in[18]; p.mup = (const float*)d_in[19];
    p.mdown = (const float*)d_in[20]; p.out = (float*)d_out; p.ws = (unsigned char*)d_ws;
#if MK_ONE_LAUNCH
    p.lo = 0; p.hi = N_STEPS;
    { void* args[] = {&p}; hipError_t e = hipLaunchCooperativeKernel((const void*)fwd_kernel, dim3(grid), dim3(NTHREADS), args, LDS_BYTES, stream);
      if (e != hipSuccess) fprintf(stderr, "cooperative launch failed: %s\n", hipGetErrorString(e)); }
#else
    for (int s = 0; s < N_STEPS; ++s) { p.lo = s; p.hi = s + 1;
        void* args[] = {&p}; hipError_t e = hipLaunchCooperativeKernel((const void*)fwd_kernel, dim3(grid), dim3(NTHREADS), args, LDS_BYTES, stream);
        if (e != hipSuccess) { fprintf(stderr, "launch %d failed: %s\n", s, hipGetErrorString(e)); break; } }
#endif
}
```

```cpp
#include <hip/hip_runtime.h>
#include <hip/hip_cooperative_groups.h>
#include <cstdio>
#include <cstdint>
namespace cg = cooperative_groups;

#ifndef MK_ONE_LAUNCH
#define MK_ONE_LAUNCH 1
#endif

#define LAS __attribute__((address_space(3)))
typedef _Float16 h16;
typedef h16 h16x8 __attribute__((ext_vector_type(8)));
typedef h16 h16x4 __attribute__((ext_vector_type(4)));
typedef h16 h16x2 __attribute__((ext_vector_type(2)));
typedef float f32x4 __attribute__((ext_vector_type(4)));
typedef float f32x2 __attribute__((ext_vector_type(2)));
typedef unsigned u32x4 __attribute__((ext_vector_type(4)));
typedef unsigned u32x2 __attribute__((ext_vector_type(2)));

constexpr int M = 16384, D = 1024, INW = 3072, FFN = 2816, NE = 8, EDIM = 3584;
constexpr int MOE_ROWS = 2 * M + NE * 256;
constexpr float ALPHA = 1.41421356237309515f;
constexpr float LN_EPS = 1e-5f, RMS_EPS = 1e-6f;
constexpr int NTHREADS = 512, NWAVES = 8;
constexpr int LDS_BYTES = 139264;

constexpr int PA_Q = 0, PA_FF = 256, PA_FB = 512, PA_I = 768, PA_G = 1024, PB_V = 1280, PB_G = 1536;
constexpr int PC_Q = 1792, PC_K = 2048, PC_V = 2304, PD_Q = 2560, PD_K = 2816, PD_V = 2944;

constexpr size_t MiB = 1u << 20;
constexpr size_t OFF_CTL = 0, CTL_BYTES = 1 * MiB;
constexpr size_t OFF_TAB = 1 * MiB;
constexpr size_t OFF_TOK = 2 * MiB;
constexpr size_t OFF_WT_IN = 4 * MiB;
constexpr size_t OFF_WT_OUT = 16 * MiB;
constexpr size_t OFF_WT_UP = 20 * MiB;
constexpr size_t OFF_WT_DOWN = 31 * MiB;
constexpr size_t OFF_WT_MUP = 37 * MiB;
constexpr size_t OFF_WT_MDOWN = 149 * MiB;
constexpr size_t OFF_X = 205 * MiB;
constexpr size_t OFF_H = 269 * MiB;
constexpr size_t OFF_Y = 301 * MiB;
constexpr size_t OFF_Z = 333 * MiB;
constexpr size_t OFF_PROJ = 397 * MiB;
constexpr size_t OFF_BIG = 533 * MiB;
constexpr size_t OFF_END = 775 * MiB;
constexpr int CW_MOD = 1024;
constexpr int CW_CNT = 64;
constexpr int CW_CUR = 128;

struct Params {
    const float* x; const float* c; const int* pos; const float* w_ada; const float* b_ada; const float* w_in; const float* w_out;
    const float* alb; const float* anw; const float* cw; const float* cb; const float* cnw; const float* cnb; const float* sink;
    const float* lnw; const float* lnb; const float* fup; const float* fdown; const float* rout; const float* mup; const float* mdown;
    float* out; unsigned char* ws; int lo, hi;
};

__device__ __forceinline__ unsigned pk2(float lo, float hi) { h16x2 v; v.x = (h16)lo; v.y = (h16)hi; return __builtin_bit_cast(unsigned, v); }
__device__ __forceinline__ float sigmoidf_(float v) { return 1.0f / (1.0f + __expf(-v)); }
__device__ __forceinline__ float siluf_(float v) { return v / (1.0f + __expf(-v)); }
__device__ __forceinline__ float wave_sum(float v) {
#pragma unroll
    for (int o = 1; o < 64; o <<= 1) v += __shfl_xor(v, o);
    return v;
}
#define LDS_WAIT() asm volatile("s_waitcnt lgkmcnt(0)" ::: "memory")

namespace g8 {
constexpr int BM = 256, BK = 64, HALF = 128, HTB = HALF * BK * 2, STAGE_BYTES = 8 * HTB, NXCD = 8, WGM = 8;
__device__ __forceinline__ int lds_byte(int r, int c) { const int st = (r >> 4) * 2 + (c >> 5), rr = r & 15, cc = c & 31, ob = rr * 64 + cc * 2; return st * 1024 + (ob ^ (((ob >> 9) & 1) << 5)); }
__device__ __forceinline__ void stage_rc(int b, int& R, int& C) { const int st = b / 1024, sb = b % 1024, swz = sb ^ (((sb >> 9) & 1) << 5); R = (st >> 1) * 16 + swz / 64; C = (st & 1) * 32 + (swz % 64) / 2; }
__device__ __forceinline__ int perm32(int rho) { const int n = rho >> 4, i = rho & 15; return 8 * (i >> 2) + 4 * n + (i & 3); }

struct Unit { const char* A; const char* B; int pm, pn; };

__device__ __forceinline__ void tile_of(int L, int nM, int nN, int& pm, int& pn) {
    const int nwg = nM * nN; int wgid = L;
    { const int q = nwg / NXCD, r = nwg % NXCD, xcd = wgid % NXCD, off = wgid / NXCD; wgid = (xcd < r ? xcd * (q + 1) : r * (q + 1) + (xcd - r) * q) + off; }
    const int nig = WGM * nN, gid = wgid / nig, fm = gid * WGM, gsz = (nM - fm) < WGM ? (nM - fm) : WGM;
    pm = fm + ((wgid % nig) % gsz); pn = (wgid % nig) / gsz;
}
struct DenseOrder {
    const char* A; const char* B; int K, nM, nN, G, c;
    __device__ void init(const void* A_, const void* B_, int Mr, int N, int K_, int G_, int c_) { A = (const char*)A_; B = (const char*)B_; K = K_; nM = Mr / BM; nN = N / BM; G = G_; c = c_; }
    __device__ __forceinline__ bool next(int i, Unit& u) const {
        const long L = (long)i * G + c; if (L >= (long)nM * nN) return false;
        tile_of((int)L, nM, nN, u.pm, u.pn);
        u.A = A + (size_t)u.pm * BM * K * 2; u.B = B + (size_t)u.pn * BM * K * 2; return true;
    }
};
struct MoeOrder {
    const char* A; const char* B; size_t bstride; int K, nM, nN, G, c; int t1, t2, t3, t4, t5, t6, t7;
    __device__ void init(const void* A_, const void* B_, size_t bstride_, int N, int K_, int G_, int c_, const unsigned* cnt) {
        A = (const char*)A_; B = (const char*)B_; bstride = bstride_; K = K_; nN = N / BM; G = G_; c = c_;
        int t = 0;
#define RT_(e) ((int)((__builtin_amdgcn_readfirstlane((int)cnt[e]) + 255) >> 8))
        t += RT_(0); t1 = t; t += RT_(1); t2 = t; t += RT_(2); t3 = t; t += RT_(3); t4 = t; t += RT_(4); t5 = t; t += RT_(5); t6 = t; t += RT_(6); t7 = t; t += RT_(7); nM = t;
#undef RT_
    }
    __device__ __forceinline__ bool next(int i, Unit& u) const {
        const long L = (long)i * G + c; if (L >= (long)nM * nN) return false;
        tile_of((int)L, nM, nN, u.pm, u.pn);
        const int e = (u.pm >= t1) + (u.pm >= t2) + (u.pm >= t3) + (u.pm >= t4) + (u.pm >= t5) + (u.pm >= t6) + (u.pm >= t7);
        u.A = A + (size_t)u.pm * BM * K * 2; u.B = B + (size_t)e * bstride + (size_t)u.pn * BM * K * 2; return true;
    }
};

struct EpiF16 {
    static constexpr bool PERM = true;
    h16* O; int ldc;
    __device__ __forceinline__ void operator()(const f32x4 (&acc)[2][2][4][2], const Unit& u, int wr, int wc, int fr, int fq) const {
        const int row0 = u.pm * BM + wr * 64 + fr, col0 = u.pn * BM + wc * 32 + 8 * fq;
#pragma unroll
        for (int ai = 0; ai < 2; ++ai)
#pragma unroll
            for (int m = 0; m < 4; ++m) { h16* rowp = O + (size_t)(row0 + ai * HALF + m * 16) * ldc + col0;
#pragma unroll
                for (int bj = 0; bj < 2; ++bj) { const f32x4 v0 = acc[ai][bj][m][0], v1 = acc[ai][bj][m][1];
                    u32x4 w; w.x = pk2(v0[0], v0[1]); w.y = pk2(v0[2], v0[3]); w.z = pk2(v1[0], v1[1]); w.w = pk2(v1[2], v1[3]);
                    *(u32x4*)(rowp + bj * HALF) = w; } }
    }
};
struct EpiSwiGLU {
    static constexpr bool PERM = true;
    h16* O; int ldh;
    __device__ __forceinline__ void operator()(const f32x4 (&acc)[2][2][4][2], const Unit& u, int wr, int wc, int fr, int fq) const {
        const int row0 = u.pm * BM + wr * 64 + fr, col0 = u.pn * (BM / 2) + wc * 16 + 4 * fq;
#pragma unroll
        for (int ai = 0; ai < 2; ++ai)
#pragma unroll
            for (int m = 0; m < 4; ++m) { h16* rowp = O + (size_t)(row0 + ai * HALF + m * 16) * ldh + col0;
#pragma unroll
                for (int bj = 0; bj < 2; ++bj) { const f32x4 g = acc[ai][bj][m][0], up = acc[ai][bj][m][1];
                    u32x2 w; w.x = pk2(siluf_(g[0]) * up[0], siluf_(g[1]) * up[1]); w.y = pk2(siluf_(g[2]) * up[2], siluf_(g[3]) * up[3]);
                    *(u32x2*)(rowp + bj * (HALF / 2)) = w; } }
    }
};
struct EpiF32 {
    static constexpr bool PERM = false;
    float* C; int ldc;
    __device__ __forceinline__ void operator()(const f32x4 (&acc)[2][2][4][2], const Unit& u, int wr, int wc, int fr, int fq) const {
        const int row0 = u.pm * BM + wr * 64 + fr, col0 = u.pn * BM + wc * 32 + 4 * fq;
#pragma unroll
        for (int ai = 0; ai < 2; ++ai)
#pragma unroll
            for (int m = 0; m < 4; ++m) { float* rowp = C + (size_t)(row0 + ai * HALF + m * 16) * ldc + col0;
#pragma unroll
                for (int bj = 0; bj < 2; ++bj)
#pragma unroll
                    for (int n = 0; n < 2; ++n) *(f32x4*)(rowp + bj * HALF + n * 16) = acc[ai][bj][m][n]; }
    }
};

template <class Epi, class Sched>
__device__ __forceinline__ void gemm_phase(LAS unsigned char* lds, const int tid, const int K, const Sched& S, const Epi& E) {
    const int wid = __builtin_amdgcn_readfirstlane(tid >> 6), lane = tid & 63, wr = wid >> 2, wc = wid & 3, fr = lane & 15, fq = lane >> 4;
    const int nt = K / BK;
    unsigned voffA[2], voffB[2];
#pragma unroll
    for (int i = 0; i < 2; ++i) { int R, C; stage_rc(tid * 16 + i * 8192, R, C); const int Rb = Epi::PERM ? ((R & ~31) + perm32(R & 31)) : R;
        voffA[i] = (unsigned)(R * K + C) * 2u; voffB[i] = (unsigned)(Rb * K + C) * 2u; }
    const size_t kstep = (size_t)(BK * 2);
    const size_t hstep = (size_t)HALF * K * 2;
    const unsigned ldsw = (unsigned)wid * 1024u;
    const int aoff = lds_byte(wr * 64 + fr, fq * 8), boff = lds_byte(wc * 32 + fr, fq * 8);
#define G8_SA(b, h) (((b) * 2 + (h)) * HTB)
#define G8_SB(b, h) ((4 + (b) * 2 + (h)) * HTB)
#define G8_STAGE(bufoff, gbase, voff) do { _Pragma("unroll") for (int _i = 0; _i < 2; ++_i) \
        __builtin_amdgcn_global_load_lds((const unsigned*)((const char*)(gbase) + (voff)[_i]), (LAS unsigned*)(lds + (bufoff) + ldsw + _i * 8192), 16, 0, 0); } while (0)
#define G8_LDA(dst, b, h) do { _Pragma("unroll") for (int m = 0; m < 4; ++m) _Pragma("unroll") for (int k = 0; k < 2; ++k) dst[m][k] = *(const LAS h16x8*)(lds + G8_SA(b, h) + aoff + m * 2048 + k * 1024); } while (0)
#define G8_LDB(dst, b, h) do { _Pragma("unroll") for (int n = 0; n < 2; ++n) _Pragma("unroll") for (int k = 0; k < 2; ++k) dst[n][k] = *(const LAS h16x8*)(lds + G8_SB(b, h) + boff + n * 2048 + k * 1024); } while (0)
#define G8_MMA(ai, bj, At, Bt) do { __builtin_amdgcn_s_setprio(1); _Pragma("unroll") for (int m = 0; m < 4; ++m) _Pragma("unroll") for (int n = 0; n < 2; ++n) _Pragma("unroll") for (int k = 0; k < 2; ++k) \
        acc[ai][bj][m][n] = __builtin_amdgcn_mfma_f32_16x16x32_f16(Bt[n][k], At[m][k], acc[ai][bj][m][n], 0, 0, 0); __builtin_amdgcn_s_setprio(0); } while (0)
#define G8_WAIT_V(n) asm volatile("s_waitcnt vmcnt(" #n ")" ::: "memory")
#define G8_WAIT_L(n) asm volatile("s_waitcnt lgkmcnt(" #n ")" ::: "memory")
#define G8_BAR __builtin_amdgcn_s_barrier()
#define G8_SCHED __builtin_amdgcn_sched_barrier(0)
    Unit cur, nxt; int ui = 0;
    if (!S.next(0, cur)) return;
    f32x4 acc[2][2][4][2];
#pragma unroll
    for (int a = 0; a < 2; ++a)
#pragma unroll
        for (int b = 0; b < 2; ++b)
#pragma unroll
            for (int m = 0; m < 4; ++m)
#pragma unroll
                for (int n = 0; n < 2; ++n) acc[a][b][m][n] = (f32x4){0.f, 0.f, 0.f, 0.f};
    h16x8 At[4][2], B0[2][2], B1[2][2];
    const char* cA = cur.A; const char* cB = cur.B;
    G8_STAGE(G8_SB(0, 0), cB, voffB); G8_STAGE(G8_SB(0, 1), cB + hstep, voffB); G8_STAGE(G8_SA(0, 0), cA, voffA); G8_STAGE(G8_SA(0, 1), cA + hstep, voffA);
    if (wr == 1) G8_BAR;
    G8_WAIT_V(2); G8_BAR;
    G8_STAGE(G8_SB(1, 0), cB + kstep, voffB); G8_STAGE(G8_SA(1, 0), cA + kstep, voffA); G8_STAGE(G8_SB(1, 1), cB + hstep + kstep, voffB);
    G8_WAIT_V(6); G8_BAR;
    for (;;) {
        const bool has_next = S.next(ui + 1, nxt);
        const char* nA = has_next ? nxt.A : cA; const char* nB = has_next ? nxt.B : cB;
        for (int t = 0; t < nt; t += 2) {
            const bool last = (t == nt - 2);
            const char* a1 = cA + (size_t)(t + 1) * kstep;
            const char* a2 = last ? nA : cA + (size_t)(t + 2) * kstep; const char* b2 = last ? nB : cB + (size_t)(t + 2) * kstep;
            const char* a3 = a2 + kstep; const char* b3 = b2 + kstep;
            G8_LDB(B0, 0, 0); G8_LDB(B1, 0, 1); G8_SCHED; G8_LDA(At, 0, 0); G8_STAGE(G8_SA(1, 1), a1 + hstep, voffA);
            G8_WAIT_V(8); G8_WAIT_L(0); G8_BAR; G8_MMA(0, 0, At, B0); G8_MMA(0, 1, At, B1); G8_BAR; G8_SCHED;
            G8_LDA(At, 0, 1); G8_STAGE(G8_SB(0, 0), b2, voffB); G8_STAGE(G8_SB(0, 1), b2 + hstep, voffB); G8_STAGE(G8_SA(0, 0), a2, voffA);
            G8_WAIT_V(8); G8_WAIT_L(0); G8_BAR; G8_MMA(1, 0, At, B0); G8_MMA(1, 1, At, B1); G8_BAR; G8_SCHED;
            G8_LDB(B0, 1, 0); G8_LDB(B1, 1, 1); G8_SCHED; G8_LDA(At, 1, 0); G8_STAGE(G8_SA(0, 1), a2 + hstep, voffA);
            G8_WAIT_V(8); G8_WAIT_L(0); G8_BAR; G8_MMA(0, 0, At, B0); G8_MMA(0, 1, At, B1); G8_BAR; G8_SCHED;
            G8_LDA(At, 1, 1); G8_STAGE(G8_SB(1, 0), b3, voffB); G8_STAGE(G8_SB(1, 1), b3 + hstep, voffB); G8_STAGE(G8_SA(1, 0), a3, voffA);
            G8_WAIT_V(8); G8_WAIT_L(0); G8_BAR; G8_MMA(1, 0, At, B0); G8_MMA(1, 1, At, B1); G8_BAR; G8_SCHED;
        }
        if (wr == 0) G8_BAR;
        E(acc, cur, wr, wc, fr, fq);
        if (!has_next) break;
#pragma unroll
        for (int a = 0; a < 2; ++a)
#pragma unroll
            for (int b = 0; b < 2; ++b)
#pragma unroll
                for (int m = 0; m < 4; ++m)
#pragma unroll
                    for (int n = 0; n < 2; ++n) acc[a][b][m][n] = (f32x4){0.f, 0.f, 0.f, 0.f};
        cur = nxt; cA = nA; cB = nB; ++ui;
        if (wr == 1) G8_BAR;
    }
    G8_WAIT_V(0);
    G8_BAR;
#undef G8_SA
#undef G8_SB
#undef G8_STAGE
#undef G8_LDA
#undef G8_LDB
#undef G8_MMA
#undef G8_WAIT_V
#undef G8_WAIT_L
#undef G8_BAR
#undef G8_SCHED
}
}

struct Frame {
    unsigned char* lds; int tid, lane, wave, G, bid;
    const Params* pp;
    unsigned char* ws;
};
#define WSP(T, off) ((T*)(F.ws + (off)))

struct MapId { __device__ __forceinline__ int operator()(int n) const { return n; } };
struct MapGU { int half; __device__ __forceinline__ int operator()(int n) const { const int up = n >= half, j = up ? n - half : n; return 8 * (j >> 2) + 4 * up + (j & 3); } };

template <class RowMap>
__device__ __forceinline__ void xpose_tile(const float* __restrict__ W, int N, h16* __restrict__ WT, int K, int k0, int n0, float* scr, int lane, RowMap rm) {
    f32x4 v[16];
    const int r4 = lane >> 4, c4 = (lane & 15) * 4;
#pragma unroll
    for (int i = 0; i < 16; ++i) v[i] = *(const f32x4*)(W + (size_t)(k0 + i * 4 + r4) * N + n0 + c4);
#pragma unroll
    for (int i = 0; i < 16; ++i) { float* s = scr + (i * 4 + r4) * 65 + c4; s[0] = v[i].x; s[1] = v[i].y; s[2] = v[i].z; s[3] = v[i].w; }
    LDS_WAIT();
    const int c = lane & 7;
#pragma unroll
    for (int j = 0; j < 8; ++j) { const int n = (lane >> 3) + 8 * j; const float* s = scr + (8 * c) * 65 + n;
        u32x4 o; o.x = pk2(s[0], s[65]); o.y = pk2(s[130], s[195]); o.z = pk2(s[260], s[325]); o.w = pk2(s[390], s[455]);
        *(u32x4*)(WT + (size_t)rm(n0 + n) * K + k0 + 8 * c) = o; }
    LDS_WAIT();
}
template <class RowMap>
__device__ __forceinline__ void xpose_matrix(Frame& F, const float* W, int K, int N, h16* WT, RowMap rm, int& tbase) {
    const int gw = F.bid * NWAVES + F.wave, NGW = F.G * NWAVES;
    const int nkt = K / 64, nnt = N / 64, ntile = nkt * nnt;
    float* scr = (float*)(F.lds) + F.wave * (64 * 65);
    int first = gw - (tbase % NGW); if (first < 0) first += NGW;
    for (int t = first; t < ntile; t += NGW) { const int kt = t / nnt, ntt = t % nnt; xpose_tile(W, N, WT, K, kt * 64, ntt * 64, scr, F.lane, rm); }
    tbase += ntile;
}
__device__ __forceinline__ void step_pre(Frame& F) {
    const Params& p = *F.pp;
    float* modacc = (float*)(F.ws + OFF_CTL) + CW_MOD;
    for (int it = F.bid; it < 256; it += F.G) {
        const int l = it >> 7, dc = it & 127;
        float sc[8];
#pragma unroll
        for (int i = 0; i < 8; ++i) sc[i] = siluf_(p.c[dc * 8 + i]);
#pragma unroll
        for (int j = 0; j < 3; ++j) { const int col4 = F.tid + 512 * j; f32x4 a = {0.f, 0.f, 0.f, 0.f};
#pragma unroll
            for (int i = 0; i < 8; ++i) { const f32x4 w = *(const f32x4*)(p.w_ada + ((size_t)(l * 1024 + dc * 8 + i)) * 6144 + col4 * 4); a += w * sc[i]; }
            if (dc == 0) a += *(const f32x4*)(p.b_ada + l * 6144 + col4 * 4);
            float* dst = modacc + l * 6144 + col4 * 4;
            atomicAdd(dst + 0, a.x); atomicAdd(dst + 1, a.y); atomicAdd(dst + 2, a.z); atomicAdd(dst + 3, a.w); }
    }
    { f32x2* tab = WSP(f32x2, OFF_TAB);
      for (int idx = F.bid * NTHREADS + F.tid; idx < M * 8; idx += F.G * NTHREADS) { const int t = idx >> 3, i = idx & 7;
          const float fhi = i == 0 ? 1.0f : i == 1 ? 0.1939227432012558f : i == 2 ? 0.03760603070259094f : i == 3 ? 0.007292664609849453f : i == 4 ? 0.0014142135623842478f : i == 5 ? 0.00027424818836152554f : i == 6 ? 5.3182957344688475e-05f : 1.0313385246263351e-05f;
          const float flo = i == 0 ? 0.0f : i == 1 ? 1.5474299619455678e-09f : i == 2 ? 2.2827298384875405e-10f : i == 3 ? 1.2736765808707418e-10f : i == 4 ? -1.115275406748939e-14f : i == 5 ? -1.2685318073746288e-11f : i == 6 ? 1.624761414818765e-12f : 1.309491116886427e-13f;
          const float ps = (float)p.pos[t];
          const float ph = ps * fhi, pe = fmaf(ps, fhi, -ph) + ps * flo;
          const float kk = rintf(ph * 0.15915494309189535f);
          float r = fmaf(-kk, 6.2831854820251465f, ph); r = fmaf(-kk, -1.7484555314695172e-07f, r); r += pe;
          float sn, cs; sincosf(r, &sn, &cs); tab[idx] = (f32x2){(float)cs, (float)sn}; } }
    int tb = 0;
    for (int l = 0; l < 2; ++l) xpose_matrix(F, p.w_in + (size_t)l * D * INW, D, INW, WSP(h16, OFF_WT_IN) + (size_t)l * INW * D, MapId{}, tb);
    for (int l = 0; l < 2; ++l) xpose_matrix(F, p.w_out + (size_t)l * D * D, D, D, WSP(h16, OFF_WT_OUT) + (size_t)l * D * D, MapId{}, tb);
    xpose_matrix(F, p.fup, D, 2 * FFN, WSP(h16, OFF_WT_UP), MapGU{FFN}, tb);
    xpose_matrix(F, p.fdown, FFN, D, WSP(h16, OFF_WT_DOWN), MapId{}, tb);
    for (int e = 0; e < NE; ++e) xpose_matrix(F, p.mup + (size_t)e * D * 2 * EDIM, D, 2 * EDIM, WSP(h16, OFF_WT_MUP) + (size_t)e * 2 * EDIM * D, MapGU{EDIM}, tb);
    for (int e = 0; e < NE; ++e) xpose_matrix(F, p.mdown + (size_t)e * EDIM * D, EDIM, D, WSP(h16, OFF_WT_MDOWN) + (size_t)e * D * EDIM, MapId{}, tb);
}

__device__ __forceinline__ void step_h0(Frame& F) {
    const float* mod = (const float*)(F.ws + OFF_CTL) + CW_MOD;
    h16* H = WSP(h16, OFF_H);
    for (size_t i = (size_t)F.bid * NTHREADS + F.tid; i < (size_t)M * D / 8; i += (size_t)F.G * NTHREADS) {
        const int col = (int)(i & 127) * 8;
        const f32x4 a = *(const f32x4*)(F.pp->x + i * 8), b = *(const f32x4*)(F.pp->x + i * 8 + 4);
        const f32x4 sh0 = *(const f32x4*)(mod + col), sh1 = *(const f32x4*)(mod + col + 4), sc0 = *(const f32x4*)(mod + 1024 + col), sc1 = *(const f32x4*)(mod + 1024 + col + 4);
        const f32x4 r0 = a * (sc0 + 1.0f) + sh0, r1 = b * (sc1 + 1.0f) + sh1;
        u32x4 w; w.x = pk2(r0[0], r0[1]); w.y = pk2(r0[2], r0[3]); w.z = pk2(r1[0], r1[1]); w.w = pk2(r1[2], r1[3]);
        *(u32x4*)(H + i * 8) = w;
    }
}

constexpr size_t SCR_QS = OFF_BIG, SCR_FF = OFF_BIG + 16 * MiB, SCR_KF = OFF_BIG + 32 * MiB, SCR_FB = OFF_BIG + 48 * MiB, SCR_KB = OFF_BIG + 64 * MiB, SCR_OA = OFF_BIG + 80 * MiB;
__device__ __forceinline__ void step_rot(Frame& F, int layer) {
    h16* P = WSP(h16, OFF_PROJ); const f32x2* tab = WSP(f32x2, OFF_TAB);
    for (int idx = F.bid * NTHREADS + F.tid; idx < M * 14; idx += F.G * NTHREADS) {
        const int t = idx / 14, hh = idx % 14;
        const int cb = hh < 4 ? PC_Q + hh * 64 : hh < 8 ? PC_K + (hh - 4) * 64 : hh < 12 ? PD_Q + (hh - 8) * 64 : PD_K + (hh - 12) * 64;
        h16* ptr = P + (size_t)t * INW + cb;
        const h16x8 x1 = *(const h16x8*)ptr, x2 = *(const h16x8*)(ptr + 8);
        h16x8 o1, o2;
#pragma unroll
        for (int i = 0; i < 8; ++i) { const f32x2 cs = tab[t * 8 + i]; const float a = (float)x1[i], b = (float)x2[i]; o1[i] = (h16)(a * cs.x - b * cs.y); o2[i] = (h16)(b * cs.x + a * cs.y); }
        *(h16x8*)ptr = o1; *(h16x8*)(ptr + 8) = o2;
    }
    float* QS = WSP(float, SCR_QS); float* FF = WSP(float, SCR_FF); float* KF = WSP(float, SCR_KF); float* FB = WSP(float, SCR_FB); float* KB = WSP(float, SCR_KB);
    for (int idx = F.bid * NTHREADS + F.tid; idx < M * 256; idx += F.G * NTHREADS) {
        const int t = idx >> 8, c = idx & 255;
        const h16* row = P + (size_t)t * INW;
        const float lb = layer == 0 ? 0.f : sigmoidf_(F.pp->alb[256 + c] - F.pp->alb[c]);
        const float q = (float)row[PA_Q + c], zf = (float)row[PA_FF + c], zb = (float)row[PA_FB + c];
        QS[idx] = siluf_(q);
        FF[idx] = lb + (1.f - lb) * sigmoidf_(zf); KF[idx] = (1.f - lb) * sigmoidf_(-zf);
        FB[idx] = lb + (1.f - lb) * sigmoidf_(zb); KB[idx] = (1.f - lb) * sigmoidf_(-zb);
    }
}

__device__ __forceinline__ void hgrn_seq_item(Frame& F, int item) {
    const int vs = item & 7, dir = (item >> 3) & 1, h = item >> 4;
    const int v = vs * 8 + F.wave, k = F.lane;
    const float* QS = WSP(float, SCR_QS) + h * 64 + k; const float* FG = WSP(float, dir ? SCR_FB : SCR_FF) + h * 64 + k; const float* KG = WSP(float, dir ? SCR_KB : SCR_KF) + h * 64 + k;
    const h16* VV = WSP(h16, OFF_PROJ) + PA_I + h * 64 + v;
    float* OA = WSP(float, SCR_OA) + (size_t)dir * M * 256 + h * 64 + v;
    float S = 0.f;
    constexpr int U = 8;
    for (int s0 = 0; s0 < M; s0 += U) {
        float f[U], kk[U], qs[U], vv[U];
#pragma unroll
        for (int u = 0; u < U; ++u) { const int t = dir ? (M - 1 - (s0 + u)) : (s0 + u); f[u] = FG[(size_t)t * 256]; kk[u] = KG[(size_t)t * 256]; qs[u] = QS[(size_t)t * 256]; vv[u] = (float)VV[(size_t)t * INW]; }
#pragma unroll
        for (int u = 0; u < U; ++u) { const int t = dir ? (M - 1 - (s0 + u)) : (s0 + u); S = f[u] * S + kk[u] * vv[u]; const float o = wave_sum(qs[u] * S); if (F.lane == 0) OA[(size_t)t * 256] = o; }
    }
}
__device__ __forceinline__ void conv_item(Frame& F, int item, int layer) {
    const Params& p = *F.pp;
    float* U = (float*)F.lds;
    float* Yt = U + 62 * 256;
    const h16* P = WSP(h16, OFF_PROJ);
    const int t0 = item * 32;
    for (int i = F.tid; i < 62 * 256; i += NTHREADS) { const int r = i >> 8, c = i & 255, t = t0 - 15 + r; float u = 0.f;
        if (t >= 0 && t < M) { const h16* row = P + (size_t)t * INW; u = (float)row[PB_V + c] * sigmoidf_((float)row[PB_G + c]); }
        U[i] = u; }
    __syncthreads();
    { const int c = F.tid & 255, tg = F.tid >> 8;
      float w[31];
#pragma unroll
      for (int j = 0; j < 31; ++j) w[j] = p.cw[(size_t)layer * 31 * 256 + j * 256 + c];
      const float bias = p.cb[layer * 256 + c];
      for (int tt = tg * 16; tt < tg * 16 + 16; ++tt) { float a = bias;
#pragma unroll
          for (int j = 0; j < 31; ++j) a += w[j] * U[(tt + j) * 256 + c];
          Yt[tt * 256 + c] = a; } }
    __syncthreads();
    { h16* Y = WSP(h16, OFF_Y);
      for (int r = F.wave * 4; r < F.wave * 4 + 4; ++r) {
          const f32x4 v = *(const f32x4*)(Yt + r * 256 + F.lane * 4);
          const float mean = wave_sum((v.x + v.y) + (v.z + v.w)) * (1.f / 256.f);
          const f32x4 d = v - mean;
          const float var = wave_sum((d.x * d.x + d.y * d.y) + (d.z * d.z + d.w * d.w)) * (1.f / 256.f);
          const float rstd = 1.0f / sqrtf(var + LN_EPS);
          const f32x4 nw = *(const f32x4*)(p.cnw + layer * 256 + F.lane * 4), nb = *(const f32x4*)(p.cnb + layer * 256 + F.lane * 4);
          const f32x4 o = d * rstd * nw + nb;
          u32x2 w2; w2.x = pk2(siluf_(o.x), siluf_(o.y)); w2.y = pk2(siluf_(o.z), siluf_(o.w));
          *(u32x2*)(Y + (size_t)(t0 + r) * D + 256 + F.lane * 4) = w2; } }
    __syncthreads();
}
#define ATT_KEY(sidx) do { const int s_ = (sidx); if (s_ >= 0 && s_ < M) { const h16* kr = Pk + (size_t)s_ * INW; const h16* vr = Pv + (size_t)s_ * INW; float sc = 0.f; \
    _Pragma("unroll") for (int c8 = 0; c8 < 8; ++c8) { const h16x8 kk = *(const h16x8*)(kr + 8 * c8); _Pragma("unroll") for (int e = 0; e < 4; ++e) sc = __builtin_amdgcn_fdot2((h16x2){qv[c8][2 * e], qv[c8][2 * e + 1]}, (h16x2){kk[2 * e], kk[2 * e + 1]}, sc, false); } \
    const float mn = fmaxf(m, sc), corr = __expf(m - mn), pw = __expf(sc - mn); l = l * corr + pw; m = mn; \
    _Pragma("unroll") for (int c8 = 0; c8 < 8; ++c8) { const h16x8 vv = *(const h16x8*)(vr + 8 * c8); _Pragma("unroll") for (int e = 0; e < 8; ++e) acc[8 * c8 + e] = acc[8 * c8 + e] * corr + pw * (float)vv[e]; } } } while (0)
__device__ __forceinline__ void attn_naive_item(Frame& F, int item, int layer, int which  ) {
    const int idx = item * NTHREADS + F.tid; const int h = idx >> 14, t = idx & (M - 1);
    const h16* P = WSP(h16, OFF_PROJ);
    const h16* Pq = P + (size_t)t * INW + (which ? PD_Q : PC_Q) + h * 64;
    const h16* Pk = P + (which ? PD_K + (h >> 1) * 64 : PC_K + h * 64);
    const h16* Pv = P + (which ? PD_V + (h >> 1) * 64 : PC_V + h * 64);
    h16x8 qv[8]; float acc[64]; float m = -1e30f, l = 0.f;
#pragma unroll
    for (int c8 = 0; c8 < 8; ++c8) { qv[c8] = *(const h16x8*)(Pq + 8 * c8) * (h16)0.125f;
#pragma unroll
        for (int e = 0; e < 8; ++e) acc[8 * c8 + e] = 0.f; }
    h16* Y = WSP(h16, OFF_Y) + (size_t)t * D + (which ? 768 : 512) + h * 64;
    float scale;
    if (which == 0) {
        for (int j = -64; j <= 64; ++j) ATT_KEY(t + j);
        for (int j = -64; j <= 64; ++j) ATT_KEY(t + 4 * j);
        for (int j = -64; j <= 64; ++j) ATT_KEY(t + 16 * j);
        scale = 1.0f / l;
    } else {
        for (int j = -128; j <= 128; ++j) ATT_KEY(t + j);
        const float sk = F.pp->sink[layer * 4 + h]; const float mt = fmaxf(m, sk), w = __expf(m - mt), den = l * w + __expf(sk - mt);
        scale = w / den;
    }
#pragma unroll
    for (int c8 = 0; c8 < 8; ++c8) { u32x4 w; w.x = pk2(acc[8 * c8] * scale, acc[8 * c8 + 1] * scale); w.y = pk2(acc[8 * c8 + 2] * scale, acc[8 * c8 + 3] * scale);
        w.z = pk2(acc[8 * c8 + 4] * scale, acc[8 * c8 + 5] * scale); w.w = pk2(acc[8 * c8 + 6] * scale, acc[8 * c8 + 7] * scale); *(u32x4*)(Y + 8 * c8) = w; }
}
__device__ __forceinline__ void step_mix(Frame& F, int layer) {
    constexpr int N_HG = 64, N_CONV = M / 32, N_AT = M * 4 / NTHREADS;
    int b = F.bid, G = F.G;
    if (G > 2 * N_HG) { if (b < N_HG) { hgrn_seq_item(F, b); return; } b -= N_HG; G -= N_HG; }
    else { for (int it = b; it < N_HG; it += G) hgrn_seq_item(F, it); }
    for (int it = b; it < N_CONV + 2 * N_AT; it += G) {
        if (it < N_CONV) conv_item(F, it, layer);
        else if (it < N_CONV + N_AT) attn_naive_item(F, it - N_CONV, layer, 0);
        else attn_naive_item(F, it - N_CONV - N_AT, layer, 1);
    }
}
__device__ __forceinline__ void step_afin(Frame& F, int layer) {
    const float* OA = WSP(float, SCR_OA); const h16* P = WSP(h16, OFF_PROJ); h16* Y = WSP(h16, OFF_Y);
    const int gw = F.bid * NWAVES + F.wave, NGW = F.G * NWAVES;
    const float nw = F.pp->anw[layer * 64 + F.lane];
    for (int it = gw; it < M * 4; it += NGW) { const int t = it >> 2, h = it & 3;
        const float o = OA[(size_t)t * 256 + h * 64 + F.lane] + OA[(size_t)M * 256 + (size_t)t * 256 + h * 64 + F.lane];
        const float ms = wave_sum(o * o) * (1.f / 64.f);
        const float g = (float)P[(size_t)t * INW + PA_G + h * 64 + F.lane];
        Y[(size_t)t * D + h * 64 + F.lane] = (h16)(o * (1.0f / sqrtf(ms + RMS_EPS)) * nw * siluf_(g)); }
}

struct LnArgs { const float* xin; const float* gate; const float* lw; const float* lb; const float* nscale; const float* nshift; float* xout; h16* hout; };
__device__ __forceinline__ void ln_core(const Frame& F, const LnArgs& a, int row, const f32x4 (&fv)[4], f32x4 (&hv)[4]) {
    f32x4 tv[4]; float s = 0.f;
#pragma unroll
    for (int j = 0; j < 4; ++j) { const int col = F.lane * 4 + 256 * j; const f32x4 xi = *(const f32x4*)(a.xin + (size_t)row * D + col), g = *(const f32x4*)(a.gate + col);
        tv[j] = xi * ALPHA + (g + 1.0f) * fv[j]; s += (tv[j].x + tv[j].y) + (tv[j].z + tv[j].w); }
    const float mean = wave_sum(s) * (1.f / D); float s2 = 0.f;
#pragma unroll
    for (int j = 0; j < 4; ++j) { tv[j] = tv[j] - mean; s2 += (tv[j].x * tv[j].x + tv[j].y * tv[j].y) + (tv[j].z * tv[j].z + tv[j].w * tv[j].w); }
    const float rstd = 1.0f / sqrtf(wave_sum(s2) * (1.f / D) + LN_EPS);
#pragma unroll
    for (int j = 0; j < 4; ++j) { const int col = F.lane * 4 + 256 * j; const f32x4 w = *(const f32x4*)(a.lw + col), b = *(const f32x4*)(a.lb + col);
        const f32x4 xo = tv[j] * rstd * w + b;
        *(f32x4*)(a.xout + (size_t)row * D + col) = xo;
        if (a.hout) { const f32x4 sc = *(const f32x4*)(a.nscale + col), sh = *(const f32x4*)(a.nshift + col); hv[j] = xo * (sc + 1.0f) + sh;
            u32x2 w2; w2.x = pk2(hv[j].x, hv[j].y); w2.y = pk2(hv[j].z, hv[j].w); *(u32x2*)(a.hout + (size_t)row * D + col) = w2; } }
}
__device__ __forceinline__ void step_ln_dense(Frame& F, const LnArgs& a, const float* Z, bool router) {
    const int gw = F.bid * NWAVES + F.wave, NGW = F.G * NWAVES;
    unsigned* cnt = (unsigned*)(F.ws + OFF_CTL) + CW_CNT; unsigned* tok = WSP(unsigned, OFF_TOK);
    for (int row = gw; row < M; row += NGW) {
        f32x4 fv[4], hv[4];
#pragma unroll
        for (int j = 0; j < 4; ++j) fv[j] = *(const f32x4*)(Z + (size_t)row * D + F.lane * 4 + 256 * j);
        ln_core(F, a, row, fv, hv);
        if (router) {
            float lg[8];
#pragma unroll
            for (int e = 0; e < 8; ++e) lg[e] = 0.f;
#pragma unroll
            for (int j = 0; j < 4; ++j)
#pragma unroll
                for (int i = 0; i < 4; ++i) { const int col = F.lane * 4 + 256 * j + i; const f32x4 w0 = *(const f32x4*)(F.pp->rout + (size_t)col * 8), w1 = *(const f32x4*)(F.pp->rout + (size_t)col * 8 + 4); const float hval = hv[j][i];
                    lg[0] += hval * w0.x; lg[1] += hval * w0.y; lg[2] += hval * w0.z; lg[3] += hval * w0.w; lg[4] += hval * w1.x; lg[5] += hval * w1.y; lg[6] += hval * w1.z; lg[7] += hval * w1.w; }
#pragma unroll
            for (int e = 0; e < 8; ++e) lg[e] = wave_sum(lg[e]);
            int e1 = 0; float l1 = lg[0];
#pragma unroll
            for (int e = 1; e < 8; ++e) if (lg[e] > l1) { l1 = lg[e]; e1 = e; }
            int e2 = -1; float l2 = -3.0e38f;
#pragma unroll
            for (int e = 0; e < 8; ++e) if (e != e1 && lg[e] > l2) { l2 = lg[e]; e2 = e; }
            const float g1 = 1.0f / (1.0f + __expf(l2 - l1)), g2 = 1.0f - g1;
            if (F.lane == 0) { tok[row * 8 + 0] = (unsigned)e1; tok[row * 8 + 1] = (unsigned)e2; tok[row * 8 + 2] = __float_as_uint(g1); tok[row * 8 + 3] = __float_as_uint(g2);
                atomicAdd(cnt + e1, 1u); atomicAdd(cnt + e2, 1u); }
        }
    }
}
__device__ __forceinline__ void step_slot(Frame& F) {
    const unsigned* cnt = (const unsigned*)(F.ws + OFF_CTL) + CW_CNT; unsigned* cur = (unsigned*)(F.ws + OFF_CTL) + CW_CUR; unsigned* tok = WSP(unsigned, OFF_TOK);
    const h16* H = WSP(h16, OFF_H); h16* HG = WSP(h16, OFF_PROJ);
    unsigned off[8]; { unsigned o = 0;
#pragma unroll
        for (int e = 0; e < 8; ++e) { off[e] = o; o += ((cnt[e] + 255u) >> 8) << 8; } }
    const int gw = F.bid * NWAVES + F.wave, NGW = F.G * NWAVES;
    for (int row = gw; row < M; row += NGW) {
        const unsigned e1 = tok[row * 8 + 0], e2 = tok[row * 8 + 1];
        unsigned s1 = 0, s2 = 0;
        if (F.lane == 0) {
            unsigned o1 = 0, o2 = 0;
#pragma unroll
            for (int e = 0; e < 8; ++e) { o1 = (e1 == (unsigned)e) ? off[e] : o1; o2 = (e2 == (unsigned)e) ? off[e] : o2; }
            s1 = o1 + atomicAdd(cur + e1, 1u); s2 = o2 + atomicAdd(cur + e2, 1u); tok[row * 8 + 4] = s1; tok[row * 8 + 5] = s2; }
        s1 = __shfl(s1, 0); s2 = __shfl(s2, 0);
        const u32x4 a = *(const u32x4*)(H + (size_t)row * D + F.lane * 8), b = *(const u32x4*)(H + (size_t)row * D + 512 + F.lane * 8);
        *(u32x4*)(HG + (size_t)s1 * D + F.lane * 8) = a; *(u32x4*)(HG + (size_t)s1 * D + 512 + F.lane * 8) = b;
        *(u32x4*)(HG + (size_t)s2 * D + F.lane * 8) = a; *(u32x4*)(HG + (size_t)s2 * D + 512 + F.lane * 8) = b;
    }
}
__device__ __forceinline__ void step_ln_moe(Frame& F, const LnArgs& a) {
    const int gw = F.bid * NWAVES + F.wave, NGW = F.G * NWAVES;
    const unsigned* tok = WSP(unsigned, OFF_TOK); const float* YS = WSP(float, OFF_PROJ);
    for (int row = gw; row < M; row += NGW) {
        const float g1 = __uint_as_float(tok[row * 8 + 2]), g2 = __uint_as_float(tok[row * 8 + 3]); const unsigned s1 = tok[row * 8 + 4], s2 = tok[row * 8 + 5];
        f32x4 fv[4], hv[4];
#pragma unroll
        for (int j = 0; j < 4; ++j) { const int col = F.lane * 4 + 256 * j; fv[j] = *(const f32x4*)(YS + (size_t)s1 * D + col) * g1 + *(const f32x4*)(YS + (size_t)s2 * D + col) * g2; }
        ln_core(F, a, row, fv, hv);
    }
}

constexpr int N_STEPS = 21;
#ifndef KMASK
#define KMASK 0xFFFF
#endif
#define KON(k) ((KMASK >> (k)) & 1)
__global__ void __launch_bounds__(NTHREADS, 2) fwd_kernel(Params kp) {
    extern __shared__ __attribute__((aligned(16))) unsigned char lds[];
    Frame F; F.lds = lds; F.tid = threadIdx.x; F.lane = F.tid & 63; F.wave = __builtin_amdgcn_readfirstlane(F.tid >> 6); F.G = gridDim.x; F.bid = blockIdx.x; F.ws = kp.ws;
    LAS unsigned char* ldsl = (LAS unsigned char*)lds;
    const int lo = kp.lo, hi = kp.hi;
    for (int s = lo; s < hi; ++s) {
        { const Params* pp_ = (const Params*)__builtin_amdgcn_kernarg_segment_ptr(); asm volatile("" : "+s"(pp_) :: "memory"); F.pp = pp_; unsigned char* ws_ = kp.ws; asm volatile("" : "+s"(ws_)); F.ws = ws_; }
        const Params& p = *F.pp;
        { int tid_ = threadIdx.x; asm volatile("" : "+v"(tid_)); F.tid = tid_; F.lane = tid_ & 63; F.wave = __builtin_amdgcn_readfirstlane(tid_ >> 6); }
        int layer = 0, kind = s;
        if (s >= 11) { layer = 1; kind = s - 9; }
        const float* mod = (const float*)(F.ws + OFF_CTL) + CW_MOD;
        const float* modl = mod + layer * 6144;
        if (KON(0) && s == 0) step_pre(F);
        else if (KON(1) && s == 1) step_h0(F);
        else if (KON(2) && kind == 2) { g8::DenseOrder S; S.init(WSP(h16, OFF_H), WSP(h16, OFF_WT_IN) + (size_t)layer * INW * D, M, INW, D, F.G, F.bid); g8::EpiF16 E{WSP(h16, OFF_PROJ), INW}; g8::gemm_phase(ldsl, F.tid, D, S, E); }
        else if (KON(3) && kind == 3) step_rot(F, layer);
        else if (KON(4) && kind == 4) step_mix(F, layer);
        else if (KON(5) && kind == 5) step_afin(F, layer);
        else if (KON(6) && kind == 6) { g8::DenseOrder S; S.init(WSP(h16, OFF_Y), WSP(h16, OFF_WT_OUT) + (size_t)layer * D * D, M, D, D, F.G, F.bid); g8::EpiF32 E{WSP(float, OFF_Z), D}; g8::gemm_phase(ldsl, F.tid, D, S, E); }
        else if (KON(7) && kind == 7) { LnArgs a{layer == 0 ? p.x : WSP(float, OFF_X), modl + 2048, p.lnw + (size_t)(layer * 2) * D, p.lnb + (size_t)(layer * 2) * D, modl + 4096, modl + 3072, WSP(float, OFF_X), WSP(h16, OFF_H)};
            step_ln_dense(F, a, WSP(float, OFF_Z), layer == 1); }
        else if (KON(8) && layer == 0 && kind == 8) { g8::DenseOrder S; S.init(WSP(h16, OFF_H), WSP(h16, OFF_WT_UP), M, 2 * FFN, D, F.G, F.bid); g8::EpiSwiGLU E{WSP(h16, OFF_PROJ), FFN}; g8::gemm_phase(ldsl, F.tid, D, S, E); }
        else if (KON(9) && layer == 0 && kind == 9) { g8::DenseOrder S; S.init(WSP(h16, OFF_PROJ), WSP(h16, OFF_WT_DOWN), M, D, FFN, F.G, F.bid); g8::EpiF32 E{WSP(float, OFF_Z), D}; g8::gemm_phase(ldsl, F.tid, FFN, S, E); }
        else if (KON(10) && layer == 0 && kind == 10) { LnArgs a{WSP(float, OFF_X), modl + 5120, p.lnw + (size_t)1 * D, p.lnb + (size_t)1 * D, mod + 6144 + 1024, mod + 6144 + 0, WSP(float, OFF_X), WSP(h16, OFF_H)};
            step_ln_dense(F, a, WSP(float, OFF_Z), false); }
        else if (KON(11) && layer == 1 && kind == 8) step_slot(F);
        else if (KON(12) && layer == 1 && kind == 9) { g8::MoeOrder S; S.init(WSP(h16, OFF_PROJ), WSP(h16, OFF_WT_MUP), (size_t)2 * EDIM * D * 2, 2 * EDIM, D, F.G, F.bid, (const unsigned*)(F.ws + OFF_CTL) + CW_CNT);
            g8::EpiSwiGLU E{WSP(h16, OFF_BIG), EDIM}; g8::gemm_phase(ldsl, F.tid, D, S, E); }
        else if (KON(13) && layer == 1 && kind == 10) { g8::MoeOrder S; S.init(WSP(h16, OFF_BIG), WSP(h16, OFF_WT_MDOWN), (size_t)D * EDIM * 2, D, EDIM, F.G, F.bid, (const unsigned*)(F.ws + OFF_CTL) + CW_CNT);
            g8::EpiF32 E{WSP(float, OFF_PROJ), D}; g8::gemm_phase(ldsl, F.tid, EDIM, S, E); }
        else if (KON(14) && layer == 1 && kind == 11) { LnArgs a{WSP(float, OFF_X), modl + 5120, p.lnw + (size_t)3 * D, p.lnb + (size_t)3 * D, nullptr, nullptr, p.out, nullptr}; step_ln_moe(F, a); }
        if (s + 1 < hi) { cg::this_grid().sync(); }
    }
}

extern "C" void kernel_launch(void* const* d_in, const int* in_sizes, int n_in, void* d_out, int out_size, void* d_ws, size_t ws_size, hipStream_t stream) {
    static int grid = 0;
    if (grid == 0) {
        if (n_in != 21 || in_sizes[0] != M * D || out_size != M * D || ws_size < OFF_END) { fprintf(stderr, "kernel_launch: unexpected shapes / workspace (%d inputs, ws %zu, need %zu)\n", n_in, ws_size, (size_t)OFF_END); grid = -1; return; }
        int dev = 0, cus = 0, per_cu = 0;
        hipGetDevice(&dev); hipDeviceGetAttribute(&cus, hipDeviceAttributeMultiprocessorCount, dev);
        hipFuncSetAttribute((const void*)fwd_kernel, hipFuncAttributeMaxDynamicSharedMemorySize, LDS_BYTES);
        hipOccupancyMaxActiveBlocksPerMultiprocessor(&per_cu, (const void*)fwd_kernel, NTHREADS, LDS_BYTES);
        if (per_cu < 1) { fprintf(stderr, "kernel_launch: occupancy query says %d blocks per CU\n", per_cu); per_cu = 1; }
        grid = cus * 1;
        fprintf(stderr, "kernel_launch: grid %d (cus %d, per_cu %d), ws %zu\n", grid, cus, per_cu, ws_size);
    }
    if (grid < 0) return;
    hipMemsetAsync((char*)d_ws + OFF_CTL, 0, CTL_BYTES, stream);
    Params p{};
    p.x = (const float*)d_in[0]; p.c = (const float*)d_in[1]; p.pos = (const int*)d_in[2]; p.w_ada = (const float*)d_in[3]; p.b_ada = (const float*)d_in[4];
    p.w_in = (const float*)d_in[5]; p.w_out = (const float*)d_in[6]; p.alb = (const float*)d_in[7]; p.anw = (const float*)d_in[8]; p.cw = (const float*)d_in[9];
    p.cb = (const float*)d_in[10]; p.cnw = (const float*)d_in[11]; p.cnb = (const float*)d_in[12]; p.sink = (const float*)d_in[13]; p.lnw = (const float*)d_in[14];
    p.lnb = (const float*)d_in[15]; p.fup = (const float*)d_in[16]; p.fdown = (const float*)d_in[17]; p.rout = (const float*)d_in[18]; p.mup = (const float*)d_in[19];
    p.mdown = (const float*)d_in[20]; p.out = (float*)d_out; p.ws = (unsigned char*)d_ws;
#if MK_ONE_LAUNCH
    p.lo = 0; p.hi = N_STEPS;
    { void* args[] = {&p}; hipError_t e = hipLaunchCooperativeKernel((const void*)fwd_kernel, dim3(grid), dim3(NTHREADS), args, LDS_BYTES, stream);
      if (e != hipSuccess) fprintf(stderr, "cooperative launch failed: %s\n", hipGetErrorString(e)); }
#else
    for (int s = 0; s < N_STEPS; ++s) { p.lo = s; p.hi = s + 1;
        void* args[] = {&p}; hipError_t e = hipLaunchCooperativeKernel((const void*)fwd_kernel, dim3(grid), dim3(NTHREADS), args, LDS_BYTES, stream);
        if (e != hipSuccess) { fprintf(stderr, "launch %d failed: %s\n", s, hipGetErrorString(e)); break; } }
#endif
}
```

```cpp
#include <hip/hip_runtime.h>
#include <hip/hip_cooperative_groups.h>
#include <cstdio>
#include <cstdint>
namespace cg = cooperative_groups;

#ifndef MK_ONE_LAUNCH
#define MK_ONE_LAUNCH 1
#endif

#define LAS __attribute__((address_space(3)))
typedef _Float16 h16;
typedef h16 h16x8 __attribute__((ext_vector_type(8)));
typedef h16 h16x4 __attribute__((ext_vector_type(4)));
typedef h16 h16x2 __attribute__((ext_vector_type(2)));
typedef float f32x4 __attribute__((ext_vector_type(4)));
typedef float f32x2 __attribute__((ext_vector_type(2)));
typedef unsigned u32x4 __attribute__((ext_vector_type(4)));
typedef unsigned u32x2 __attribute__((ext_vector_type(2)));

constexpr int M = 16384, D = 1024, INW = 3072, FFN = 2816, NE = 8, EDIM = 3584;
constexpr int MOE_ROWS = 2 * M + NE * 256;
constexpr float ALPHA = 1.41421356237309515f;
constexpr float LN_EPS = 1e-5f, RMS_EPS = 1e-6f;
constexpr int NTHREADS = 512, NWAVES = 8;
constexpr int LDS_BYTES = 139264;

constexpr int PA_Q = 0, PA_FF = 256, PA_FB = 512, PA_I = 768, PA_G = 1024, PB_V = 1280, PB_G = 1536;
constexpr int PC_Q = 1792, PC_K = 2048, PC_V = 2304, PD_Q = 2560, PD_K = 2816, PD_V = 2944;

constexpr size_t MiB = 1u << 20;
constexpr size_t OFF_CTL = 0, CTL_BYTES = 1 * MiB;
constexpr size_t OFF_TAB = 1 * MiB;
constexpr size_t OFF_TOK = 2 * MiB;
constexpr size_t OFF_WT_IN = 4 * MiB;
constexpr size_t OFF_WT_OUT = 16 * MiB;
constexpr size_t OFF_WT_UP = 20 * MiB;
constexpr size_t OFF_WT_DOWN = 31 * MiB;
constexpr size_t OFF_WT_MUP = 37 * MiB;
constexpr size_t OFF_WT_MDOWN = 149 * MiB;
constexpr size_t OFF_X = 205 * MiB;
constexpr size_t OFF_H = 269 * MiB;
constexpr size_t OFF_Y = 301 * MiB;
constexpr size_t OFF_Z = 333 * MiB;
constexpr size_t OFF_PROJ = 397 * MiB;
constexpr size_t OFF_BIG = 533 * MiB;
constexpr size_t OFF_END = 775 * MiB;
constexpr int CW_MOD = 1024;
constexpr int CW_CNT = 64;
constexpr int CW_CUR = 128;

struct Params {
    const float* x; const float* c; const int* pos; const float* w_ada; const float* b_ada; const float* w_in; const float* w_out;
    const float* alb; const float* anw; const float* cw; const float* cb; const float* cnw; const float* cnb; const float* sink;
    const float* lnw; const float* lnb; const float* fup; const float* fdown; const float* rout; const float* mup; const float* mdown;
    float* out; unsigned char* ws; int lo, hi;
};

__device__ __forceinline__ unsigned pk2(float lo, float hi) { h16x2 v; v.x = (h16)lo; v.y = (h16)hi; return __builtin_bit_cast(unsigned, v); }
__device__ __forceinline__ float sigmoidf_(float v) { return 1.0f / (1.0f + __expf(-v)); }
__device__ __forceinline__ float siluf_(float v) { return v / (1.0f + __expf(-v)); }
__device__ __forceinline__ float wave_sum(float v) {
#pragma unroll
    for (int o = 1; o < 64; o <<= 1) v += __shfl_xor(v, o);
    return v;
}
#define LDS_WAIT() asm volatile("s_waitcnt lgkmcnt(0)" ::: "memory")

namespace g8 {
constexpr int BM = 256, BK = 64, HALF = 128, HTB = HALF * BK * 2, STAGE_BYTES = 8 * HTB, NXCD = 8, WGM = 8;
__device__ __forceinline__ int lds_byte(int r, int c) { const int st = (r >> 4) * 2 + (c >> 5), rr = r & 15, cc = c & 31, ob = rr * 64 + cc * 2; return st * 1024 + (ob ^ (((ob >> 9) & 1) << 5)); }
__device__ __forceinline__ void stage_rc(int b, int& R, int& C) { const int st = b / 1024, sb = b % 1024, swz = sb ^ (((sb >> 9) & 1) << 5); R = (st >> 1) * 16 + swz / 64; C = (st & 1) * 32 + (swz % 64) / 2; }
__device__ __forceinline__ int perm32(int rho) { const int n = rho >> 4, i = rho & 15; return 8 * (i >> 2) + 4 * n + (i & 3); }

struct Unit { const char* A; const char* B; int pm, pn; };

__device__ __forceinline__ void tile_of(int L, int nM, int nN, int& pm, int& pn) {
    const int nwg = nM * nN; int wgid = L;
    { const int q = nwg / NXCD, r = nwg % NXCD, xcd = wgid % NXCD, off = wgid / NXCD; wgid = (xcd < r ? xcd * (q + 1) : r * (q + 1) + (xcd - r) * q) + off; }
    const int nig = WGM * nN, gid = wgid / nig, fm = gid * WGM, gsz = (nM - fm) < WGM ? (nM - fm) : WGM;
    pm = fm + ((wgid % nig) % gsz); pn = (wgid % nig) / gsz;
}
struct DenseOrder {
    const char* A; const char* B; int K, nM, nN, G, c;
    __device__ void init(const void* A_, const void* B_, int Mr, int N, int K_, int G_, int c_) { A = (const char*)A_; B = (const char*)B_; K = K_; nM = Mr / BM; nN = N / BM; G = G_; c = c_; }
    __device__ __forceinline__ bool next(int i, Unit& u) const {
        const long L = (long)i * G + c; if (L >= (long)nM * nN) return false;
        tile_of((int)L, nM, nN, u.pm, u.pn);
        u.A = A + (size_t)u.pm * BM * K * 2; u.B = B + (size_t)u.pn * BM * K * 2; return true;
    }
};
struct MoeOrder {
    const char* A; const char* B; size_t bstride; int K, nM, nN, G, c; int t1, t2, t3, t4, t5, t6, t7;
    __device__ void init(const void* A_, const void* B_, size_t bstride_, int N, int K_, int G_, int c_, const unsigned* cnt) {
        A = (const char*)A_; B = (const char*)B_; bstride = bstride_; K = K_; nN = N / BM; G = G_; c = c_;
        int t = 0;
#define RT_(e) ((int)((__builtin_amdgcn_readfirstlane((int)cnt[e]) + 255) >> 8))
        t += RT_(0); t1 = t; t += RT_(1); t2 = t; t += RT_(2); t3 = t; t += RT_(3); t4 = t; t += RT_(4); t5 = t; t += RT_(5); t6 = t; t += RT_(6); t7 = t; t += RT_(7); nM = t;
#undef RT_
    }
    __device__ __forceinline__ bool next(int i, Unit& u) const {
        const long L = (long)i * G + c; if (L >= (long)nM * nN) return false;
        tile_of((int)L, nM, nN, u.pm, u.pn);
        const int e = (u.pm >= t1) + (u.pm >= t2) + (u.pm >= t3) + (u.pm >= t4) + (u.pm >= t5) + (u.pm >= t6) + (u.pm >= t7);
        u.A = A + (size_t)u.pm * BM * K * 2; u.B = B + (size_t)e * bstride + (size_t)u.pn * BM * K * 2; return true;
    }
};

struct EpiF16 {
    static constexpr bool PERM = true;
    h16* O; int ldc;
    __device__ __forceinline__ void operator()(const f32x4 (&acc)[2][2][4][2], const Unit& u, int wr, int wc, int fr, int fq) const {
        const int row0 = u.pm * BM + wr * 64 + fr, col0 = u.pn * BM + wc * 32 + 8 * fq;
#pragma unroll
        for (int ai = 0; ai < 2; ++ai)
#pragma unroll
            for (int m = 0; m < 4; ++m) { h16* rowp = O + (size_t)(row0 + ai * HALF + m * 16) * ldc + col0;
#pragma unroll
                for (int bj = 0; bj < 2; ++bj) { const f32x4 v0 = acc[ai][bj][m][0], v1 = acc[ai][bj][m][1];
                    u32x4 w; w.x = pk2(v0[0], v0[1]); w.y = pk2(v0[2], v0[3]); w.z = pk2(v1[0], v1[1]); w.w = pk2(v1[2], v1[3]);
                    *(u32x4*)(rowp + bj * HALF) = w; } }
    }
};
struct EpiSwiGLU {
    static constexpr bool PERM = true;
    h16* O; int ldh;
    __device__ __forceinline__ void operator()(const f32x4 (&acc)[2][2][4][2], const Unit& u, int wr, int wc, int fr, int fq) const {
        const int row0 = u.pm * BM + wr * 64 + fr, col0 = u.pn * (BM / 2) + wc * 16 + 4 * fq;
#pragma unroll
        for (int ai = 0; ai < 2; ++ai)
#pragma unroll
            for (int m = 0; m < 4; ++m) { h16* rowp = O + (size_t)(row0 + ai * HALF + m * 16) * ldh + col0;
#pragma unroll
                for (int bj = 0; bj < 2; ++bj) { const f32x4 g = acc[ai][bj][m][0], up = acc[ai][bj][m][1];
                    u32x2 w; w.x = pk2(siluf_(g[0]) * up[0], siluf_(g[1]) * up[1]); w.y = pk2(siluf_(g[2]) * up[2], siluf_(g[3]) * up[3]);
                    *(u32x2*)(rowp + bj * (HALF / 2)) = w; } }
    }
};
struct EpiF32 {
    static constexpr bool PERM = false;
    float* C; int ldc;
    __device__ __forceinline__ void operator()(const f32x4 (&acc)[2][2][4][2], const Unit& u, int wr, int wc, int fr, int fq) const {
        const int row0 = u.pm * BM + wr * 64 + fr, col0 = u.pn * BM + wc * 32 + 4 * fq;
#pragma unroll
        for (int ai = 0; ai < 2; ++ai)
#pragma unroll
            for (int m = 0; m < 4; ++m) { float* rowp = C + (size_t)(row0 + ai * HALF + m * 16) * ldc + col0;
#pragma unroll
                for (int bj = 0; bj < 2; ++bj)
#pragma unroll
                    for (int n = 0; n < 2; ++n) *(f32x4*)(rowp + bj * HALF + n * 16) = acc[ai][bj][m][n]; }
    }
};

template <class Epi, class Sched>
__device__ __forceinline__ void gemm_phase(LAS unsigned char* lds, const int tid, const int K, const Sched& S, const Epi& E) {
    const int wid = __builtin_amdgcn_readfirstlane(tid >> 6), lane = tid & 63, wr = wid >> 2, wc = wid & 3, fr = lane & 15, fq = lane >> 4;
    const int nt = K / BK;
    unsigned voffA[2], voffB[2];
#pragma unroll
    for (int i = 0; i < 2; ++i) { int R, C; stage_rc(tid * 16 + i * 8192, R, C); const int Rb = Epi::PERM ? ((R & ~31) + perm32(R & 31)) : R;
        voffA[i] = (unsigned)(R * K + C) * 2u; voffB[i] = (unsigned)(Rb * K + C) * 2u; }
    const size_t kstep = (size_t)(BK * 2);
    const size_t hstep = (size_t)HALF * K * 2;
    const unsigned ldsw = (unsigned)wid * 1024u;
    const int aoff = lds_byte(wr * 64 + fr, fq * 8), boff = lds_byte(wc * 32 + fr, fq * 8);
#define G8_SA(b, h) (((b) * 2 + (h)) * HTB)
#define G8_SB(b, h) ((4 + (b) * 2 + (h)) * HTB)
#define G8_STAGE(bufoff, gbase, voff) do { _Pragma("unroll") for (int _i = 0; _i < 2; ++_i) \
        __builtin_amdgcn_global_load_lds((const unsigned*)((const char*)(gbase) + (voff)[_i]), (LAS unsigned*)(lds + (bufoff) + ldsw + _i * 8192), 16, 0, 0); } while (0)
#define G8_LDA(dst, b, h) do { _Pragma("unroll") for (int m = 0; m < 4; ++m) _Pragma("unroll") for (int k = 0; k < 2; ++k) dst[m][k] = *(const LAS h16x8*)(lds + G8_SA(b, h) + aoff + m * 2048 + k * 1024); } while (0)
#define G8_LDB(dst, b, h) do { _Pragma("unroll") for (int n = 0; n < 2; ++n) _Pragma("unroll") for (int k = 0; k < 2; ++k) dst[n][k] = *(const LAS h16x8*)(lds + G8_SB(b, h) + boff + n * 2048 + k * 1024); } while (0)
#define G8_MMA(ai, bj, At, Bt) do { __builtin_amdgcn_s_setprio(1); _Pragma("unroll") for (int m = 0; m < 4; ++m) _Pragma("unroll") for (int n = 0; n < 2; ++n) _Pragma("unroll") for (int k = 0; k < 2; ++k) \
        acc[ai][bj][m][n] = __builtin_amdgcn_mfma_f32_16x16x32_f16(Bt[n][k], At[m][k], acc[ai][bj][m][n], 0, 0, 0); __builtin_amdgcn_s_setprio(0); } while (0)
#define G8_WAIT_V(n) asm volatile("s_waitcnt vmcnt(" #n ")" ::: "memory")
#define G8_WAIT_L(n) asm volatile("s_waitcnt lgkmcnt(" #n ")" ::: "memory")
#define G8_BAR __builtin_amdgcn_s_barrier()
#define G8_SCHED __builtin_amdgcn_sched_barrier(0)
    Unit cur, nxt; int ui = 0;
    if (!S.next(0, cur)) return;
    f32x4 acc[2][2][4][2];
#pragma unroll
    for (int a = 0; a < 2; ++a)
#pragma unroll
        for (int b = 0; b < 2; ++b)
#pragma unroll
            for (int m = 0; m < 4; ++m)
#pragma unroll
                for (int n = 0; n < 2; ++n) acc[a][b][m][n] = (f32x4){0.f, 0.f, 0.f, 0.f};
    h16x8 At[4][2], B0[2][2], B1[2][2];
    const char* cA = cur.A; const char* cB = cur.B;
    G8_STAGE(G8_SB(0, 0), cB, voffB); G8_STAGE(G8_SB(0, 1), cB + hstep, voffB); G8_STAGE(G8_SA(0, 0), cA, voffA); G8_STAGE(G8_SA(0, 1), cA + hstep, voffA);
    if (wr == 1) G8_BAR;
    G8_WAIT_V(2); G8_BAR;
    G8_STAGE(G8_SB(1, 0), cB + kstep, voffB); G8_STAGE(G8_SA(1, 0), cA + kstep, voffA); G8_STAGE(G8_SB(1, 1), cB + hstep + kstep, voffB);
    G8_WAIT_V(6); G8_BAR;
    for (;;) {
        const bool has_next = S.next(ui + 1, nxt);
        const char* nA = has_next ? nxt.A : cA; const char* nB = has_next ? nxt.B : cB;
        for (int t = 0; t < nt; t += 2) {
            const bool last = (t == nt - 2);
            const char* a1 = cA + (size_t)(t + 1) * kstep;
            const char* a2 = last ? nA : cA + (size_t)(t + 2) * kstep; const char* b2 = last ? nB : cB + (size_t)(t + 2) * kstep;
            const char* a3 = a2 + kstep; const char* b3 = b2 + kstep;
            G8_LDB(B0, 0, 0); G8_LDB(B1, 0, 1); G8_SCHED; G8_LDA(At, 0, 0); G8_STAGE(G8_SA(1, 1), a1 + hstep, voffA);
            G8_WAIT_V(8); G8_WAIT_L(0); G8_BAR; G8_MMA(0, 0, At, B0); G8_MMA(0, 1, At, B1); G8_BAR; G8_SCHED;
            G8_LDA(At, 0, 1); G8_STAGE(G8_SB(0, 0), b2, voffB); G8_STAGE(G8_SB(0, 1), b2 + hstep, voffB); G8_STAGE(G8_SA(0, 0), a2, voffA);
            G8_WAIT_V(8); G8_WAIT_L(0); G8_BAR; G8_MMA(1, 0, At, B0); G8_MMA(1, 1, At, B1); G8_BAR; G8_SCHED;
            G8_LDB(B0, 1, 0); G8_LDB(B1, 1, 1); G8_SCHED; G8_LDA(At, 1, 0); G8_STAGE(G8_SA(0, 1), a2 + hstep, voffA);
            G8_WAIT_V(8); G8_WAIT_L(0); G8_BAR; G8_MMA(0, 0, At, B0); G8_MMA(0, 1, At, B1); G8_BAR; G8_SCHED;
            G8_LDA(At, 1, 1); G8_STAGE(G8_SB(1, 0), b3, voffB); G8_STAGE(G8_SB(1, 1), b3 + hstep, voffB); G8_STAGE(G8_SA(1, 0), a3, voffA);
            G8_WAIT_V(8); G8_WAIT_L(0); G8_BAR; G8_MMA(1, 0, At, B0); G8_MMA(1, 1, At, B1); G8_BAR; G8_SCHED;
        }
        if (wr == 0) G8_BAR;
        E(acc, cur, wr, wc, fr, fq);
        if (!has_next) break;
#pragma unroll
        for (int a = 0; a < 2; ++a)
#pragma unroll
            for (int b = 0; b < 2; ++b)
#pragma unroll
                for (int m = 0; m < 4; ++m)
#pragma unroll
                    for (int n = 0; n < 2; ++n) acc[a][b][m][n] = (f32x4){0.f, 0.f, 0.f, 0.f};
        cur = nxt; cA = nA; cB = nB; ++ui;
        if (wr == 1) G8_BAR;
    }
    G8_WAIT_V(0);
    G8_BAR;
#undef G8_SA
#undef G8_SB
#undef G8_STAGE
#undef G8_LDA
#undef G8_LDB
#undef G8_MMA
#undef G8_WAIT_V
#undef G8_WAIT_L
#undef G8_BAR
#undef G8_SCHED
}
}

struct Frame {
    unsigned char* lds; int tid, lane, wave, G, bid;
    const Params* pp;
    unsigned char* ws;
};
#define WSP(T, off) ((T*)(F.ws + (off)))

struct MapId { __device__ __forceinline__ int operator()(int n) const { return n; } };
struct MapGU { int half; __device__ __forceinline__ int operator()(int n) const { const int up = n >= half, j = up ? n - half : n; return 8 * (j >> 2) + 4 * up + (j & 3); } };

template <class RowMap>
__device__ __forceinline__ void xpose_tile(const float* __restrict__ W, int N, h16* __restrict__ WT, int K, int k0, int n0, float* scr, int lane, RowMap rm) {
    f32x4 v[16];
    const int r4 = lane >> 4, c4 = (lane & 15) * 4;
#pragma unroll
    for (int i = 0; i < 16; ++i) v[i] = *(const f32x4*)(W + (size_t)(k0 + i * 4 + r4) * N + n0 + c4);
#pragma unroll
    for (int i = 0; i < 16; ++i) { float* s = scr + (i * 4 + r4) * 65 + c4; s[0] = v[i].x; s[1] = v[i].y; s[2] = v[i].z; s[3] = v[i].w; }
    LDS_WAIT();
    const int c = lane & 7;
#pragma unroll
    for (int j = 0; j < 8; ++j) { const int n = (lane >> 3) + 8 * j; const float* s = scr + (8 * c) * 65 + n;
        u32x4 o; o.x = pk2(s[0], s[65]); o.y = pk2(s[130], s[195]); o.z = pk2(s[260], s[325]); o.w = pk2(s[390], s[455]);
        *(u32x4*)(WT + (size_t)rm(n0 + n) * K + k0 + 8 * c) = o; }
    LDS_WAIT();
}
template <class RowMap>
__device__ __forceinline__ void xpose_matrix(Frame& F, const float* W, int K, int N, h16* WT, RowMap rm, int& tbase) {
    const int gw = F.bid * NWAVES + F.wave, NGW = F.G * NWAVES;
    const int nkt = K / 64, nnt = N / 64, ntile = nkt * nnt;
    float* scr = (float*)(F.lds) + F.wave * (64 * 65);
    int first = gw - (tbase % NGW); if (first < 0) first += NGW;
    for (int t = first; t < ntile; t += NGW) { const int kt = t / nnt, ntt = t % nnt; xpose_tile(W, N, WT, K, kt * 64, ntt * 64, scr, F.lane, rm); }
    tbase += ntile;
}
__device__ __forceinline__ void step_pre(Frame& F) {
    const Params& p = *F.pp;
    float* modacc = (float*)(F.ws + OFF_CTL) + CW_MOD;
    for (int it = F.bid; it < 256; it += F.G) {
        const int l = it >> 7, dc = it & 127;
        float sc[8];
#pragma unroll
        for (int i = 0; i < 8; ++i) sc[i] = siluf_(p.c[dc * 8 + i]);
#pragma unroll
        for (int j = 0; j < 3; ++j) { const int col4 = F.tid + 512 * j; f32x4 a = {0.f, 0.f, 0.f, 0.f};
#pragma unroll
            for (int i = 0; i < 8; ++i) { const f32x4 w = *(const f32x4*)(p.w_ada + ((size_t)(l * 1024 + dc * 8 + i)) * 6144 + col4 * 4); a += w * sc[i]; }
            if (dc == 0) a += *(const f32x4*)(p.b_ada + l * 6144 + col4 * 4);
            float* dst = modacc + l * 6144 + col4 * 4;
            atomicAdd(dst + 0, a.x); atomicAdd(dst + 1, a.y); atomicAdd(dst + 2, a.z); atomicAdd(dst + 3, a.w); }
    }
    { f32x2* tab = WSP(f32x2, OFF_TAB);
      for (int idx = F.bid * NTHREADS + F.tid; idx < M * 8; idx += F.G * NTHREADS) { const int t = idx >> 3, i = idx & 7;
          const float fhi = i == 0 ? 1.0f : i == 1 ? 0.1939227432012558f : i == 2 ? 0.03760603070259094f : i == 3 ? 0.007292664609849453f : i == 4 ? 0.0014142135623842478f : i == 5 ? 0.00027424818836152554f : i == 6 ? 5.3182957344688475e-05f : 1.0313385246263351e-05f;
          const float flo = i == 0 ? 0.0f : i == 1 ? 1.5474299619455678e-09f : i == 2 ? 2.2827298384875405e-10f : i == 3 ? 1.2736765808707418e-10f : i == 4 ? -1.115275406748939e-14f : i == 5 ? -1.2685318073746288e-11f : i == 6 ? 1.624761414818765e-12f : 1.309491116886427e-13f;
          const float ps = (float)p.pos[t];
          const float ph = ps * fhi, pe = fmaf(ps, fhi, -ph) + ps * flo;
          const float kk = rintf(ph * 0.15915494309189535f);
          float r = fmaf(-kk, 6.2831854820251465f, ph); r = fmaf(-kk, -1.7484555314695172e-07f, r); r += pe;
          float sn, cs; sincosf(r, &sn, &cs); tab[idx] = (f32x2){(float)cs, (float)sn}; } }
    int tb = 0;
    for (int l = 0; l < 2; ++l) xpose_matrix(F, p.w_in + (size_t)l * D * INW, D, INW, WSP(h16, OFF_WT_IN) + (size_t)l * INW * D, MapId{}, tb);
    for (int l = 0; l < 2; ++l) xpose_matrix(F, p.w_out + (size_t)l * D * D, D, D, WSP(h16, OFF_WT_OUT) + (size_t)l * D * D, MapId{}, tb);
    xpose_matrix(F, p.fup, D, 2 * FFN, WSP(h16, OFF_WT_UP), MapGU{FFN}, tb);
    xpose_matrix(F, p.fdown, FFN, D, WSP(h16, OFF_WT_DOWN), MapId{}, tb);
    for (int e = 0; e < NE; ++e) xpose_matrix(F, p.mup + (size_t)e * D * 2 * EDIM, D, 2 * EDIM, WSP(h16, OFF_WT_MUP) + (size_t)e * 2 * EDIM * D, MapGU{EDIM}, tb);
    for (int e = 0; e < NE; ++e) xpose_matrix(F, p.mdown + (size_t)e * EDIM * D, EDIM, D, WSP(h16, OFF_WT_MDOWN) + (size_t)e * D * EDIM, MapId{}, tb);
}

__device__ __forceinline__ void step_h0(Frame& F) {
    const float* mod = (const float*)(F.ws + OFF_CTL) + CW_MOD;
    h16* H = WSP(h16, OFF_H);
    for (size_t i = (size_t)F.bid * NTHREADS + F.tid; i < (size_t)M * D / 8; i += (size_t)F.G * NTHREADS) {
        const int col = (int)(i & 127) * 8;
        const f32x4 a = *(const f32x4*)(F.pp->x + i * 8), b = *(const f32x4*)(F.pp->x + i * 8 + 4);
        const f32x4 sh0 = *(const f32x4*)(mod + col), sh1 = *(const f32x4*)(mod + col + 4), sc0 = *(const f32x4*)(mod + 1024 + col), sc1 = *(const f32x4*)(mod + 1024 + col + 4);
        const f32x4 r0 = a * (sc0 + 1.0f) + sh0, r1 = b * (sc1 + 1.0f) + sh1;
        u32x4 w; w.x = pk2(r0[0], r0[1]); w.y = pk2(r0[2], r0[3]); w.z = pk2(r1[0], r1[1]); w.w = pk2(r1[2], r1[3]);
        *(u32x4*)(H + i * 8) = w;
    }
}

constexpr int SSEG = 128, NSS = M / SSEG, NCH = SSEG / 16;
constexpr size_t SCR_SE = OFF_BIG, SCR_SI = OFF_BIG + 32 * MiB, SCR_LP = OFF_BIG + 64 * MiB, SCR_OA = OFF_BIG + 80 * MiB;
__device__ __forceinline__ void step_rot(Frame& F, int layer) {
    h16* P = WSP(h16, OFF_PROJ); const f32x2* tab = WSP(f32x2, OFF_TAB);
    for (int idx = F.bid * NTHREADS + F.tid; idx < M * 14; idx += F.G * NTHREADS) {
        const int t = idx / 14, hh = idx % 14;
        const int cb = hh < 4 ? PC_Q + hh * 64 : hh < 8 ? PC_K + (hh - 4) * 64 : hh < 12 ? PD_Q + (hh - 8) * 64 : PD_K + (hh - 12) * 64;
        h16* ptr = P + (size_t)t * INW + cb;
        const h16x8 x1 = *(const h16x8*)ptr, x2 = *(const h16x8*)(ptr + 8);
        h16x8 o1, o2;
#pragma unroll
        for (int i = 0; i < 8; ++i) { const f32x2 cs = tab[t * 8 + i]; const float a = (float)x1[i], b = (float)x2[i]; o1[i] = (h16)(a * cs.x - b * cs.y); o2[i] = (h16)(b * cs.x + a * cs.y); }
        *(h16x8*)ptr = o1; *(h16x8*)(ptr + 8) = o2;
    }
}

template <int N> __device__ __forceinline__ float row_shr(float v) { return __builtin_bit_cast(float, __builtin_amdgcn_update_dpp(0, __builtin_bit_cast(int, v), 0x110 | N, 0xF, 0xF, true)); }
__device__ __forceinline__ float row_scan16(float v) { v += row_shr<1>(v); v += row_shr<2>(v); v += row_shr<4>(v); v += row_shr<8>(v); return v; }
__device__ __forceinline__ h16x4 cvt4(const f32x4 v) { h16x4 r; r[0] = (h16)v[0]; r[1] = (h16)v[1]; r[2] = (h16)v[2]; r[3] = (h16)v[3]; return r; }
#define MFMA16(a, b, c) __builtin_amdgcn_mfma_f32_16x16x16f16((a), (b), (c), 0, 0, 0)
template <bool FULL>
__device__ __forceinline__ void hg_chunk(const h16* __restrict__ P, const int h, const int dir, const int c0, const int lane, const float (&lb)[4][4], f32x4 (&S)[4][4], float (&lp)[4][4], float* __restrict__ OAdir, const h16x4 ident) {
    const int tau = lane & 15, g = lane >> 4;
    const h16* row = P + (size_t)(c0 + (dir ? 15 - tau : tau)) * INW + h * 64 + 4 * g;
    h16x4 zr[4], qr[4], vr[4];
#pragma unroll
    for (int kt = 0; kt < 4; ++kt) { zr[kt] = *(const h16x4*)(row + (dir ? PA_FB : PA_FF) + 16 * kt); vr[kt] = *(const h16x4*)(row + PA_I + 16 * kt); if (FULL) qr[kt] = *(const h16x4*)(row + PA_Q + 16 * kt); }
    float cum[4][4], kkv[4][4], tot[4][4];
#pragma unroll
    for (int kt = 0; kt < 4; ++kt)
#pragma unroll
        for (int j = 0; j < 4; ++j) { const float z = (float)zr[kt][j]; const float e = __expf(-fabsf(z)), r = 1.0f / (1.0f + e); const float sg = z >= 0.f ? r : e * r, nsg = z >= 0.f ? e * r : r;
            const float oml = 1.0f - lb[kt][j]; cum[kt][j] = row_scan16(__logf(lb[kt][j] + oml * sg)); kkv[kt][j] = oml * nsg; }
#pragma unroll
    for (int kt = 0; kt < 4; ++kt)
#pragma unroll
        for (int j = 0; j < 4; ++j) tot[kt][j] = __shfl(cum[kt][j], (lane & 48) | 15);
    const f32x4 zero4 = {0.f, 0.f, 0.f, 0.f};
    h16x4 KT[4], VT[4];
#pragma unroll
    for (int kt = 0; kt < 4; ++kt) { h16x4 kh;
#pragma unroll
        for (int j = 0; j < 4; ++j) kh[j] = (h16)(kkv[kt][j] * __expf(tot[kt][j] - cum[kt][j]));
        KT[kt] = cvt4(MFMA16(kh, ident, zero4)); VT[kt] = cvt4(MFMA16(vr[kt], ident, zero4)); }
    if (FULL) {
        f32x4 sc = zero4; h16x4 QA[4];
#pragma unroll
        for (int kt = 0; kt < 4; ++kt)
#pragma unroll
            for (int j = 0; j < 4; ++j) { const float ref = __shfl(cum[kt][j], (lane & 48) | 7); const float qs = siluf_((float)qr[kt][j]);
                QA[kt][j] = (h16)(qs * __expf(cum[kt][j]));
                sc = __builtin_amdgcn_mfma_f32_16x16x4f32(kkv[kt][j] * __expf(ref - cum[kt][j]), qs * __expf(cum[kt][j] - ref), sc, 0, 0, 0); }
        h16x4 AA;
#pragma unroll
        for (int j = 0; j < 4; ++j) AA[j] = (h16)((4 * g + j <= tau) ? sc[j] : 0.f);
#pragma unroll
        for (int dt = 0; dt < 4; ++dt) { f32x4 o = MFMA16(AA, VT[dt], zero4);
#pragma unroll
            for (int kt = 0; kt < 4; ++kt) o = MFMA16(QA[kt], cvt4(S[kt][dt]), o);
#pragma unroll
            for (int j = 0; j < 4; ++j) { const int to = 4 * g + j; OAdir[(size_t)(c0 + (dir ? 15 - to : to)) * 256 + h * 64 + 16 * dt + tau] = o[j]; } }
    }
#pragma unroll
    for (int kt = 0; kt < 4; ++kt) { float dec[4];
#pragma unroll
        for (int j = 0; j < 4; ++j) { dec[j] = __expf(tot[kt][j]); lp[kt][j] += tot[kt][j]; }
#pragma unroll
        for (int dt = 0; dt < 4; ++dt) { f32x4 sv = S[kt][dt]; sv[0] *= dec[0]; sv[1] *= dec[1]; sv[2] *= dec[2]; sv[3] *= dec[3]; S[kt][dt] = MFMA16(KT[kt], VT[dt], sv); } }
}
__device__ __forceinline__ void hg_setup(const Frame& F, int layer, int h, float (&lb)[4][4], h16x4& ident) {
    const int tau = F.lane & 15, g = F.lane >> 4;
#pragma unroll
    for (int kt = 0; kt < 4; ++kt)
#pragma unroll
        for (int j = 0; j < 4; ++j) { const int c = h * 64 + 16 * kt + 4 * g + j; lb[kt][j] = (layer == 0 ? 0.f : 1.f) * sigmoidf_(F.pp->alb[256 + c] - F.pp->alb[c]); }
#pragma unroll
    for (int j = 0; j < 4; ++j) ident[j] = (h16)((4 * g + j == tau) ? 1.0f : 0.0f);
}
__device__ __forceinline__ void hg_pass1(Frame& F, int layer) {
    const int gw = F.bid * NWAVES + F.wave, NGW = F.G * NWAVES; const int tau = F.lane & 15, g = F.lane >> 4;
    const h16* P = WSP(h16, OFF_PROJ); float* SE = WSP(float, SCR_SE); float* LP = WSP(float, SCR_LP);
    for (int it = gw; it < 8 * NSS; it += NGW) { const int ss = it % NSS, hd = it / NSS, dir = hd & 1, h = hd >> 1;
        float lb[4][4], lp[4][4]; h16x4 ident; f32x4 S[4][4]; hg_setup(F, layer, h, lb, ident);
#pragma unroll
        for (int kt = 0; kt < 4; ++kt)
#pragma unroll
            for (int j = 0; j < 4; ++j) { lp[kt][j] = 0.f; S[kt][j] = (f32x4){0.f, 0.f, 0.f, 0.f}; }
#pragma unroll 1
        for (int ci = 0; ci < NCH; ++ci) hg_chunk<false>(P, h, dir, ss * SSEG + (dir ? NCH - 1 - ci : ci) * 16, F.lane, lb, S, lp, nullptr, ident);
        int l2 = F.lane; asm volatile("" : "+v"(l2));
        float* se = SE + (size_t)it * 4096 + (4 * (l2 >> 4)) * 64 + (l2 & 15);
#pragma unroll
        for (int kt = 0; kt < 4; ++kt)
#pragma unroll
            for (int j = 0; j < 4; ++j) {
#pragma unroll
                for (int dt = 0; dt < 4; ++dt) se[(16 * kt + j) * 64 + 16 * dt] = S[kt][dt][j]; }
        if ((l2 & 15) == 0) {
#pragma unroll
            for (int kt = 0; kt < 4; ++kt)
#pragma unroll
                for (int j = 0; j < 4; ++j) LP[(size_t)it * 64 + 16 * kt + 4 * (l2 >> 4) + j] = lp[kt][j]; }
    }
}
__device__ __forceinline__ void step_hg2(Frame& F) {
    const float* SE = WSP(float, SCR_SE); const float* LP = WSP(float, SCR_LP); float* SI = WSP(float, SCR_SI);
    for (int e = F.bid * NTHREADS + F.tid; e < 8 * 4096; e += F.G * NTHREADS) { const int hd = e >> 12, cd = e & 4095, c = cd >> 6, dir = hd & 1;
        float st = 0.f;
        for (int n0 = 0; n0 < NSS; n0 += 8) { float se[8], lpv[8];
#pragma unroll
            for (int u = 0; u < 8; ++u) { const int n = dir ? NSS - 1 - (n0 + u) : n0 + u; se[u] = SE[((size_t)hd * NSS + n) * 4096 + cd]; lpv[u] = LP[((size_t)hd * NSS + n) * 64 + c]; }
#pragma unroll
            for (int u = 0; u < 8; ++u) { const int n = dir ? NSS - 1 - (n0 + u) : n0 + u; SI[((size_t)hd * NSS + n) * 4096 + cd] = st; st = __expf(lpv[u]) * st + se[u]; } }
    }
}
__device__ __forceinline__ void step_hg3(Frame& F, int layer) {
    const int gw = F.bid * NWAVES + F.wave, NGW = F.G * NWAVES; const int tau = F.lane & 15, g = F.lane >> 4;
    const h16* P = WSP(h16, OFF_PROJ); const float* SI = WSP(float, SCR_SI);
    for (int it = gw; it < 8 * NSS; it += NGW) { const int ss = it % NSS, hd = it / NSS, dir = hd & 1, h = hd >> 1;
        float lb[4][4], lp[4][4]; h16x4 ident; f32x4 S[4][4]; hg_setup(F, layer, h, lb, ident);
        const float* si = SI + (size_t)it * 4096 + (4 * g) * 64 + tau;
#pragma unroll
        for (int kt = 0; kt < 4; ++kt)
#pragma unroll
            for (int dt = 0; dt < 4; ++dt) {
#pragma unroll
                for (int j = 0; j < 4; ++j) S[kt][dt][j] = si[(16 * kt + j) * 64 + 16 * dt];
                lp[kt][dt] = 0.f; }
        float* OAdir = WSP(float, SCR_OA) + (size_t)dir * M * 256;
#pragma unroll 1
        for (int ci = 0; ci < NCH; ++ci) hg_chunk<true>(P, h, dir, ss * SSEG + (dir ? NCH - 1 - ci : ci) * 16, F.lane, lb, S, lp, OAdir, ident);
    }
}
__device__ __forceinline__ void conv_item(Frame& F, int item, int layer) {
    const Params& p = *F.pp;
    float* U = (float*)F.lds;
    float* Yt = U + 62 * 256;
    const h16* P = WSP(h16, OFF_PROJ);
    const int t0 = item * 32;
    for (int i = F.tid; i < 62 * 256; i += NTHREADS) { const int r = i >> 8, c = i & 255, t = t0 - 15 + r; float u = 0.f;
        if (t >= 0 && t < M) { const h16* row = P + (size_t)t * INW; u = (float)row[PB_V + c] * sigmoidf_((float)row[PB_G + c]); }
        U[i] = u; }
    __syncthreads();
    { const int c = F.tid & 255, tg = F.tid >> 8;
      float w[31];
#pragma unroll
      for (int j = 0; j < 31; ++j) w[j] = p.cw[(size_t)layer * 31 * 256 + j * 256 + c];
      const float bias = p.cb[layer * 256 + c];
      for (int tt = tg * 16; tt < tg * 16 + 16; ++tt) { float a = bias;
#pragma unroll
          for (int j = 0; j < 31; ++j) a += w[j] * U[(tt + j) * 256 + c];
          Yt[tt * 256 + c] = a; } }
    __syncthreads();
    { h16* Y = WSP(h16, OFF_Y);
      for (int r = F.wave * 4; r < F.wave * 4 + 4; ++r) {
          const f32x4 v = *(const f32x4*)(Yt + r * 256 + F.lane * 4);
          const float mean = wave_sum((v.x + v.y) + (v.z + v.w)) * (1.f / 256.f);
          const f32x4 d = v - mean;
          const float var = wave_sum((d.x * d.x + d.y * d.y) + (d.z * d.z + d.w * d.w)) * (1.f / 256.f);
          const float rstd = 1.0f / sqrtf(var + LN_EPS);
          const f32x4 nw = *(const f32x4*)(p.cnw + layer * 256 + F.lane * 4), nb = *(const f32x4*)(p.cnb + layer * 256 + F.lane * 4);
          const f32x4 o = d * rstd * nw + nb;
          u32x2 w2; w2.x = pk2(siluf_(o.x), siluf_(o.y)); w2.y = pk2(siluf_(o.z), siluf_(o.w));
          *(u32x2*)(Y + (size_t)(t0 + r) * D + 256 + F.lane * 4) = w2; } }
    __syncthreads();
}
#define ATT_KEY(sidx) do { const int s_ = (sidx); if (s_ >= 0 && s_ < M) { const h16* kr = Pk + (size_t)s_ * INW; const h16* vr = Pv + (size_t)s_ * INW; float sc = 0.f; \
    _Pragma("unroll") for (int c8 = 0; c8 < 8; ++c8) { const h16x8 kk = *(const h16x8*)(kr + 8 * c8); _Pragma("unroll") for (int e = 0; e < 4; ++e) sc = __builtin_amdgcn_fdot2((h16x2){qv[c8][2 * e], qv[c8][2 * e + 1]}, (h16x2){kk[2 * e], kk[2 * e + 1]}, sc, false); } \
    const float mn = fmaxf(m, sc), corr = __expf(m - mn), pw = __expf(sc - mn); l = l * corr + pw; m = mn; \
    _Pragma("unroll") for (int c8 = 0; c8 < 8; ++c8) { const h16x8 vv = *(const h16x8*)(vr + 8 * c8); _Pragma("unroll") for (int e = 0; e < 8; ++e) acc[8 * c8 + e] = acc[8 * c8 + e] * corr + pw * (float)vv[e]; } } } while (0)
__device__ __forceinline__ void attn_naive_item(Frame& F, int item, int layer, int which  ) {
    const int idx = item * NTHREADS + F.tid; const int h = idx >> 14, t = idx & (M - 1);
    const h16* P = WSP(h16, OFF_PROJ);
    const h16* Pq = P + (size_t)t * INW + (which ? PD_Q : PC_Q) + h * 64;
    const h16* Pk = P + (which ? PD_K + (h >> 1) * 64 : PC_K + h * 64);
    const h16* Pv = P + (which ? PD_V + (h >> 1) * 64 : PC_V + h * 64);
    h16x8 qv[8]; float acc[64]; float m = -1e30f, l = 0.f;
#pragma unroll
    for (int c8 = 0; c8 < 8; ++c8) { qv[c8] = *(const h16x8*)(Pq + 8 * c8) * (h16)0.125f;
#pragma unroll
        for (int e = 0; e < 8; ++e) acc[8 * c8 + e] = 0.f; }
    h16* Y = WSP(h16, OFF_Y) + (size_t)t * D + (which ? 768 : 512) + h * 64;
    float scale;
    if (which == 0) {
        for (int j = -64; j <= 64; ++j) ATT_KEY(t + j);
        for (int j = -64; j <= 64; ++j) ATT_KEY(t + 4 * j);
        for (int j = -64; j <= 64; ++j) ATT_KEY(t + 16 * j);
        scale = 1.0f / l;
    } else {
        for (int j = -128; j <= 128; ++j) ATT_KEY(t + j);
        const float sk = F.pp->sink[layer * 4 + h]; const float mt = fmaxf(m, sk), w = __expf(m - mt), den = l * w + __expf(sk - mt);
        scale = w / den;
    }
#pragma unroll
    for (int c8 = 0; c8 < 8; ++c8) { u32x4 w; w.x = pk2(acc[8 * c8] * scale, acc[8 * c8 + 1] * scale); w.y = pk2(acc[8 * c8 + 2] * scale, acc[8 * c8 + 3] * scale);
        w.z = pk2(acc[8 * c8 + 4] * scale, acc[8 * c8 + 5] * scale); w.w = pk2(acc[8 * c8 + 6] * scale, acc[8 * c8 + 7] * scale); *(u32x4*)(Y + 8 * c8) = w; }
}
__device__ __forceinline__ void step_mix(Frame& F, int layer) {
    constexpr int N_CONV = M / 32, N_AT = M * 4 / NTHREADS;
    hg_pass1(F, layer);
    for (int it = F.bid; it < N_CONV + 2 * N_AT; it += F.G) {
        if (it < N_CONV) conv_item(F, it, layer);
        else if (it < N_CONV + N_AT) attn_naive_item(F, it - N_CONV, layer, 0);
        else attn_naive_item(F, it - N_CONV - N_AT, layer, 1);
    }
}
__device__ __forceinline__ void step_afin(Frame& F, int layer) {
    const float* OA = WSP(float, SCR_OA); const h16* P = WSP(h16, OFF_PROJ); h16* Y = WSP(h16, OFF_Y);
    const int gw = F.bid * NWAVES + F.wave, NGW = F.G * NWAVES;
    const float nw = F.pp->anw[layer * 64 + F.lane];
    for (int it = gw; it < M * 4; it += NGW) { const int t = it >> 2, h = it & 3;
        const float o = OA[(size_t)t * 256 + h * 64 + F.lane] + OA[(size_t)M * 256 + (size_t)t * 256 + h * 64 + F.lane];
        const float ms = wave_sum(o * o) * (1.f / 64.f);
        const float g = (float)P[(size_t)t * INW + PA_G + h * 64 + F.lane];
        Y[(size_t)t * D + h * 64 + F.lane] = (h16)(o * (1.0f / sqrtf(ms + RMS_EPS)) * nw * siluf_(g)); }
}

struct LnArgs { const float* xin; const float* gate; const float* lw; const float* lb; const float* nscale; const float* nshift; float* xout; h16* hout; };
__device__ __forceinline__ void ln_core(const Frame& F, const LnArgs& a, int row, const f32x4 (&fv)[4], f32x4 (&hv)[4]) {
    f32x4 tv[4]; float s = 0.f;
#pragma unroll
    for (int j = 0; j < 4; ++j) { const int col = F.lane * 4 + 256 * j; const f32x4 xi = *(const f32x4*)(a.xin + (size_t)row * D + col), g = *(const f32x4*)(a.gate + col);
        tv[j] = xi * ALPHA + (g + 1.0f) * fv[j]; s += (tv[j].x + tv[j].y) + (tv[j].z + tv[j].w); }
    const float mean = wave_sum(s) * (1.f / D); float s2 = 0.f;
#pragma unroll
    for (int j = 0; j < 4; ++j) { tv[j] = tv[j] - mean; s2 += (tv[j].x * tv[j].x + tv[j].y * tv[j].y) + (tv[j].z * tv[j].z + tv[j].w * tv[j].w); }
    const float rstd = 1.0f / sqrtf(wave_sum(s2) * (1.f / D) + LN_EPS);
#pragma unroll
    for (int j = 0; j < 4; ++j) { const int col = F.lane * 4 + 256 * j; const f32x4 w = *(const f32x4*)(a.lw + col), b = *(const f32x4*)(a.lb + col);
        const f32x4 xo = tv[j] * rstd * w + b;
        *(f32x4*)(a.xout + (size_t)row * D + col) = xo;
        if (a.hout) { const f32x4 sc = *(const f32x4*)(a.nscale + col), sh = *(const f32x4*)(a.nshift + col); hv[j] = xo * (sc + 1.0f) + sh;
            u32x2 w2; w2.x = pk2(hv[j].x, hv[j].y); w2.y = pk2(hv[j].z, hv[j].w); *(u32x2*)(a.hout + (size_t)row * D + col) = w2; } }
}
__device__ __forceinline__ void step_ln_dense(Frame& F, const LnArgs& a, const float* Z, bool router) {
    const int gw = F.bid * NWAVES + F.wave, NGW = F.G * NWAVES;
    unsigned* cnt = (unsigned*)(F.ws + OFF_CTL) + CW_CNT; unsigned* tok = WSP(unsigned, OFF_TOK);
    for (int row = gw; row < M; row += NGW) {
        f32x4 fv[4], hv[4];
#pragma unroll
        for (int j = 0; j < 4; ++j) fv[j] = *(const f32x4*)(Z + (size_t)row * D + F.lane * 4 + 256 * j);
        ln_core(F, a, row, fv, hv);
        if (router) {
            float lg[8];
#pragma unroll
            for (int e = 0; e < 8; ++e) lg[e] = 0.f;
#pragma unroll
            for (int j = 0; j < 4; ++j)
#pragma unroll
                for (int i = 0; i < 4; ++i) { const int col = F.lane * 4 + 256 * j + i; const f32x4 w0 = *(const f32x4*)(F.pp->rout + (size_t)col * 8), w1 = *(const f32x4*)(F.pp->rout + (size_t)col * 8 + 4); const float hval = hv[j][i];
                    lg[0] += hval * w0.x; lg[1] += hval * w0.y; lg[2] += hval * w0.z; lg[3] += hval * w0.w; lg[4] += hval * w1.x; lg[5] += hval * w1.y; lg[6] += hval * w1.z; lg[7] += hval * w1.w; }
#pragma unroll
            for (int e = 0; e < 8; ++e) lg[e] = wave_sum(lg[e]);
            int e1 = 0; float l1 = lg[0];
#pragma unroll
            for (int e = 1; e < 8; ++e) if (lg[e] > l1) { l1 = lg[e]; e1 = e; }
            int e2 = -1; float l2 = -3.0e38f;
#pragma unroll
            for (int e = 0; e < 8; ++e) if (e != e1 && lg[e] > l2) { l2 = lg[e]; e2 = e; }
            const float g1 = 1.0f / (1.0f + __expf(l2 - l1)), g2 = 1.0f - g1;
            if (F.lane == 0) { tok[row * 8 + 0] = (unsigned)e1; tok[row * 8 + 1] = (unsigned)e2; tok[row * 8 + 2] = __float_as_uint(g1); tok[row * 8 + 3] = __float_as_uint(g2);
                atomicAdd(cnt + e1, 1u); atomicAdd(cnt + e2, 1u); }
        }
    }
}
__device__ __forceinline__ void step_slot(Frame& F) {
    const unsigned* cnt = (const unsigned*)(F.ws + OFF_CTL) + CW_CNT; unsigned* cur = (unsigned*)(F.ws + OFF_CTL) + CW_CUR; unsigned* tok = WSP(unsigned, OFF_TOK);
    const h16* H = WSP(h16, OFF_H); h16* HG = WSP(h16, OFF_PROJ);
    unsigned off[8]; { unsigned o = 0;
#pragma unroll
        for (int e = 0; e < 8; ++e) { off[e] = o; o += ((cnt[e] + 255u) >> 8) << 8; } }
    const int gw = F.bid * NWAVES + F.wave, NGW = F.G * NWAVES;
    for (int row = gw; row < M; row += NGW) {
        const unsigned e1 = tok[row * 8 + 0], e2 = tok[row * 8 + 1];
        unsigned s1 = 0, s2 = 0;
        if (F.lane == 0) {
            unsigned o1 = 0, o2 = 0;
#pragma unroll
            for (int e = 0; e < 8; ++e) { o1 = (e1 == (unsigned)e) ? off[e] : o1; o2 = (e2 == (unsigned)e) ? off[e] : o2; }
            s1 = o1 + atomicAdd(cur + e1, 1u); s2 = o2 + atomicAdd(cur + e2, 1u); tok[row * 8 + 4] = s1; tok[row * 8 + 5] = s2; }
        s1 = __shfl(s1, 0); s2 = __shfl(s2, 0);
        const u32x4 a = *(const u32x4*)(H + (size_t)row * D + F.lane * 8), b = *(const u32x4*)(H + (size_t)row * D + 512 + F.lane * 8);
        *(u32x4*)(HG + (size_t)s1 * D + F.lane * 8) = a; *(u32x4*)(HG + (size_t)s1 * D + 512 + F.lane * 8) = b;
        *(u32x4*)(HG + (size_t)s2 * D + F.lane * 8) = a; *(u32x4*)(HG + (size_t)s2 * D + 512 + F.lane * 8) = b;
    }
}
__device__ __forceinline__ void step_ln_moe(Frame& F, const LnArgs& a) {
    const int gw = F.bid * NWAVES + F.wave, NGW = F.G * NWAVES;
    const unsigned* tok = WSP(unsigned, OFF_TOK); const float* YS = WSP(float, OFF_PROJ);
    for (int row = gw; row < M; row += NGW) {
        const float g1 = __uint_as_float(tok[row * 8 + 2]), g2 = __uint_as_float(tok[row * 8 + 3]); const unsigned s1 = tok[row * 8 + 4], s2 = tok[row * 8 + 5];
        f32x4 fv[4], hv[4];
#pragma unroll
        for (int j = 0; j < 4; ++j) { const int col = F.lane * 4 + 256 * j; fv[j] = *(const f32x4*)(YS + (size_t)s1 * D + col) * g1 + *(const f32x4*)(YS + (size_t)s2 * D + col) * g2; }
        ln_core(F, a, row, fv, hv);
    }
}

constexpr int N_STEPS = 25;
#ifndef KMASK
#define KMASK 0xFFFFF
#endif
#define KON(k) ((KMASK >> (k)) & 1)
__global__ void __launch_bounds__(NTHREADS, 2) fwd_kernel(Params kp) {
    extern __shared__ __attribute__((aligned(16))) unsigned char lds[];
    Frame F; F.lds = lds; F.tid = threadIdx.x; F.lane = F.tid & 63; F.wave = __builtin_amdgcn_readfirstlane(F.tid >> 6); F.G = gridDim.x; F.bid = blockIdx.x; F.ws = kp.ws;
    LAS unsigned char* ldsl = (LAS unsigned char*)lds;
    const int lo = kp.lo, hi = kp.hi;
    for (int s = lo; s < hi; ++s) {
        { const Params* pp_ = (const Params*)__builtin_amdgcn_kernarg_segment_ptr(); asm volatile("" : "+s"(pp_) :: "memory"); F.pp = pp_; unsigned char* ws_ = kp.ws; asm volatile("" : "+s"(ws_)); F.ws = ws_; }
        const Params& p = *F.pp;
        { int tid_ = threadIdx.x; asm volatile("" : "+v"(tid_)); F.tid = tid_; F.lane = tid_ & 63; F.wave = __builtin_amdgcn_readfirstlane(tid_ >> 6); }
        int layer = 0, kind = s;
        if (s >= 13) { layer = 1; kind = s - 11; }
        const float* mod = (const float*)(F.ws + OFF_CTL) + CW_MOD;
        const float* modl = mod + layer * 6144;
        if (KON(0) && s == 0) step_pre(F);
        else if (KON(1) && s == 1) step_h0(F);
        else if (KON(2) && kind == 2) { g8::DenseOrder S; S.init(WSP(h16, OFF_H), WSP(h16, OFF_WT_IN) + (size_t)layer * INW * D, M, INW, D, F.G, F.bid); g8::EpiF16 E{WSP(h16, OFF_PROJ), INW}; g8::gemm_phase(ldsl, F.tid, D, S, E); }
        else if (KON(3) && kind == 3) step_rot(F, layer);
        else if (KON(4) && kind == 4) step_mix(F, layer);
        else if (KON(5) && kind == 5) step_hg2(F);
        else if (KON(6) && kind == 6) step_hg3(F, layer);
        else if (KON(7) && kind == 7) step_afin(F, layer);
        else if (KON(8) && kind == 8) { g8::DenseOrder S; S.init(WSP(h16, OFF_Y), WSP(h16, OFF_WT_OUT) + (size_t)layer * D * D, M, D, D, F.G, F.bid); g8::EpiF32 E{WSP(float, OFF_Z), D}; g8::gemm_phase(ldsl, F.tid, D, S, E); }
        else if (KON(9) && kind == 9) { LnArgs a{layer == 0 ? p.x : WSP(float, OFF_X), modl + 2048, p.lnw + (size_t)(layer * 2) * D, p.lnb + (size_t)(layer * 2) * D, modl + 4096, modl + 3072, WSP(float, OFF_X), WSP(h16, OFF_H)};
            step_ln_dense(F, a, WSP(float, OFF_Z), layer == 1); }
        else if (KON(10) && layer == 0 && kind == 10) { g8::DenseOrder S; S.init(WSP(h16, OFF_H), WSP(h16, OFF_WT_UP), M, 2 * FFN, D, F.G, F.bid); g8::EpiSwiGLU E{WSP(h16, OFF_PROJ), FFN}; g8::gemm_phase(ldsl, F.tid, D, S, E); }
        else if (KON(11) && layer == 0 && kind == 11) { g8::DenseOrder S; S.init(WSP(h16, OFF_PROJ), WSP(h16, OFF_WT_DOWN), M, D, FFN, F.G, F.bid); g8::EpiF32 E{WSP(float, OFF_Z), D}; g8::gemm_phase(ldsl, F.tid, FFN, S, E); }
        else if (KON(12) && layer == 0 && kind == 12) { LnArgs a{WSP(float, OFF_X), modl + 5120, p.lnw + (size_t)1 * D, p.lnb + (size_t)1 * D, mod + 6144 + 1024, mod + 6144 + 0, WSP(float, OFF_X), WSP(h16, OFF_H)};
            step_ln_dense(F, a, WSP(float, OFF_Z), false); }
        else if (KON(13) && layer == 1 && kind == 10) step_slot(F);
        else if (KON(14) && layer == 1 && kind == 11) { g8::MoeOrder S; S.init(WSP(h16, OFF_PROJ), WSP(h16, OFF_WT_MUP), (size_t)2 * EDIM * D * 2, 2 * EDIM, D, F.G, F.bid, (const unsigned*)(F.ws + OFF_CTL) + CW_CNT);
            g8::EpiSwiGLU E{WSP(h16, OFF_BIG), EDIM}; g8::gemm_phase(ldsl, F.tid, D, S, E); }
        else if (KON(15) && layer == 1 && kind == 12) { g8::MoeOrder S; S.init(WSP(h16, OFF_BIG), WSP(h16, OFF_WT_MDOWN), (size_t)D * EDIM * 2, D, EDIM, F.G, F.bid, (const unsigned*)(F.ws + OFF_CTL) + CW_CNT);
            g8::EpiF32 E{WSP(float, OFF_PROJ), D}; g8::gemm_phase(ldsl, F.tid, EDIM, S, E); }
        else if (KON(16) && layer == 1 && kind == 13) { LnArgs a{WSP(float, OFF_X), modl + 5120, p.lnw + (size_t)3 * D, p.lnb + (size_t)3 * D, nullptr, nullptr, p.out, nullptr}; step_ln_moe(F, a); }
        if (s + 1 < hi) { cg::this_grid().sync(); }
    }
}

extern "C" void kernel_launch(void* const* d_in, const int* in_sizes, int n_in, void* d_out, int out_size, void* d_ws, size_t ws_size, hipStream_t stream) {
    static int grid = 0;
    if (grid == 0) {
        if (n_in != 21 || in_sizes[0] != M * D || out_size != M * D || ws_size < OFF_END) { fprintf(stderr, "kernel_launch: unexpected shapes / workspace (%d inputs, ws %zu, need %zu)\n", n_in, ws_size, (size_t)OFF_END); grid = -1; return; }
        int dev = 0, cus = 0, per_cu = 0;
        hipGetDevice(&dev); hipDeviceGetAttribute(&cus, hipDeviceAttributeMultiprocessorCount, dev);
        hipFuncSetAttribute((const void*)fwd_kernel, hipFuncAttributeMaxDynamicSharedMemorySize, LDS_BYTES);
        hipOccupancyMaxActiveBlocksPerMultiprocessor(&per_cu, (const void*)fwd_kernel, NTHREADS, LDS_BYTES);
        if (per_cu < 1) { fprintf(stderr, "kernel_launch: occupancy query says %d blocks per CU\n", per_cu); per_cu = 1; }
        grid = cus * 1;
        fprintf(stderr, "kernel_launch: grid %d (cus %d, per_cu %d), ws %zu\n", grid, cus, per_cu, ws_size);
    }
    if (grid < 0) return;
    hipMemsetAsync((char*)d_ws + OFF_CTL, 0, CTL_BYTES, stream);
    Params p{};
    p.x = (const float*)d_in[0]; p.c = (const float*)d_in[1]; p.pos = (const int*)d_in[2]; p.w_ada = (const float*)d_in[3]; p.b_ada = (const float*)d_in[4];
    p.w_in = (const float*)d_in[5]; p.w_out = (const float*)d_in[6]; p.alb = (const float*)d_in[7]; p.anw = (const float*)d_in[8]; p.cw = (const float*)d_in[9];
    p.cb = (const float*)d_in[10]; p.cnw = (const float*)d_in[11]; p.cnb = (const float*)d_in[12]; p.sink = (const float*)d_in[13]; p.lnw = (const float*)d_in[14];
    p.lnb = (const float*)d_in[15]; p.fup = (const float*)d_in[16]; p.fdown = (const float*)d_in[17]; p.rout = (const float*)d_in[18]; p.mup = (const float*)d_in[19];
    p.mdown = (const float*)d_in[20]; p.out = (float*)d_out; p.ws = (unsigned char*)d_ws;
#if MK_ONE_LAUNCH
    p.lo = 0; p.hi = N_STEPS;
    { void* args[] = {&p}; hipError_t e = hipLaunchCooperativeKernel((const void*)fwd_kernel, dim3(grid), dim3(NTHREADS), args, LDS_BYTES, stream);
      if (e != hipSuccess) fprintf(stderr, "cooperative launch failed: %s\n", hipGetErrorString(e)); }
#else
    for (int s = 0; s < N_STEPS; ++s) { p.lo = s; p.hi = s + 1;
        void* args[] = {&p}; hipError_t e = hipLaunchCooperativeKernel((const void*)fwd_kernel, dim3(grid), dim3(NTHREADS), args, LDS_BYTES, stream);
        if (e != hipSuccess) { fprintf(stderr, "launch %d failed: %s\n", s, hipGetErrorString(e)); break; } }
#endif
}
```

```cpp
#include <hip/hip_runtime.h>
#include <hip/hip_cooperative_groups.h>
#include <cstdio>
#include <cstdint>
namespace cg = cooperative_groups;

#ifndef ATT_NAIVE
#define ATT_NAIVE 0
#endif
#ifndef MK_ONE_LAUNCH
#define MK_ONE_LAUNCH 1
#endif

#define LAS __attribute__((address_space(3)))
typedef _Float16 h16;
typedef h16 h16x8 __attribute__((ext_vector_type(8)));
typedef h16 h16x4 __attribute__((ext_vector_type(4)));
typedef h16 h16x2 __attribute__((ext_vector_type(2)));
typedef float f32x4 __attribute__((ext_vector_type(4)));
typedef float f32x2 __attribute__((ext_vector_type(2)));
typedef unsigned u32x4 __attribute__((ext_vector_type(4)));
typedef unsigned u32x2 __attribute__((ext_vector_type(2)));

constexpr int M = 16384, D = 1024, INW = 3072, FFN = 2816, NE = 8, EDIM = 3584;
constexpr int MOE_ROWS = 2 * M + NE * 256;
constexpr float ALPHA = 1.41421356237309515f;
constexpr float LN_EPS = 1e-5f, RMS_EPS = 1e-6f;
constexpr int NTHREADS = 512, NWAVES = 8;
constexpr int LDS_BYTES = 139264;

constexpr int PA_Q = 0, PA_FF = 256, PA_FB = 512, PA_I = 768, PA_G = 1024, PB_V = 1280, PB_G = 1536;
constexpr int PC_Q = 1792, PC_K = 2048, PC_V = 2304, PD_Q = 2560, PD_K = 2816, PD_V = 2944;

constexpr size_t MiB = 1u << 20;
constexpr size_t OFF_CTL = 0, CTL_BYTES = 1 * MiB;
constexpr size_t OFF_TAB = 1 * MiB;
constexpr size_t OFF_TOK = 2 * MiB;
constexpr size_t OFF_WT_IN = 4 * MiB;
constexpr size_t OFF_WT_OUT = 16 * MiB;
constexpr size_t OFF_WT_UP = 20 * MiB;
constexpr size_t OFF_WT_DOWN = 31 * MiB;
constexpr size_t OFF_WT_MUP = 37 * MiB;
constexpr size_t OFF_WT_MDOWN = 149 * MiB;
constexpr size_t OFF_X = 205 * MiB;
constexpr size_t OFF_H = 269 * MiB;
constexpr size_t OFF_Y = 301 * MiB;
constexpr size_t OFF_Z = 333 * MiB;
constexpr size_t OFF_PROJ = 397 * MiB;
constexpr size_t OFF_BIG = 533 * MiB;
constexpr size_t OFF_END = 775 * MiB;
constexpr int CW_MOD = 1024;
constexpr int CW_CNT = 64;
constexpr int CW_CUR = 128;

struct Params {
    const float* x; const float* c; const int* pos; const float* w_ada; const float* b_ada; const float* w_in; const float* w_out;
    const float* alb; const float* anw; const float* cw; const float* cb; const float* cnw; const float* cnb; const float* sink;
    const float* lnw; const float* lnb; const float* fup; const float* fdown; const float* rout; const float* mup; const float* mdown;
    float* out; unsigned char* ws; int lo, hi;
};

__device__ __forceinline__ unsigned pk2(float lo, float hi) { h16x2 v; v.x = (h16)lo; v.y = (h16)hi; return __builtin_bit_cast(unsigned, v); }
__device__ __forceinline__ float sigmoidf_(float v) { return 1.0f / (1.0f + __expf(-v)); }
__device__ __forceinline__ float siluf_(float v) { return v / (1.0f + __expf(-v)); }
__device__ __forceinline__ float wave_sum(float v) {
#pragma unroll
    for (int o = 1; o < 64; o <<= 1) v += __shfl_xor(v, o);
    return v;
}
#define LDS_WAIT() asm volatile("s_waitcnt lgkmcnt(0)" ::: "memory")

namespace g8 {
constexpr int BM = 256, BK = 64, HALF = 128, HTB = HALF * BK * 2, STAGE_BYTES = 8 * HTB, NXCD = 8, WGM = 8;
__device__ __forceinline__ int lds_byte(int r, int c) { const int st = (r >> 4) * 2 + (c >> 5), rr = r & 15, cc = c & 31, ob = rr * 64 + cc * 2; return st * 1024 + (ob ^ (((ob >> 9) & 1) << 5)); }
__device__ __forceinline__ void stage_rc(int b, int& R, int& C) { const int st = b / 1024, sb = b % 1024, swz = sb ^ (((sb >> 9) & 1) << 5); R = (st >> 1) * 16 + swz / 64; C = (st & 1) * 32 + (swz % 64) / 2; }
__device__ __forceinline__ int perm32(int rho) { const int n = rho >> 4, i = rho & 15; return 8 * (i >> 2) + 4 * n + (i & 3); }

struct Unit { const char* A; const char* B; int pm, pn; };

__device__ __forceinline__ void tile_of(int L, int nM, int nN, int& pm, int& pn) {
    const int nwg = nM * nN; int wgid = L;
    { const int q = nwg / NXCD, r = nwg % NXCD, xcd = wgid % NXCD, off = wgid / NXCD; wgid = (xcd < r ? xcd * (q + 1) : r * (q + 1) + (xcd - r) * q) + off; }
    const int nig = WGM * nN, gid = wgid / nig, fm = gid * WGM, gsz = (nM - fm) < WGM ? (nM - fm) : WGM;
    pm = fm + ((wgid % nig) % gsz); pn = (wgid % nig) / gsz;
}
struct DenseOrder {
    const char* A; const char* B; int K, nM, nN, G, c;
    __device__ void init(const void* A_, const void* B_, int Mr, int N, int K_, int G_, int c_) { A = (const char*)A_; B = (const char*)B_; K = K_; nM = Mr / BM; nN = N / BM; G = G_; c = c_; }
    __device__ __forceinline__ bool next(int i, Unit& u) const {
        const long L = (long)i * G + c; if (L >= (long)nM * nN) return false;
        tile_of((int)L, nM, nN, u.pm, u.pn);
        u.A = A + (size_t)u.pm * BM * K * 2; u.B = B + (size_t)u.pn * BM * K * 2; return true;
    }
};
struct MoeOrder {
    const char* A; const char* B; size_t bstride; int K, nM, nN, G, c; int t1, t2, t3, t4, t5, t6, t7;
    __device__ void init(const void* A_, const void* B_, size_t bstride_, int N, int K_, int G_, int c_, const unsigned* cnt) {
        A = (const char*)A_; B = (const char*)B_; bstride = bstride_; K = K_; nN = N / BM; G = G_; c = c_;
        int t = 0;
#define RT_(e) ((int)((__builtin_amdgcn_readfirstlane((int)cnt[e]) + 255) >> 8))
        t += RT_(0); t1 = t; t += RT_(1); t2 = t; t += RT_(2); t3 = t; t += RT_(3); t4 = t; t += RT_(4); t5 = t; t += RT_(5); t6 = t; t += RT_(6); t7 = t; t += RT_(7); nM = t;
#undef RT_
    }
    __device__ __forceinline__ bool next(int i, Unit& u) const {
        const long L = (long)i * G + c; if (L >= (long)nM * nN) return false;
        tile_of((int)L, nM, nN, u.pm, u.pn);
        const int e = (u.pm >= t1) + (u.pm >= t2) + (u.pm >= t3) + (u.pm >= t4) + (u.pm >= t5) + (u.pm >= t6) + (u.pm >= t7);
        u.A = A + (size_t)u.pm * BM * K * 2; u.B = B + (size_t)e * bstride + (size_t)u.pn * BM * K * 2; return true;
    }
};

struct EpiF16 {
    static constexpr bool PERM = true;
    h16* O; int ldc;
    __device__ __forceinline__ void operator()(const f32x4 (&acc)[2][2][4][2], const Unit& u, int wr, int wc, int fr, int fq) const {
        const int row0 = u.pm * BM + wr * 64 + fr, col0 = u.pn * BM + wc * 32 + 8 * fq;
#pragma unroll
        for (int ai = 0; ai < 2; ++ai)
#pragma unroll
            for (int m = 0; m < 4; ++m) { h16* rowp = O + (size_t)(row0 + ai * HALF + m * 16) * ldc + col0;
#pragma unroll
                for (int bj = 0; bj < 2; ++bj) { const f32x4 v0 = acc[ai][bj][m][0], v1 = acc[ai][bj][m][1];
                    u32x4 w; w.x = pk2(v0[0], v0[1]); w.y = pk2(v0[2], v0[3]); w.z = pk2(v1[0], v1[1]); w.w = pk2(v1[2], v1[3]);
                    *(u32x4*)(rowp + bj * HALF) = w; } }
    }
};
struct EpiSwiGLU {
    static constexpr bool PERM = true;
    h16* O; int ldh;
    __device__ __forceinline__ void operator()(const f32x4 (&acc)[2][2][4][2], const Unit& u, int wr, int wc, int fr, int fq) const {
        const int row0 = u.pm * BM + wr * 64 + fr, col0 = u.pn * (BM / 2) + wc * 16 + 4 * fq;
#pragma unroll
        for (int ai = 0; ai < 2; ++ai)
#pragma unroll
            for (int m = 0; m < 4; ++m) { h16* rowp = O + (size_t)(row0 + ai * HALF + m * 16) * ldh + col0;
#pragma unroll
                for (int bj = 0; bj < 2; ++bj) { const f32x4 g = acc[ai][bj][m][0], up = acc[ai][bj][m][1];
                    u32x2 w; w.x = pk2(siluf_(g[0]) * up[0], siluf_(g[1]) * up[1]); w.y = pk2(siluf_(g[2]) * up[2], siluf_(g[3]) * up[3]);
                    *(u32x2*)(rowp + bj * (HALF / 2)) = w; } }
    }
};
struct EpiF32 {
    static constexpr bool PERM = false;
    float* C; int ldc;
    __device__ __forceinline__ void operator()(const f32x4 (&acc)[2][2][4][2], const Unit& u, int wr, int wc, int fr, int fq) const {
        const int row0 = u.pm * BM + wr * 64 + fr, col0 = u.pn * BM + wc * 32 + 4 * fq;
#pragma unroll
        for (int ai = 0; ai < 2; ++ai)
#pragma unroll
            for (int m = 0; m < 4; ++m) { float* rowp = C + (size_t)(row0 + ai * HALF + m * 16) * ldc + col0;
#pragma unroll
                for (int bj = 0; bj < 2; ++bj)
#pragma unroll
                    for (int n = 0; n < 2; ++n) *(f32x4*)(rowp + bj * HALF + n * 16) = acc[ai][bj][m][n]; }
    }
};

template <class Epi, class Sched>
__device__ __forceinline__ void gemm_phase(LAS unsigned char* lds, const int tid, const int K, const Sched& S, const Epi& E) {
    const int wid = __builtin_amdgcn_readfirstlane(tid >> 6), lane = tid & 63, wr = wid >> 2, wc = wid & 3, fr = lane & 15, fq = lane >> 4;
    const int nt = K / BK;
    unsigned voffA[2], voffB[2];
#pragma unroll
    for (int i = 0; i < 2; ++i) { int R, C; stage_rc(tid * 16 + i * 8192, R, C); const int Rb = Epi::PERM ? ((R & ~31) + perm32(R & 31)) : R;
        voffA[i] = (unsigned)(R * K + C) * 2u; voffB[i] = (unsigned)(Rb * K + C) * 2u; }
    const size_t kstep = (size_t)(BK * 2);
    const size_t hstep = (size_t)HALF * K * 2;
    const unsigned ldsw = (unsigned)wid * 1024u;
    const int aoff = lds_byte(wr * 64 + fr, fq * 8), boff = lds_byte(wc * 32 + fr, fq * 8);
#define G8_SA(b, h) (((b) * 2 + (h)) * HTB)
#define G8_SB(b, h) ((4 + (b) * 2 + (h)) * HTB)
#define G8_STAGE(bufoff, gbase, voff) do { _Pragma("unroll") for (int _i = 0; _i < 2; ++_i) \
        __builtin_amdgcn_global_load_lds((const unsigned*)((const char*)(gbase) + (voff)[_i]), (LAS unsigned*)(lds + (bufoff) + ldsw + _i * 8192), 16, 0, 0); } while (0)
#define G8_LDA(dst, b, h) do { _Pragma("unroll") for (int m = 0; m < 4; ++m) _Pragma("unroll") for (int k = 0; k < 2; ++k) dst[m][k] = *(const LAS h16x8*)(lds + G8_SA(b, h) + aoff + m * 2048 + k * 1024); } while (0)
#define G8_LDB(dst, b, h) do { _Pragma("unroll") for (int n = 0; n < 2; ++n) _Pragma("unroll") for (int k = 0; k < 2; ++k) dst[n][k] = *(const LAS h16x8*)(lds + G8_SB(b, h) + boff + n * 2048 + k * 1024); } while (0)
#define G8_MMA(ai, bj, At, Bt) do { __builtin_amdgcn_s_setprio(1); _Pragma("unroll") for (int m = 0; m < 4; ++m) _Pragma("unroll") for (int n = 0; n < 2; ++n) _Pragma("unroll") for (int k = 0; k < 2; ++k) \
        acc[ai][bj][m][n] = __builtin_amdgcn_mfma_f32_16x16x32_f16(Bt[n][k], At[m][k], acc[ai][bj][m][n], 0, 0, 0); __builtin_amdgcn_s_setprio(0); } while (0)
#define G8_WAIT_V(n) asm volatile("s_waitcnt vmcnt(" #n ")" ::: "memory")
#define G8_WAIT_L(n) asm volatile("s_waitcnt lgkmcnt(" #n ")" ::: "memory")
#define G8_BAR __builtin_amdgcn_s_barrier()
#define G8_SCHED __builtin_amdgcn_sched_barrier(0)
    Unit cur, nxt; int ui = 0;
    if (!S.next(0, cur)) return;
    f32x4 acc[2][2][4][2];
#pragma unroll
    for (int a = 0; a < 2; ++a)
#pragma unroll
        for (int b = 0; b < 2; ++b)
#pragma unroll
            for (int m = 0; m < 4; ++m)
#pragma unroll
                for (int n = 0; n < 2; ++n) acc[a][b][m][n] = (f32x4){0.f, 0.f, 0.f, 0.f};
    h16x8 At[4][2], B0[2][2], B1[2][2];
    const char* cA = cur.A; const char* cB = cur.B;
    G8_STAGE(G8_SB(0, 0), cB, voffB); G8_STAGE(G8_SB(0, 1), cB + hstep, voffB); G8_STAGE(G8_SA(0, 0), cA, voffA); G8_STAGE(G8_SA(0, 1), cA + hstep, voffA);
    if (wr == 1) G8_BAR;
    G8_WAIT_V(2); G8_BAR;
    G8_STAGE(G8_SB(1, 0), cB + kstep, voffB); G8_STAGE(G8_SA(1, 0), cA + kstep, voffA); G8_STAGE(G8_SB(1, 1), cB + hstep + kstep, voffB);
    G8_WAIT_V(6); G8_BAR;
    for (;;) {
        const bool has_next = S.next(ui + 1, nxt);
        const char* nA = has_next ? nxt.A : cA; const char* nB = has_next ? nxt.B : cB;
        for (int t = 0; t < nt; t += 2) {
            const bool last = (t == nt - 2);
            const char* a1 = cA + (size_t)(t + 1) * kstep;
            const char* a2 = last ? nA : cA + (size_t)(t + 2) * kstep; const char* b2 = last ? nB : cB + (size_t)(t + 2) * kstep;
            const char* a3 = a2 + kstep; const char* b3 = b2 + kstep;
            G8_LDB(B0, 0, 0); G8_LDB(B1, 0, 1); G8_SCHED; G8_LDA(At, 0, 0); G8_STAGE(G8_SA(1, 1), a1 + hstep, voffA);
            G8_WAIT_V(8); G8_WAIT_L(0); G8_BAR; G8_MMA(0, 0, At, B0); G8_MMA(0, 1, At, B1); G8_BAR; G8_SCHED;
            G8_LDA(At, 0, 1); G8_STAGE(G8_SB(0, 0), b2, voffB); G8_STAGE(G8_SB(0, 1), b2 + hstep, voffB); G8_STAGE(G8_SA(0, 0), a2, voffA);
            G8_WAIT_V(8); G8_WAIT_L(0); G8_BAR; G8_MMA(1, 0, At, B0); G8_MMA(1, 1, At, B1); G8_BAR; G8_SCHED;
            G8_LDB(B0, 1, 0); G8_LDB(B1, 1, 1); G8_SCHED; G8_LDA(At, 1, 0); G8_STAGE(G8_SA(0, 1), a2 + hstep, voffA);
            G8_WAIT_V(8); G8_WAIT_L(0); G8_BAR; G8_MMA(0, 0, At, B0); G8_MMA(0, 1, At, B1); G8_BAR; G8_SCHED;
            G8_LDA(At, 1, 1); G8_STAGE(G8_SB(1, 0), b3, voffB); G8_STAGE(G8_SB(1, 1), b3 + hstep, voffB); G8_STAGE(G8_SA(1, 0), a3, voffA);
            G8_WAIT_V(8); G8_WAIT_L(0); G8_BAR; G8_MMA(1, 0, At, B0); G8_MMA(1, 1, At, B1); G8_BAR; G8_SCHED;
        }
        if (wr == 0) G8_BAR;
        { int fr_e = fr, fq_e = fq; asm volatile("" : "+v"(fr_e), "+v"(fq_e)); E(acc, cur, wr, wc, fr_e, fq_e); }
        if (!has_next) break;
#pragma unroll
        for (int a = 0; a < 2; ++a)
#pragma unroll
            for (int b = 0; b < 2; ++b)
#pragma unroll
                for (int m = 0; m < 4; ++m)
#pragma unroll
                    for (int n = 0; n < 2; ++n) acc[a][b][m][n] = (f32x4){0.f, 0.f, 0.f, 0.f};
        cur = nxt; cA = nA; cB = nB; ++ui;
        if (wr == 1) G8_BAR;
    }
    G8_WAIT_V(0);
    G8_BAR;
#undef G8_SA
#undef G8_SB
#undef G8_STAGE
#undef G8_LDA
#undef G8_LDB
#undef G8_MMA
#undef G8_WAIT_V
#undef G8_WAIT_L
#undef G8_BAR
#undef G8_SCHED
}
}

struct Frame {
    unsigned char* lds; int tid, lane, wave, G, bid;
    const Params* pp;
    unsigned char* ws;
};
#define WSP(T, off) ((T*)(F.ws + (off)))

struct MapId { __device__ __forceinline__ int operator()(int n) const { return n; } };
struct MapGU { int half; __device__ __forceinline__ int operator()(int n) const { const int up = n >= half, j = up ? n - half : n; return 8 * (j >> 2) + 4 * up + (j & 3); } };

template <class RowMap>
__device__ __forceinline__ void xpose_tile(const float* __restrict__ W, int N, h16* __restrict__ WT, int K, int k0, int n0, float* scr, int lane, RowMap rm) {
    f32x4 v[16];
    const int r4 = lane >> 4, c4 = (lane & 15) * 4;
#pragma unroll
    for (int i = 0; i < 16; ++i) v[i] = *(const f32x4*)(W + (size_t)(k0 + i * 4 + r4) * N + n0 + c4);
#pragma unroll
    for (int i = 0; i < 16; ++i) { float* s = scr + (i * 4 + r4) * 65 + c4; s[0] = v[i].x; s[1] = v[i].y; s[2] = v[i].z; s[3] = v[i].w; }
    LDS_WAIT();
    const int c = lane & 7;
#pragma unroll
    for (int j = 0; j < 8; ++j) { const int n = (lane >> 3) + 8 * j; const float* s = scr + (8 * c) * 65 + n;
        u32x4 o; o.x = pk2(s[0], s[65]); o.y = pk2(s[130], s[195]); o.z = pk2(s[260], s[325]); o.w = pk2(s[390], s[455]);
        *(u32x4*)(WT + (size_t)rm(n0 + n) * K + k0 + 8 * c) = o; }
    LDS_WAIT();
}
template <class RowMap>
__device__ __forceinline__ void xpose_matrix(Frame& F, const float* W, int K, int N, h16* WT, RowMap rm, int& tbase) {
    const int gw = F.bid * NWAVES + F.wave, NGW = F.G * NWAVES;
    const int nkt = K / 64, nnt = N / 64, ntile = nkt * nnt;
    float* scr = (float*)(F.lds) + F.wave * (64 * 65);
    int first = gw - (tbase % NGW); if (first < 0) first += NGW;
    for (int t = first; t < ntile; t += NGW) { const int kt = t / nnt, ntt = t % nnt; xpose_tile(W, N, WT, K, kt * 64, ntt * 64, scr, F.lane, rm); }
    tbase += ntile;
}
__device__ __forceinline__ void step_pre(Frame& F) {
    const Params& p = *F.pp;
    float* modacc = (float*)(F.ws + OFF_CTL) + CW_MOD;
    for (int it = F.bid; it < 256; it += F.G) {
        const int l = it >> 7, dc = it & 127;
        float sc[8];
#pragma unroll
        for (int i = 0; i < 8; ++i) sc[i] = siluf_(p.c[dc * 8 + i]);
#pragma unroll
        for (int j = 0; j < 3; ++j) { const int col4 = F.tid + 512 * j; f32x4 a = {0.f, 0.f, 0.f, 0.f};
#pragma unroll
            for (int i = 0; i < 8; ++i) { const f32x4 w = *(const f32x4*)(p.w_ada + ((size_t)(l * 1024 + dc * 8 + i)) * 6144 + col4 * 4); a += w * sc[i]; }
            if (dc == 0) a += *(const f32x4*)(p.b_ada + l * 6144 + col4 * 4);
            float* dst = modacc + l * 6144 + col4 * 4;
            atomicAdd(dst + 0, a.x); atomicAdd(dst + 1, a.y); atomicAdd(dst + 2, a.z); atomicAdd(dst + 3, a.w); }
    }
    { f32x2* tab = WSP(f32x2, OFF_TAB);
      for (int idx = F.bid * NTHREADS + F.tid; idx < M * 8; idx += F.G * NTHREADS) { const int t = idx >> 3, i = idx & 7;
          const float fhi = i == 0 ? 1.0f : i == 1 ? 0.1939227432012558f : i == 2 ? 0.03760603070259094f : i == 3 ? 0.007292664609849453f : i == 4 ? 0.0014142135623842478f : i == 5 ? 0.00027424818836152554f : i == 6 ? 5.3182957344688475e-05f : 1.0313385246263351e-05f;
          const float flo = i == 0 ? 0.0f : i == 1 ? 1.5474299619455678e-09f : i == 2 ? 2.2827298384875405e-10f : i == 3 ? 1.2736765808707418e-10f : i == 4 ? -1.115275406748939e-14f : i == 5 ? -1.2685318073746288e-11f : i == 6 ? 1.624761414818765e-12f : 1.309491116886427e-13f;
          const float ps = (float)p.pos[t];
          const float ph = ps * fhi, pe = fmaf(ps, fhi, -ph) + ps * flo;
          const float kk = rintf(ph * 0.15915494309189535f);
          float r = fmaf(-kk, 6.2831854820251465f, ph); r = fmaf(-kk, -1.7484555314695172e-07f, r); r += pe;
          float sn, cs; sincosf(r, &sn, &cs); tab[idx] = (f32x2){(float)cs, (float)sn}; } }
    int tb = 0;
    for (int l = 0; l < 2; ++l) xpose_matrix(F, p.w_in + (size_t)l * D * INW, D, INW, WSP(h16, OFF_WT_IN) + (size_t)l * INW * D, MapId{}, tb);
    for (int l = 0; l < 2; ++l) xpose_matrix(F, p.w_out + (size_t)l * D * D, D, D, WSP(h16, OFF_WT_OUT) + (size_t)l * D * D, MapId{}, tb);
    xpose_matrix(F, p.fup, D, 2 * FFN, WSP(h16, OFF_WT_UP), MapGU{FFN}, tb);
    xpose_matrix(F, p.fdown, FFN, D, WSP(h16, OFF_WT_DOWN), MapId{}, tb);
    for (int e = 0; e < NE; ++e) xpose_matrix(F, p.mup + (size_t)e * D * 2 * EDIM, D, 2 * EDIM, WSP(h16, OFF_WT_MUP) + (size_t)e * 2 * EDIM * D, MapGU{EDIM}, tb);
    for (int e = 0; e < NE; ++e) xpose_matrix(F, p.mdown + (size_t)e * EDIM * D, EDIM, D, WSP(h16, OFF_WT_MDOWN) + (size_t)e * D * EDIM, MapId{}, tb);
}

__device__ __forceinline__ void step_h0(Frame& F) {
    const float* mod = (const float*)(F.ws + OFF_CTL) + CW_MOD;
    h16* H = WSP(h16, OFF_H);
    for (size_t i = (size_t)F.bid * NTHREADS + F.tid; i < (size_t)M * D / 8; i += (size_t)F.G * NTHREADS) {
        const int col = (int)(i & 127) * 8;
        const f32x4 a = *(const f32x4*)(F.pp->x + i * 8), b = *(const f32x4*)(F.pp->x + i * 8 + 4);
        const f32x4 sh0 = *(const f32x4*)(mod + col), sh1 = *(const f32x4*)(mod + col + 4), sc0 = *(const f32x4*)(mod + 1024 + col), sc1 = *(const f32x4*)(mod + 1024 + col + 4);
        const f32x4 r0 = a * (sc0 + 1.0f) + sh0, r1 = b * (sc1 + 1.0f) + sh1;
        u32x4 w; w.x = pk2(r0[0], r0[1]); w.y = pk2(r0[2], r0[3]); w.z = pk2(r1[0], r1[1]); w.w = pk2(r1[2], r1[3]);
        *(u32x4*)(H + i * 8) = w;
    }
}

constexpr int SSEG = 128, NSS = M / SSEG, NCH = SSEG / 16;
constexpr size_t SCR_SE = OFF_BIG, SCR_SI = OFF_BIG + 32 * MiB, SCR_LP = OFF_BIG + 64 * MiB, SCR_OA = OFF_BIG + 80 * MiB;
__device__ __forceinline__ void step_rot(Frame& F, int layer) {
    h16* P = WSP(h16, OFF_PROJ); const f32x2* tab = WSP(f32x2, OFF_TAB);
    for (int idx = F.bid * NTHREADS + F.tid; idx < M * 14; idx += F.G * NTHREADS) {
        const int t = idx / 14, hh = idx % 14;
        const int cb = hh < 4 ? PC_Q + hh * 64 : hh < 8 ? PC_K + (hh - 4) * 64 : hh < 12 ? PD_Q + (hh - 8) * 64 : PD_K + (hh - 12) * 64;
        h16* ptr = P + (size_t)t * INW + cb;
        const h16x8 x1 = *(const h16x8*)ptr, x2 = *(const h16x8*)(ptr + 8);
        h16x8 o1, o2;
#pragma unroll
        for (int i = 0; i < 8; ++i) { const f32x2 cs = tab[t * 8 + i]; const float a = (float)x1[i], b = (float)x2[i]; o1[i] = (h16)(a * cs.x - b * cs.y); o2[i] = (h16)(b * cs.x + a * cs.y); }
        *(h16x8*)ptr = o1; *(h16x8*)(ptr + 8) = o2;
    }
}

template <int N> __device__ __forceinline__ float row_shr(float v) { return __builtin_bit_cast(float, __builtin_amdgcn_update_dpp(0, __builtin_bit_cast(int, v), 0x110 | N, 0xF, 0xF, true)); }
__device__ __forceinline__ float row_scan16(float v) { v += row_shr<1>(v); v += row_shr<2>(v); v += row_shr<4>(v); v += row_shr<8>(v); return v; }
__device__ __forceinline__ h16x4 cvt4(const f32x4 v) { h16x4 r; r[0] = (h16)v[0]; r[1] = (h16)v[1]; r[2] = (h16)v[2]; r[3] = (h16)v[3]; return r; }
#define MFMA16(a, b, c) __builtin_amdgcn_mfma_f32_16x16x16f16((a), (b), (c), 0, 0, 0)
template <bool FULL>
__device__ __forceinline__ void hg_chunk(const h16* __restrict__ P, const int h, const int dir, const int c0, const int lane, const float (&lb)[4][4], f32x4 (&S)[4][4], float (&lp)[4][4], float* __restrict__ OAdir, const h16x4 ident) {
    const int tau = lane & 15, g = lane >> 4;
    const h16* row = P + (size_t)(c0 + (dir ? 15 - tau : tau)) * INW + h * 64 + 4 * g;
    h16x4 zr[4], qr[4], vr[4];
#pragma unroll
    for (int kt = 0; kt < 4; ++kt) { zr[kt] = *(const h16x4*)(row + (dir ? PA_FB : PA_FF) + 16 * kt); vr[kt] = *(const h16x4*)(row + PA_I + 16 * kt); if (FULL) qr[kt] = *(const h16x4*)(row + PA_Q + 16 * kt); }
    float cum[4][4], kkv[4][4], tot[4][4];
#pragma unroll
    for (int kt = 0; kt < 4; ++kt)
#pragma unroll
        for (int j = 0; j < 4; ++j) { const float z = (float)zr[kt][j]; const float e = __expf(-fabsf(z)), r = 1.0f / (1.0f + e); const float sg = z >= 0.f ? r : e * r, nsg = z >= 0.f ? e * r : r;
            const float oml = 1.0f - lb[kt][j]; cum[kt][j] = row_scan16(__logf(lb[kt][j] + oml * sg)); kkv[kt][j] = oml * nsg; }
#pragma unroll
    for (int kt = 0; kt < 4; ++kt)
#pragma unroll
        for (int j = 0; j < 4; ++j) tot[kt][j] = __shfl(cum[kt][j], (lane & 48) | 15);
    const f32x4 zero4 = {0.f, 0.f, 0.f, 0.f};
    h16x4 KT[4], VT[4];
#pragma unroll
    for (int kt = 0; kt < 4; ++kt) { h16x4 kh;
#pragma unroll
        for (int j = 0; j < 4; ++j) kh[j] = (h16)(kkv[kt][j] * __expf(tot[kt][j] - cum[kt][j]));
        KT[kt] = cvt4(MFMA16(kh, ident, zero4)); VT[kt] = cvt4(MFMA16(vr[kt], ident, zero4)); }
    if (FULL) {
        f32x4 sc = zero4; h16x4 QA[4];
#pragma unroll
        for (int kt = 0; kt < 4; ++kt)
#pragma unroll
            for (int j = 0; j < 4; ++j) { const float ref = __shfl(cum[kt][j], (lane & 48) | 7); const float qs = siluf_((float)qr[kt][j]);
                QA[kt][j] = (h16)(qs * __expf(cum[kt][j]));
                sc = __builtin_amdgcn_mfma_f32_16x16x4f32(kkv[kt][j] * __expf(ref - cum[kt][j]), qs * __expf(cum[kt][j] - ref), sc, 0, 0, 0); }
        h16x4 AA;
#pragma unroll
        for (int j = 0; j < 4; ++j) AA[j] = (h16)((4 * g + j <= tau) ? sc[j] : 0.f);
#pragma unroll
        for (int dt = 0; dt < 4; ++dt) { f32x4 o = MFMA16(AA, VT[dt], zero4);
#pragma unroll
            for (int kt = 0; kt < 4; ++kt) o = MFMA16(QA[kt], cvt4(S[kt][dt]), o);
#pragma unroll
            for (int j = 0; j < 4; ++j) { const int to = 4 * g + j; OAdir[(size_t)(c0 + (dir ? 15 - to : to)) * 256 + h * 64 + 16 * dt + tau] = o[j]; } }
    }
#pragma unroll
    for (int kt = 0; kt < 4; ++kt) { float dec[4];
#pragma unroll
        for (int j = 0; j < 4; ++j) { dec[j] = __expf(tot[kt][j]); lp[kt][j] += tot[kt][j]; }
#pragma unroll
        for (int dt = 0; dt < 4; ++dt) { f32x4 sv = S[kt][dt]; sv[0] *= dec[0]; sv[1] *= dec[1]; sv[2] *= dec[2]; sv[3] *= dec[3]; S[kt][dt] = MFMA16(KT[kt], VT[dt], sv); } }
}
__device__ __forceinline__ void hg_setup(const Frame& F, int layer, int h, float (&lb)[4][4], h16x4& ident) {
    const int tau = F.lane & 15, g = F.lane >> 4;
#pragma unroll
    for (int kt = 0; kt < 4; ++kt)
#pragma unroll
        for (int j = 0; j < 4; ++j) { const int c = h * 64 + 16 * kt + 4 * g + j; lb[kt][j] = (layer == 0 ? 0.f : 1.f) * sigmoidf_(F.pp->alb[256 + c] - F.pp->alb[c]); }
#pragma unroll
    for (int j = 0; j < 4; ++j) ident[j] = (h16)((4 * g + j == tau) ? 1.0f : 0.0f);
}
__device__ __forceinline__ void hg_pass1(Frame& F, int layer) {
    const int gw = F.bid * NWAVES + F.wave, NGW = F.G * NWAVES; const int tau = F.lane & 15, g = F.lane >> 4;
    const h16* P = WSP(h16, OFF_PROJ); float* SE = WSP(float, SCR_SE); float* LP = WSP(float, SCR_LP);
    for (int it = gw; it < 8 * NSS; it += NGW) { const int ss = it % NSS, hd = it / NSS, dir = hd & 1, h = hd >> 1;
        float lb[4][4], lp[4][4]; h16x4 ident; f32x4 S[4][4]; hg_setup(F, layer, h, lb, ident);
#pragma unroll
        for (int kt = 0; kt < 4; ++kt)
#pragma unroll
            for (int j = 0; j < 4; ++j) { lp[kt][j] = 0.f; S[kt][j] = (f32x4){0.f, 0.f, 0.f, 0.f}; }
#pragma unroll 1
        for (int ci = 0; ci < NCH; ++ci) hg_chunk<false>(P, h, dir, ss * SSEG + (dir ? NCH - 1 - ci : ci) * 16, F.lane, lb, S, lp, nullptr, ident);
        int l2 = F.lane; asm volatile("" : "+v"(l2));
        float* se = SE + (size_t)it * 4096 + (4 * (l2 >> 4)) * 64 + (l2 & 15);
#pragma unroll
        for (int kt = 0; kt < 4; ++kt)
#pragma unroll
            for (int j = 0; j < 4; ++j) {
#pragma unroll
                for (int dt = 0; dt < 4; ++dt) se[(16 * kt + j) * 64 + 16 * dt] = S[kt][dt][j]; }
        if ((l2 & 15) == 0) {
#pragma unroll
            for (int kt = 0; kt < 4; ++kt)
#pragma unroll
                for (int j = 0; j < 4; ++j) LP[(size_t)it * 64 + 16 * kt + 4 * (l2 >> 4) + j] = lp[kt][j]; }
    }
}
__device__ __forceinline__ void step_hg2(Frame& F) {
    const float* SE = WSP(float, SCR_SE); const float* LP = WSP(float, SCR_LP); float* SI = WSP(float, SCR_SI);
    for (int e = F.bid * NTHREADS + F.tid; e < 8 * 4096; e += F.G * NTHREADS) { const int hd = e >> 12, cd = e & 4095, c = cd >> 6, dir = hd & 1;
        float st = 0.f;
        for (int n0 = 0; n0 < NSS; n0 += 8) { float se[8], lpv[8];
#pragma unroll
            for (int u = 0; u < 8; ++u) { const int n = dir ? NSS - 1 - (n0 + u) : n0 + u; se[u] = SE[((size_t)hd * NSS + n) * 4096 + cd]; lpv[u] = LP[((size_t)hd * NSS + n) * 64 + c]; }
#pragma unroll
            for (int u = 0; u < 8; ++u) { const int n = dir ? NSS - 1 - (n0 + u) : n0 + u; SI[((size_t)hd * NSS + n) * 4096 + cd] = st; st = __expf(lpv[u]) * st + se[u]; } }
    }
}
__device__ __forceinline__ void step_hg3(Frame& F, int layer) {
    const int gw = F.bid * NWAVES + F.wave, NGW = F.G * NWAVES; const int tau = F.lane & 15, g = F.lane >> 4;
    const h16* P = WSP(h16, OFF_PROJ); const float* SI = WSP(float, SCR_SI);
    for (int it = gw; it < 8 * NSS; it += NGW) { const int ss = it % NSS, hd = it / NSS, dir = hd & 1, h = hd >> 1;
        float lb[4][4], lp[4][4]; h16x4 ident; f32x4 S[4][4]; hg_setup(F, layer, h, lb, ident);
        const float* si = SI + (size_t)it * 4096 + (4 * g) * 64 + tau;
#pragma unroll
        for (int kt = 0; kt < 4; ++kt)
#pragma unroll
            for (int dt = 0; dt < 4; ++dt) {
#pragma unroll
                for (int j = 0; j < 4; ++j) S[kt][dt][j] = si[(16 * kt + j) * 64 + 16 * dt];
                lp[kt][dt] = 0.f; }
        float* OAdir = WSP(float, SCR_OA) + (size_t)dir * M * 256;
#pragma unroll 1
        for (int ci = 0; ci < NCH; ++ci) hg_chunk<true>(P, h, dir, ss * SSEG + (dir ? NCH - 1 - ci : ci) * 16, F.lane, lb, S, lp, OAdir, ident);
    }
}
__device__ __forceinline__ void conv_item(Frame& F, int item, int layer) {
    const Params& p = *F.pp;
    float* U = (float*)F.lds;
    float* Yt = U + 62 * 256;
    const h16* P = WSP(h16, OFF_PROJ);
    const int t0 = item * 32;
    for (int i = F.tid; i < 62 * 256; i += NTHREADS) { const int r = i >> 8, c = i & 255, t = t0 - 15 + r; float u = 0.f;
        if (t >= 0 && t < M) { const h16* row = P + (size_t)t * INW; u = (float)row[PB_V + c] * sigmoidf_((float)row[PB_G + c]); }
        U[i] = u; }
    __syncthreads();
    { const int c = F.tid & 255, tg = F.tid >> 8;
      float w[31];
#pragma unroll
      for (int j = 0; j < 31; ++j) w[j] = p.cw[(size_t)layer * 31 * 256 + j * 256 + c];
      const float bias = p.cb[layer * 256 + c];
      for (int tt = tg * 16; tt < tg * 16 + 16; ++tt) { float a = bias;
#pragma unroll
          for (int j = 0; j < 31; ++j) a += w[j] * U[(tt + j) * 256 + c];
          Yt[tt * 256 + c] = a; } }
    __syncthreads();
    { h16* Y = WSP(h16, OFF_Y);
      for (int r = F.wave * 4; r < F.wave * 4 + 4; ++r) {
          const f32x4 v = *(const f32x4*)(Yt + r * 256 + F.lane * 4);
          const float mean = wave_sum((v.x + v.y) + (v.z + v.w)) * (1.f / 256.f);
          const f32x4 d = v - mean;
          const float var = wave_sum((d.x * d.x + d.y * d.y) + (d.z * d.z + d.w * d.w)) * (1.f / 256.f);
          const float rstd = 1.0f / sqrtf(var + LN_EPS);
          const f32x4 nw = *(const f32x4*)(p.cnw + layer * 256 + F.lane * 4), nb = *(const f32x4*)(p.cnb + layer * 256 + F.lane * 4);
          const f32x4 o = d * rstd * nw + nb;
          u32x2 w2; w2.x = pk2(siluf_(o.x), siluf_(o.y)); w2.y = pk2(siluf_(o.z), siluf_(o.w));
          *(u32x2*)(Y + (size_t)(t0 + r) * D + 256 + F.lane * 4) = w2; } }
    __syncthreads();
}
#define ATT_KEY(sidx) do { const int s_ = (sidx); if (s_ >= 0 && s_ < M) { const h16* kr = Pk + (size_t)s_ * INW; const h16* vr = Pv + (size_t)s_ * INW; float sc = 0.f; \
    _Pragma("unroll") for (int c8 = 0; c8 < 8; ++c8) { const h16x8 kk = *(const h16x8*)(kr + 8 * c8); _Pragma("unroll") for (int e = 0; e < 4; ++e) sc = __builtin_amdgcn_fdot2((h16x2){qv[c8][2 * e], qv[c8][2 * e + 1]}, (h16x2){kk[2 * e], kk[2 * e + 1]}, sc, false); } \
    const float mn = fmaxf(m, sc), corr = __expf(m - mn), pw = __expf(sc - mn); l = l * corr + pw; m = mn; \
    _Pragma("unroll") for (int c8 = 0; c8 < 8; ++c8) { const h16x8 vv = *(const h16x8*)(vr + 8 * c8); _Pragma("unroll") for (int e = 0; e < 8; ++e) acc[8 * c8 + e] = acc[8 * c8 + e] * corr + pw * (float)vv[e]; } } } while (0)
__device__ __forceinline__ void attn_naive_item(Frame& F, int item, int layer, int which  ) {
    const int idx = item * NTHREADS + F.tid; const int h = idx >> 14, t = idx & (M - 1);
    const h16* P = WSP(h16, OFF_PROJ);
    const h16* Pq = P + (size_t)t * INW + (which ? PD_Q : PC_Q) + h * 64;
    const h16* Pk = P + (which ? PD_K + (h >> 1) * 64 : PC_K + h * 64);
    const h16* Pv = P + (which ? PD_V + (h >> 1) * 64 : PC_V + h * 64);
    h16x8 qv[8]; float acc[64]; float m = -1e30f, l = 0.f;
#pragma unroll
    for (int c8 = 0; c8 < 8; ++c8) { qv[c8] = *(const h16x8*)(Pq + 8 * c8) * (h16)0.125f;
#pragma unroll
        for (int e = 0; e < 8; ++e) acc[8 * c8 + e] = 0.f; }
    h16* Y = WSP(h16, OFF_Y) + (size_t)t * D + (which ? 768 : 512) + h * 64;
    float scale;
    if (which == 0) {
        for (int j = -64; j <= 64; ++j) ATT_KEY(t + j);
        for (int j = -64; j <= 64; ++j) ATT_KEY(t + 4 * j);
        for (int j = -64; j <= 64; ++j) ATT_KEY(t + 16 * j);
        scale = 1.0f / l;
    } else {
        for (int j = -128; j <= 128; ++j) ATT_KEY(t + j);
        const float sk = F.pp->sink[layer * 4 + h]; const float mt = fmaxf(m, sk), w = __expf(m - mt), den = l * w + __expf(sk - mt);
        scale = w / den;
    }
#pragma unroll
    for (int c8 = 0; c8 < 8; ++c8) { u32x4 w; w.x = pk2(acc[8 * c8] * scale, acc[8 * c8 + 1] * scale); w.y = pk2(acc[8 * c8 + 2] * scale, acc[8 * c8 + 3] * scale);
        w.z = pk2(acc[8 * c8 + 4] * scale, acc[8 * c8 + 5] * scale); w.w = pk2(acc[8 * c8 + 6] * scale, acc[8 * c8 + 7] * scale); *(u32x4*)(Y + 8 * c8) = w; }
}
typedef __attribute__((__vector_size__(4 * sizeof(short)))) short vs4;
typedef __attribute__((address_space(3))) vs4 lds_vs4;
constexpr int ATT_PITCH = 144, ATT_WAVE_LDS = 32 * ATT_PITCH;
struct AttLoad { h16x8 kf[2][2]; u32x4 vc[4]; };
__device__ __forceinline__ void att_load(AttLoad& L, const h16* __restrict__ Kp, const h16* __restrict__ Vp, int tkb, int st, int lane) {
    const int r = lane & 15, g = lane >> 4;
#pragma unroll
    for (int sb = 0; sb < 2; ++sb) { int tk = tkb + (16 * sb + r) * st; tk = tk < 0 ? 0 : (tk > M - 1 ? M - 1 : tk); const h16* kr = Kp + (size_t)tk * INW + 8 * g;
        L.kf[sb][0] = *(const h16x8*)kr; L.kf[sb][1] = *(const h16x8*)(kr + 32); }
#pragma unroll
    for (int n = 0; n < 4; ++n) { int tk = tkb + ((lane >> 3) + 8 * n) * st; tk = tk < 0 ? 0 : (tk > M - 1 ? M - 1 : tk); L.vc[n] = *(const u32x4*)(Vp + (size_t)tk * INW + 8 * (lane & 7)); }
}
template <int WIN>
__device__ __forceinline__ void att_seg(const h16* __restrict__ Kp, const h16* __restrict__ Vp, const int tk0, const int st, const int nblk, const int qo, const h16x8 (&Qf)[2],
                                        float& m, float& l, f32x4 (&O)[4], unsigned char* vlds, const int lane) {
    const int g = lane >> 4;
    AttLoad cur, nxt; att_load(cur, Kp, Vp, tk0, st, lane);
    const f32x4 zero4 = {0.f, 0.f, 0.f, 0.f};
#pragma unroll 1
    for (int blk = 0; blk < nblk; ++blk) {
        const int nb = blk + 1 < nblk ? blk + 1 : blk;
        att_load(nxt, Kp, Vp, tk0 + 32 * nb * st, st, lane);
        LDS_WAIT();
#pragma unroll
        for (int n = 0; n < 4; ++n) *(u32x4*)(vlds + ((lane >> 3) + 8 * n) * ATT_PITCH + 16 * (lane & 7)) = cur.vc[n];
        f32x4 sa = __builtin_amdgcn_mfma_f32_16x16x32_f16(cur.kf[0][0], Qf[0], zero4, 0, 0, 0); sa = __builtin_amdgcn_mfma_f32_16x16x32_f16(cur.kf[0][1], Qf[1], sa, 0, 0, 0);
        f32x4 sb = __builtin_amdgcn_mfma_f32_16x16x32_f16(cur.kf[1][0], Qf[0], zero4, 0, 0, 0); sb = __builtin_amdgcn_mfma_f32_16x16x32_f16(cur.kf[1][1], Qf[1], sb, 0, 0, 0);
        float sv[8]; bool ok[8]; float bm = -1e30f;
#pragma unroll
        for (int e = 0; e < 8; ++e) { const int kk = 32 * blk + 16 * (e >> 2) + 4 * g + (e & 3); const int tk = tk0 + kk * st;
            ok[e] = ((unsigned)(kk - qo) <= (unsigned)WIN) && ((unsigned)tk < (unsigned)M); sv[e] = e < 4 ? sa[e & 3] : sb[e & 3]; bm = ok[e] ? fmaxf(bm, sv[e]) : bm; }
        bm = fmaxf(bm, __shfl_xor(bm, 16)); bm = fmaxf(bm, __shfl_xor(bm, 32));
        const float mn = fmaxf(m, bm), corr = __expf(m - mn); m = mn;
        float ps = 0.f; h16x8 pf;
#pragma unroll
        for (int e = 0; e < 8; ++e) { const float pe = ok[e] ? __expf(sv[e] - mn) : 0.f; ps += pe; pf[e] = (h16)pe; }
        l = l * corr + ps;
        LDS_WAIT();
#pragma unroll
        for (int dt = 0; dt < 4; ++dt) {
            const int q4 = (lane >> 2) & 3, p4 = lane & 3;
            const vs4 r0 = __builtin_amdgcn_ds_read_tr16_b64_v4i16((lds_vs4*)(vlds + (4 * g + q4) * ATT_PITCH + (16 * dt + 4 * p4) * 2));
            const vs4 r1 = __builtin_amdgcn_ds_read_tr16_b64_v4i16((lds_vs4*)(vlds + (16 + 4 * g + q4) * ATT_PITCH + (16 * dt + 4 * p4) * 2));
            typedef short s16x8 __attribute__((ext_vector_type(8)));
            s16x8 vv; vv[0] = r0[0]; vv[1] = r0[1]; vv[2] = r0[2]; vv[3] = r0[3]; vv[4] = r1[0]; vv[5] = r1[1]; vv[6] = r1[2]; vv[7] = r1[3];
            f32x4 o = O[dt]; o[0] *= corr; o[1] *= corr; o[2] *= corr; o[3] *= corr;
            O[dt] = __builtin_amdgcn_mfma_f32_16x16x32_f16(__builtin_bit_cast(h16x8, vv), pf, o, 0, 0, 0); }
        cur = nxt;
    }
}
__device__ __forceinline__ void att_unit(Frame& F, int u, int layer) {
    const int lane = F.lane, i = lane & 15, g = lane >> 4;
    const h16* P = WSP(h16, OFF_PROJ); h16* Y = WSP(h16, OFF_Y);
    unsigned char* vlds = F.lds + F.wave * ATT_WAVE_LDS;
    float m = -1e30f, l = 0.f; f32x4 O[4];
#pragma unroll
    for (int dt = 0; dt < 4; ++dt) O[dt] = (f32x4){0.f, 0.f, 0.f, 0.f};
    h16x8 Qf[2]; int tq, h; float scale;
    if (u < 4096) {
        const int r = u & 15; h = (u >> 4) & 3; const int b = u >> 6; const int tq0 = 256 * b + r; tq = tq0 + 16 * i;
        const h16* qp = P + (size_t)tq * INW + PC_Q + h * 64 + 8 * g; Qf[0] = *(const h16x8*)qp * (h16)0.125f; Qf[1] = *(const h16x8*)(qp + 32) * (h16)0.125f;
        const h16* Kp = P + PC_K + h * 64; const h16* Vp = P + PC_V + h * 64;
        att_seg<128>(Kp, Vp, tq0 - 64 * 16, 16, 5, i, Qf, m, l, O, vlds, lane);
        att_seg<128>(Kp, Vp, tq0 - 64 * 4, 4, 6, 4 * i, Qf, m, l, O, vlds, lane);
        att_seg<128>(Kp, Vp, tq0 - 64, 1, 12, 16 * i, Qf, m, l, O, vlds, lane);
        l += __shfl_xor(l, 16); l += __shfl_xor(l, 32);
        scale = 1.0f / l;
    } else {
        const int v = u - 4096; h = v >> 10; const int tq0 = (v & 1023) * 16; tq = tq0 + i;
        const h16* qp = P + (size_t)tq * INW + PD_Q + h * 64 + 8 * g; Qf[0] = *(const h16x8*)qp * (h16)0.125f; Qf[1] = *(const h16x8*)(qp + 32) * (h16)0.125f;
        const h16* Kp = P + PD_K + (h >> 1) * 64; const h16* Vp = P + PD_V + (h >> 1) * 64;
        att_seg<256>(Kp, Vp, tq0 - 128, 1, 9, i, Qf, m, l, O, vlds, lane);
        l += __shfl_xor(l, 16); l += __shfl_xor(l, 32);
        const float sk = F.pp->sink[layer * 4 + h]; const float mt = fmaxf(m, sk), w = __expf(m - mt), den = l * w + __expf(sk - mt);
        scale = w / den;
    }
    h16* yo = Y + (size_t)tq * D + (u < 4096 ? 512 : 768) + h * 64 + 4 * g;
#pragma unroll
    for (int dt = 0; dt < 4; ++dt) { u32x2 w2; w2.x = pk2(O[dt][0] * scale, O[dt][1] * scale); w2.y = pk2(O[dt][2] * scale, O[dt][3] * scale); *(u32x2*)(yo + 16 * dt) = w2; }
}
__device__ __forceinline__ void step_mix(Frame& F, int layer) {
    constexpr int N_CONV = M / 32;
    hg_pass1(F, layer);
    for (int it = F.bid; it < N_CONV; it += F.G) conv_item(F, it, layer);
#if ATT_NAIVE
    for (int it = F.bid; it < 256; it += F.G) attn_naive_item(F, it & 127, layer, it >> 7);
#else
    { const int gw = F.bid * NWAVES + F.wave, NGW = F.G * NWAVES;
#pragma unroll 1
      for (int u = gw; u < 8192; u += NGW) att_unit(F, u, layer); }
#endif
}
__device__ __forceinline__ void step_afin(Frame& F, int layer) {
    const float* OA = WSP(float, SCR_OA); const h16* P = WSP(h16, OFF_PROJ); h16* Y = WSP(h16, OFF_Y);
    const int gw = F.bid * NWAVES + F.wave, NGW = F.G * NWAVES;
    const float nw = F.pp->anw[layer * 64 + F.lane];
    for (int it = gw; it < M * 4; it += NGW) { const int t = it >> 2, h = it & 3;
        const float o = OA[(size_t)t * 256 + h * 64 + F.lane] + OA[(size_t)M * 256 + (size_t)t * 256 + h * 64 + F.lane];
        const float ms = wave_sum(o * o) * (1.f / 64.f);
        const float g = (float)P[(size_t)t * INW + PA_G + h * 64 + F.lane];
        Y[(size_t)t * D + h * 64 + F.lane] = (h16)(o * (1.0f / sqrtf(ms + RMS_EPS)) * nw * siluf_(g)); }
}

struct LnArgs { const float* xin; const float* gate; const float* lw; const float* lb; const float* nscale; const float* nshift; float* xout; h16* hout; };
__device__ __forceinline__ void ln_core(const Frame& F, const LnArgs& a, int row, const f32x4 (&fv)[4], f32x4 (&hv)[4]) {
    f32x4 tv[4]; float s = 0.f;
#pragma unroll
    for (int j = 0; j < 4; ++j) { const int col = F.lane * 4 + 256 * j; const f32x4 xi = *(const f32x4*)(a.xin + (size_t)row * D + col), g = *(const f32x4*)(a.gate + col);
        tv[j] = xi * ALPHA + (g + 1.0f) * fv[j]; s += (tv[j].x + tv[j].y) + (tv[j].z + tv[j].w); }
    const float mean = wave_sum(s) * (1.f / D); float s2 = 0.f;
#pragma unroll
    for (int j = 0; j < 4; ++j) { tv[j] = tv[j] - mean; s2 += (tv[j].x * tv[j].x + tv[j].y * tv[j].y) + (tv[j].z * tv[j].z + tv[j].w * tv[j].w); }
    const float rstd = 1.0f / sqrtf(wave_sum(s2) * (1.f / D) + LN_EPS);
#pragma unroll
    for (int j = 0; j < 4; ++j) { const int col = F.lane * 4 + 256 * j; const f32x4 w = *(const f32x4*)(a.lw + col), b = *(const f32x4*)(a.lb + col);
        const f32x4 xo = tv[j] * rstd * w + b;
        *(f32x4*)(a.xout + (size_t)row * D + col) = xo;
        if (a.hout) { const f32x4 sc = *(const f32x4*)(a.nscale + col), sh = *(const f32x4*)(a.nshift + col); hv[j] = xo * (sc + 1.0f) + sh;
            u32x2 w2; w2.x = pk2(hv[j].x, hv[j].y); w2.y = pk2(hv[j].z, hv[j].w); *(u32x2*)(a.hout + (size_t)row * D + col) = w2; } }
}
__device__ __forceinline__ void step_ln_dense(Frame& F, const LnArgs& a, const float* Z, bool router) {
    const int gw = F.bid * NWAVES + F.wave, NGW = F.G * NWAVES;
    unsigned* cnt = (unsigned*)(F.ws + OFF_CTL) + CW_CNT; unsigned* tok = WSP(unsigned, OFF_TOK);
    for (int row = gw; row < M; row += NGW) {
        f32x4 fv[4], hv[4];
#pragma unroll
        for (int j = 0; j < 4; ++j) fv[j] = *(const f32x4*)(Z + (size_t)row * D + F.lane * 4 + 256 * j);
        ln_core(F, a, row, fv, hv);
        if (router) {
            float lg[8];
#pragma unroll
            for (int e = 0; e < 8; ++e) lg[e] = 0.f;
#pragma unroll
            for (int j = 0; j < 4; ++j)
#pragma unroll
                for (int i = 0; i < 4; ++i) { const int col = F.lane * 4 + 256 * j + i; const f32x4 w0 = *(const f32x4*)(F.pp->rout + (size_t)col * 8), w1 = *(const f32x4*)(F.pp->rout + (size_t)col * 8 + 4); const float hval = hv[j][i];
                    lg[0] += hval * w0.x; lg[1] += hval * w0.y; lg[2] += hval * w0.z; lg[3] += hval * w0.w; lg[4] += hval * w1.x; lg[5] += hval * w1.y; lg[6] += hval * w1.z; lg[7] += hval * w1.w; }
#pragma unroll
            for (int e = 0; e < 8; ++e) lg[e] = wave_sum(lg[e]);
            int e1 = 0; float l1 = lg[0];
#pragma unroll
            for (int e = 1; e < 8; ++e) if (lg[e] > l1) { l1 = lg[e]; e1 = e; }
            int e2 = -1; float l2 = -3.0e38f;
#pragma unroll
            for (int e = 0; e < 8; ++e) if (e != e1 && lg[e] > l2) { l2 = lg[e]; e2 = e; }
            const float g1 = 1.0f / (1.0f + __expf(l2 - l1)), g2 = 1.0f - g1;
            if (F.lane == 0) { tok[row * 8 + 0] = (unsigned)e1; tok[row * 8 + 1] = (unsigned)e2; tok[row * 8 + 2] = __float_as_uint(g1); tok[row * 8 + 3] = __float_as_uint(g2);
                atomicAdd(cnt + e1, 1u); atomicAdd(cnt + e2, 1u); }
        }
    }
}
__device__ __forceinline__ void step_slot(Frame& F) {
    const unsigned* cnt = (const unsigned*)(F.ws + OFF_CTL) + CW_CNT; unsigned* cur = (unsigned*)(F.ws + OFF_CTL) + CW_CUR; unsigned* tok = WSP(unsigned, OFF_TOK);
    const h16* H = WSP(h16, OFF_H); h16* HG = WSP(h16, OFF_PROJ);
    unsigned off[8]; { unsigned o = 0;
#pragma unroll
        for (int e = 0; e < 8; ++e) { off[e] = o; o += ((cnt[e] + 255u) >> 8) << 8; } }
    const int gw = F.bid * NWAVES + F.wave, NGW = F.G * NWAVES;
    for (int row = gw; row < M; row += NGW) {
        const unsigned e1 = tok[row * 8 + 0], e2 = tok[row * 8 + 1];
        unsigned s1 = 0, s2 = 0;
        if (F.lane == 0) {
            unsigned o1 = 0, o2 = 0;
#pragma unroll
            for (int e = 0; e < 8; ++e) { o1 = (e1 == (unsigned)e) ? off[e] : o1; o2 = (e2 == (unsigned)e) ? off[e] : o2; }
            s1 = o1 + atomicAdd(cur + e1, 1u); s2 = o2 + atomicAdd(cur + e2, 1u); tok[row * 8 + 4] = s1; tok[row * 8 + 5] = s2; }
        s1 = __shfl(s1, 0); s2 = __shfl(s2, 0);
        const u32x4 a = *(const u32x4*)(H + (size_t)row * D + F.lane * 8), b = *(const u32x4*)(H + (size_t)row * D + 512 + F.lane * 8);
        *(u32x4*)(HG + (size_t)s1 * D + F.lane * 8) = a; *(u32x4*)(HG + (size_t)s1 * D + 512 + F.lane * 8) = b;
        *(u32x4*)(HG + (size_t)s2 * D + F.lane * 8) = a; *(u32x4*)(HG + (size_t)s2 * D + 512 + F.lane * 8) = b;
    }
}
__device__ __forceinline__ void step_ln_moe(Frame& F, const LnArgs& a) {
    const int gw = F.bid * NWAVES + F.wave, NGW = F.G * NWAVES;
    const unsigned* tok = WSP(unsigned, OFF_TOK); const float* YS = WSP(float, OFF_PROJ);
    for (int row = gw; row < M; row += NGW) {
        const float g1 = __uint_as_float(tok[row * 8 + 2]), g2 = __uint_as_float(tok[row * 8 + 3]); const unsigned s1 = tok[row * 8 + 4], s2 = tok[row * 8 + 5];
        f32x4 fv[4], hv[4];
#pragma unroll
        for (int j = 0; j < 4; ++j) { const int col = F.lane * 4 + 256 * j; fv[j] = *(const f32x4*)(YS + (size_t)s1 * D + col) * g1 + *(const f32x4*)(YS + (size_t)s2 * D + col) * g2; }
        ln_core(F, a, row, fv, hv);
    }
}

constexpr int N_STEPS = 25;
#ifndef KMASK
#define KMASK 0xFFFFF
#endif
#define KON(k) ((KMASK >> (k)) & 1)
__global__ void __launch_bounds__(NTHREADS, 2) fwd_kernel(Params kp) {
    extern __shared__ __attribute__((aligned(16))) unsigned char lds[];
    Frame F; F.lds = lds; F.tid = threadIdx.x; F.lane = F.tid & 63; F.wave = __builtin_amdgcn_readfirstlane(F.tid >> 6); F.G = gridDim.x; F.bid = blockIdx.x; F.ws = kp.ws;
    LAS unsigned char* ldsl = (LAS unsigned char*)lds;
    const int lo = kp.lo, hi = kp.hi;
    for (int s = lo; s < hi; ++s) {
        { const Params* pp_ = (const Params*)__builtin_amdgcn_kernarg_segment_ptr(); asm volatile("" : "+s"(pp_) :: "memory"); F.pp = pp_; unsigned char* ws_ = kp.ws; asm volatile("" : "+s"(ws_)); F.ws = ws_; }
        const Params& p = *F.pp;
        { int tid_ = threadIdx.x; asm volatile("" : "+v"(tid_)); F.tid = tid_; F.lane = tid_ & 63; F.wave = __builtin_amdgcn_readfirstlane(tid_ >> 6); }
        int layer = 0, kind = s;
        if (s >= 13) { layer = 1; kind = s - 11; }
        const float* mod = (const float*)(F.ws + OFF_CTL) + CW_MOD;
        const float* modl = mod + layer * 6144;
        if (KON(0) && s == 0) step_pre(F);
        else if (KON(1) && s == 1) step_h0(F);
        else if (KON(2) && kind == 2) { g8::DenseOrder S; S.init(WSP(h16, OFF_H), WSP(h16, OFF_WT_IN) + (size_t)layer * INW * D, M, INW, D, F.G, F.bid); g8::EpiF16 E{WSP(h16, OFF_PROJ), INW}; g8::gemm_phase(ldsl, F.tid, D, S, E); }
        else if (KON(3) && kind == 3) step_rot(F, layer);
        else if (KON(4) && kind == 4) step_mix(F, layer);
        else if (KON(5) && kind == 5) step_hg2(F);
        else if (KON(6) && kind == 6) step_hg3(F, layer);
        else if (KON(7) && kind == 7) step_afin(F, layer);
        else if (KON(8) && kind == 8) { g8::DenseOrder S; S.init(WSP(h16, OFF_Y), WSP(h16, OFF_WT_OUT) + (size_t)layer * D * D, M, D, D, F.G, F.bid); g8::EpiF32 E{WSP(float, OFF_Z), D}; g8::gemm_phase(ldsl, F.tid, D, S, E); }
        else if (KON(9) && kind == 9) { LnArgs a{layer == 0 ? p.x : WSP(float, OFF_X), modl + 2048, p.lnw + (size_t)(layer * 2) * D, p.lnb + (size_t)(layer * 2) * D, modl + 4096, modl + 3072, WSP(float, OFF_X), WSP(h16, OFF_H)};
            step_ln_dense(F, a, WSP(float, OFF_Z), layer == 1); }
        else if (KON(10) && layer == 0 && kind == 10) { g8::DenseOrder S; S.init(WSP(h16, OFF_H), WSP(h16, OFF_WT_UP), M, 2 * FFN, D, F.G, F.bid); g8::EpiSwiGLU E{WSP(h16, OFF_PROJ), FFN}; g8::gemm_phase(ldsl, F.tid, D, S, E); }
        else if (KON(11) && layer == 0 && kind == 11) { g8::DenseOrder S; S.init(WSP(h16, OFF_PROJ), WSP(h16, OFF_WT_DOWN), M, D, FFN, F.G, F.bid); g8::EpiF32 E{WSP(float, OFF_Z), D}; g8::gemm_phase(ldsl, F.tid, FFN, S, E); }
        else if (KON(12) && layer == 0 && kind == 12) { LnArgs a{WSP(float, OFF_X), modl + 5120, p.lnw + (size_t)1 * D, p.lnb + (size_t)1 * D, mod + 6144 + 1024, mod + 6144 + 0, WSP(float, OFF_X), WSP(h16, OFF_H)};
            step_ln_dense(F, a, WSP(float, OFF_Z), false); }
        else if (KON(13) && layer == 1 && kind == 10) step_slot(F);
        else if (KON(14) && layer == 1 && kind == 11) { g8::MoeOrder S; S.init(WSP(h16, OFF_PROJ), WSP(h16, OFF_WT_MUP), (size_t)2 * EDIM * D * 2, 2 * EDIM, D, F.G, F.bid, (const unsigned*)(F.ws + OFF_CTL) + CW_CNT);
            g8::EpiSwiGLU E{WSP(h16, OFF_BIG), EDIM}; g8::gemm_phase(ldsl, F.tid, D, S, E); }
        else if (KON(15) && layer == 1 && kind == 12) { g8::MoeOrder S; S.init(WSP(h16, OFF_BIG), WSP(h16, OFF_WT_MDOWN), (size_t)D * EDIM * 2, D, EDIM, F.G, F.bid, (const unsigned*)(F.ws + OFF_CTL) + CW_CNT);
            g8::EpiF32 E{WSP(float, OFF_PROJ), D}; g8::gemm_phase(ldsl, F.tid, EDIM, S, E); }
        else if (KON(16) && layer == 1 && kind == 13) { LnArgs a{WSP(float, OFF_X), modl + 5120, p.lnw + (size_t)3 * D, p.lnb + (size_t)3 * D, nullptr, nullptr, p.out, nullptr}; step_ln_moe(F, a); }
        if (s + 1 < hi) { cg::this_grid().sync(); }
    }
}

extern "C" void kernel_launch(void* const* d_in, const int* in_sizes, int n_in, void* d_out, int out_size, void* d_ws, size_t ws_size, hipStream_t stream) {
    static int grid = 0;
    if (grid == 0) {
        if (n_in != 21 || in_sizes[0] != M * D || out_size != M * D || ws_size < OFF_END) { fprintf(stderr, "kernel_launch: unexpected shapes / workspace (%d inputs, ws %zu, need %zu)\n", n_in, ws_size, (size_t)OFF_END); grid = -1; return; }
        int dev = 0, cus = 0, per_cu = 0;
        hipGetDevice(&dev); hipDeviceGetAttribute(&cus, hipDeviceAttributeMultiprocessorCount, dev);
        hipFuncSetAttribute((const void*)fwd_kernel, hipFuncAttributeMaxDynamicSharedMemorySize, LDS_BYTES);
        hipOccupancyMaxActiveBlocksPerMultiprocessor(&per_cu, (const void*)fwd_kernel, NTHREADS, LDS_BYTES);
        if (per_cu < 1) { fprintf(stderr, "kernel_launch: occupancy query says %d blocks per CU\n", per_cu); per_cu = 1; }
        grid = cus * 1;
        fprintf(stderr, "kernel_launch: grid %d (cus %d, per_cu %d), ws %zu\n", grid, cus, per_cu, ws_size);
    }
    if (grid < 0) return;
    hipMemsetAsync((char*)d_ws + OFF_CTL, 0, CTL_BYTES, stream);
    Params p{};
    p.x = (const float*)d_in[0]; p.c = (const float*)d_in[1]; p.pos = (const int*)d_in[2]; p.w_ada = (const float*)d_in[3]; p.b_ada = (const float*)d_in[4];
    p.w_in = (const float*)d_in[5]; p.w_out = (const float*)d_in[6]; p.alb = (const float*)d_in[7]; p.anw = (const float*)d_in[8]; p.cw = (const float*)d_in[9];
    p.cb = (const float*)d_in[10]; p.cnw = (const float*)d_in[11]; p.cnb = (const float*)d_in[12]; p.sink = (const float*)d_in[13]; p.lnw = (const float*)d_in[14];
    p.lnb = (const float*)d_in[15]; p.fup = (const float*)d_in[16]; p.fdown = (const float*)d_in[17]; p.rout = (const float*)d_in[18]; p.mup = (const float*)d_in[19];
    p.mdown = (const float*)d_in[20]; p.out = (float*)d_out; p.ws = (unsigned char*)d_ws;
#if MK_ONE_LAUNCH
    p.lo = 0; p.hi = N_STEPS;
    { void* args[] = {&p}; hipError_t e = hipLaunchCooperativeKernel((const void*)fwd_kernel, dim3(grid), dim3(NTHREADS), args, LDS_BYTES, stream);
      if (e != hipSuccess) fprintf(stderr, "cooperative launch failed: %s\n", hipGetErrorString(e)); }
#else
    for (int s = 0; s < N_STEPS; ++s) { p.lo = s; p.hi = s + 1;
        void* args[] = {&p}; hipError_t e = hipLaunchCooperativeKernel((const void*)fwd_kernel, dim3(grid), dim3(NTHREADS), args, LDS_BYTES, stream);
        if (e != hipSuccess) { fprintf(stderr, "launch %d failed: %s\n", s, hipGetErrorString(e)); break; } }
#endif
}
```

```cpp
#include <hip/hip_runtime.h>
#include <hip/hip_cooperative_groups.h>
#include <cstdio>
#include <cstdint>
namespace cg = cooperative_groups;

#ifndef ATT_NAIVE
#define ATT_NAIVE 0
#endif
#ifndef PROBE_DUP
#define PROBE_DUP 0
#endif
#ifndef MK_ONE_LAUNCH
#define MK_ONE_LAUNCH 1
#endif

#define LAS __attribute__((address_space(3)))
typedef _Float16 h16;
typedef h16 h16x8 __attribute__((ext_vector_type(8)));
typedef h16 h16x4 __attribute__((ext_vector_type(4)));
typedef h16 h16x2 __attribute__((ext_vector_type(2)));
typedef float f32x4 __attribute__((ext_vector_type(4)));
typedef float f32x2 __attribute__((ext_vector_type(2)));
typedef unsigned u32x4 __attribute__((ext_vector_type(4)));
typedef unsigned u32x2 __attribute__((ext_vector_type(2)));

constexpr int M = 16384, D = 1024, INW = 3072, FFN = 2816, NE = 8, EDIM = 3584;
constexpr int MOE_ROWS = 2 * M + NE * 256;
constexpr float ALPHA = 1.41421356237309515f;
constexpr float LN_EPS = 1e-5f, RMS_EPS = 1e-6f;
constexpr int NTHREADS = 512, NWAVES = 8;
constexpr int LDS_BYTES = 139264;

constexpr int PA_Q = 0, PA_FF = 256, PA_FB = 512, PA_I = 768, PA_G = 1024, PB_V = 1280, PB_G = 1536;
constexpr int PC_Q = 1792, PC_K = 2048, PC_V = 2304, PD_Q = 2560, PD_K = 2816, PD_V = 2944;

constexpr size_t MiB = 1u << 20;
constexpr size_t OFF_CTL = 0, CTL_BYTES = 1 * MiB;
constexpr size_t OFF_TAB = 1 * MiB;
constexpr size_t OFF_TOK = 2 * MiB;
constexpr size_t OFF_WT_IN = 4 * MiB;
constexpr size_t OFF_WT_OUT = 16 * MiB;
constexpr size_t OFF_WT_UP = 20 * MiB;
constexpr size_t OFF_WT_DOWN = 31 * MiB;
constexpr size_t OFF_WT_MUP = 37 * MiB;
constexpr size_t OFF_WT_MDOWN = 149 * MiB;
constexpr size_t OFF_X = 205 * MiB;
constexpr size_t OFF_H = 269 * MiB;
constexpr size_t OFF_Y = 301 * MiB;
constexpr size_t OFF_Z = 333 * MiB;
constexpr size_t OFF_PROJ = 397 * MiB;
constexpr size_t OFF_BIG = 533 * MiB;
constexpr size_t OFF_END = 775 * MiB;
constexpr int CW_MOD = 1024;
constexpr int CW_CNT = 64;
constexpr int CW_CUR = 128;
constexpr int CW_BAR = 16384;
constexpr int LDS_BARST = LDS_BYTES - 16;

struct Params {
    const float* x; const float* c; const int* pos; const float* w_ada; const float* b_ada; const float* w_in; const float* w_out;
    const float* alb; const float* anw; const float* cw; const float* cb; const float* cnw; const float* cnb; const float* sink;
    const float* lnw; const float* lnb; const float* fup; const float* fdown; const float* rout; const float* mup; const float* mdown;
    float* out; unsigned char* ws; int lo, hi;
};

__device__ __forceinline__ unsigned pk2(float lo, float hi) { h16x2 v; v.x = (h16)lo; v.y = (h16)hi; return __builtin_bit_cast(unsigned, v); }
__device__ __forceinline__ float sigmoidf_(float v) { return 1.0f / (1.0f + __expf(-v)); }
__device__ __forceinline__ float siluf_(float v) { return v / (1.0f + __expf(-v)); }
__device__ __forceinline__ float wave_sum(float v) {
#pragma unroll
    for (int o = 1; o < 64; o <<= 1) v += __shfl_xor(v, o);
    return v;
}
#define LDS_WAIT() asm volatile("s_waitcnt lgkmcnt(0)" ::: "memory")

namespace g8 {
constexpr int BM = 256, BK = 64, HALF = 128, HTB = HALF * BK * 2, STAGE_BYTES = 8 * HTB, NXCD = 8, WGM = 8;
__device__ __forceinline__ int lds_byte(int r, int c) { const int st = (r >> 4) * 2 + (c >> 5), rr = r & 15, cc = c & 31, ob = rr * 64 + cc * 2; return st * 1024 + (ob ^ (((ob >> 9) & 1) << 5)); }
__device__ __forceinline__ void stage_rc(int b, int& R, int& C) { const int st = b / 1024, sb = b % 1024, swz = sb ^ (((sb >> 9) & 1) << 5); R = (st >> 1) * 16 + swz / 64; C = (st & 1) * 32 + (swz % 64) / 2; }
__device__ __forceinline__ int perm32(int rho) { const int n = rho >> 4, i = rho & 15; return 8 * (i >> 2) + 4 * n + (i & 3); }

struct Unit { const char* A; const char* B; int pm, pn; };

__device__ __forceinline__ void tile_of(int L, int nM, int nN, int& pm, int& pn) {
    const int nwg = nM * nN; int wgid = L;
    { const int q = nwg / NXCD, r = nwg % NXCD, xcd = wgid % NXCD, off = wgid / NXCD; wgid = (xcd < r ? xcd * (q + 1) : r * (q + 1) + (xcd - r) * q) + off; }
    const int nig = WGM * nN, gid = wgid / nig, fm = gid * WGM, gsz = (nM - fm) < WGM ? (nM - fm) : WGM;
    pm = fm + ((wgid % nig) % gsz); pn = (wgid % nig) / gsz;
}
struct DenseOrder {
    const char* A; const char* B; int K, nM, nN, G, c;
    __device__ void init(const void* A_, const void* B_, int Mr, int N, int K_, int G_, int c_) { A = (const char*)A_; B = (const char*)B_; K = K_; nM = Mr / BM; nN = N / BM; G = G_; c = c_; }
    __device__ __forceinline__ bool next(int i, Unit& u) const {
        const long L = (long)i * G + c; if (L >= (long)nM * nN) return false;
        tile_of((int)L, nM, nN, u.pm, u.pn);
        u.A = A + (size_t)u.pm * BM * K * 2; u.B = B + (size_t)u.pn * BM * K * 2; return true;
    }
};
struct MoeOrder {
    const char* A; const char* B; size_t bstride; int K, nM, nN, G, c; int t1, t2, t3, t4, t5, t6, t7;
    __device__ void init(const void* A_, const void* B_, size_t bstride_, int N, int K_, int G_, int c_, const unsigned* cnt) {
        A = (const char*)A_; B = (const char*)B_; bstride = bstride_; K = K_; nN = N / BM; G = G_; c = c_;
        int t = 0;
#define RT_(e) ((int)((__builtin_amdgcn_readfirstlane((int)cnt[e]) + 255) >> 8))
        t += RT_(0); t1 = t; t += RT_(1); t2 = t; t += RT_(2); t3 = t; t += RT_(3); t4 = t; t += RT_(4); t5 = t; t += RT_(5); t6 = t; t += RT_(6); t7 = t; t += RT_(7); nM = t;
#undef RT_
    }
    __device__ __forceinline__ bool next(int i, Unit& u) const {
        const long L = (long)i * G + c; if (L >= (long)nM * nN) return false;
        tile_of((int)L, nM, nN, u.pm, u.pn);
        const int e = (u.pm >= t1) + (u.pm >= t2) + (u.pm >= t3) + (u.pm >= t4) + (u.pm >= t5) + (u.pm >= t6) + (u.pm >= t7);
        u.A = A + (size_t)u.pm * BM * K * 2; u.B = B + (size_t)e * bstride + (size_t)u.pn * BM * K * 2; return true;
    }
};

struct EpiF16 {
    static constexpr bool PERM = true;
    h16* O; int ldc;
    __device__ __forceinline__ void operator()(const f32x4 (&acc)[2][2][4][2], const Unit& u, int wr, int wc, int fr, int fq) const {
        const int row0 = u.pm * BM + wr * 64 + fr, col0 = u.pn * BM + wc * 32 + 8 * fq;
#pragma unroll
        for (int ai = 0; ai < 2; ++ai)
#pragma unroll
            for (int m = 0; m < 4; ++m) { h16* rowp = O + (size_t)(row0 + ai * HALF + m * 16) * ldc + col0;
#pragma unroll
                for (int bj = 0; bj < 2; ++bj) { const f32x4 v0 = acc[ai][bj][m][0], v1 = acc[ai][bj][m][1];
                    u32x4 w; w.x = pk2(v0[0], v0[1]); w.y = pk2(v0[2], v0[3]); w.z = pk2(v1[0], v1[1]); w.w = pk2(v1[2], v1[3]);
                    *(u32x4*)(rowp + bj * HALF) = w; } }
    }
};
struct EpiSwiGLU {
    static constexpr bool PERM = true;
    h16* O; int ldh;
    __device__ __forceinline__ void operator()(const f32x4 (&acc)[2][2][4][2], const Unit& u, int wr, int wc, int fr, int fq) const {
        const int row0 = u.pm * BM + wr * 64 + fr, col0 = u.pn * (BM / 2) + wc * 16 + 4 * fq;
#pragma unroll
        for (int ai = 0; ai < 2; ++ai)
#pragma unroll
            for (int m = 0; m < 4; ++m) { h16* rowp = O + (size_t)(row0 + ai * HALF + m * 16) * ldh + col0;
#pragma unroll
                for (int bj = 0; bj < 2; ++bj) { const f32x4 g = acc[ai][bj][m][0], up = acc[ai][bj][m][1];
                    u32x2 w; w.x = pk2(siluf_(g[0]) * up[0], siluf_(g[1]) * up[1]); w.y = pk2(siluf_(g[2]) * up[2], siluf_(g[3]) * up[3]);
                    *(u32x2*)(rowp + bj * (HALF / 2)) = w; } }
    }
};
struct EpiF32 {
    static constexpr bool PERM = false;
    float* C; int ldc;
    __device__ __forceinline__ void operator()(const f32x4 (&acc)[2][2][4][2], const Unit& u, int wr, int wc, int fr, int fq) const {
        const int row0 = u.pm * BM + wr * 64 + fr, col0 = u.pn * BM + wc * 32 + 4 * fq;
#pragma unroll
        for (int ai = 0; ai < 2; ++ai)
#pragma unroll
            for (int m = 0; m < 4; ++m) { float* rowp = C + (size_t)(row0 + ai * HALF + m * 16) * ldc + col0;
#pragma unroll
                for (int bj = 0; bj < 2; ++bj)
#pragma unroll
                    for (int n = 0; n < 2; ++n) *(f32x4*)(rowp + bj * HALF + n * 16) = acc[ai][bj][m][n]; }
    }
};

template <class Epi, class Sched>
__device__ __forceinline__ void gemm_phase(LAS unsigned char* lds, const int tid, const int K, const Sched& S, const Epi& E) {
    const int wid = __builtin_amdgcn_readfirstlane(tid >> 6), lane = tid & 63, wr = wid >> 2, wc = wid & 3, fr = lane & 15, fq = lane >> 4;
    const int nt = K / BK;
    unsigned voffA[2], voffB[2];
#pragma unroll
    for (int i = 0; i < 2; ++i) { int R, C; stage_rc(tid * 16 + i * 8192, R, C); const int Rb = Epi::PERM ? ((R & ~31) + perm32(R & 31)) : R;
        voffA[i] = (unsigned)(R * K + C) * 2u; voffB[i] = (unsigned)(Rb * K + C) * 2u; }
    const size_t kstep = (size_t)(BK * 2);
    const size_t hstep = (size_t)HALF * K * 2;
    const unsigned ldsw = (unsigned)wid * 1024u;
    const int aoff = lds_byte(wr * 64 + fr, fq * 8), boff = lds_byte(wc * 32 + fr, fq * 8);
#define G8_SA(b, h) (((b) * 2 + (h)) * HTB)
#define G8_SB(b, h) ((4 + (b) * 2 + (h)) * HTB)
#define G8_STAGE(bufoff, gbase, voff) do { _Pragma("unroll") for (int _i = 0; _i < 2; ++_i) \
        __builtin_amdgcn_global_load_lds((const unsigned*)((const char*)(gbase) + (voff)[_i]), (LAS unsigned*)(lds + (bufoff) + ldsw + _i * 8192), 16, 0, 0); } while (0)
#define G8_LDA(dst, b, h) do { _Pragma("unroll") for (int m = 0; m < 4; ++m) _Pragma("unroll") for (int k = 0; k < 2; ++k) dst[m][k] = *(const LAS h16x8*)(lds + G8_SA(b, h) + aoff + m * 2048 + k * 1024); } while (0)
#define G8_LDB(dst, b, h) do { _Pragma("unroll") for (int n = 0; n < 2; ++n) _Pragma("unroll") for (int k = 0; k < 2; ++k) dst[n][k] = *(const LAS h16x8*)(lds + G8_SB(b, h) + boff + n * 2048 + k * 1024); } while (0)
#define G8_MMA(ai, bj, At, Bt) do { __builtin_amdgcn_s_setprio(1); _Pragma("unroll") for (int m = 0; m < 4; ++m) _Pragma("unroll") for (int n = 0; n < 2; ++n) _Pragma("unroll") for (int k = 0; k < 2; ++k) \
        acc[ai][bj][m][n] = __builtin_amdgcn_mfma_f32_16x16x32_f16(Bt[n][k], At[m][k], acc[ai][bj][m][n], 0, 0, 0); __builtin_amdgcn_s_setprio(0); } while (0)
#define G8_WAIT_V(n) asm volatile("s_waitcnt vmcnt(" #n ")" ::: "memory")
#define G8_WAIT_L(n) asm volatile("s_waitcnt lgkmcnt(" #n ")" ::: "memory")
#define G8_BAR __builtin_amdgcn_s_barrier()
#define G8_SCHED __builtin_amdgcn_sched_barrier(0)
    Unit cur, nxt; int ui = 0;
    if (!S.next(0, cur)) return;
    f32x4 acc[2][2][4][2];
#pragma unroll
    for (int a = 0; a < 2; ++a)
#pragma unroll
        for (int b = 0; b < 2; ++b)
#pragma unroll
            for (int m = 0; m < 4; ++m)
#pragma unroll
                for (int n = 0; n < 2; ++n) acc[a][b][m][n] = (f32x4){0.f, 0.f, 0.f, 0.f};
    h16x8 At[4][2], B0[2][2], B1[2][2];
    const char* cA = cur.A; const char* cB = cur.B;
    G8_STAGE(G8_SB(0, 0), cB, voffB); G8_STAGE(G8_SB(0, 1), cB + hstep, voffB); G8_STAGE(G8_SA(0, 0), cA, voffA); G8_STAGE(G8_SA(0, 1), cA + hstep, voffA);
    if (wr == 1) G8_BAR;
    G8_WAIT_V(2); G8_BAR;
    G8_STAGE(G8_SB(1, 0), cB + kstep, voffB); G8_STAGE(G8_SA(1, 0), cA + kstep, voffA); G8_STAGE(G8_SB(1, 1), cB + hstep + kstep, voffB);
    G8_WAIT_V(6); G8_BAR;
    for (;;) {
        const bool has_next = S.next(ui + 1, nxt);
        const char* nA = has_next ? nxt.A : cA; const char* nB = has_next ? nxt.B : cB;
        for (int t = 0; t < nt; t += 2) {
            const bool last = (t == nt - 2);
            const char* a1 = cA + (size_t)(t + 1) * kstep;
            const char* a2 = last ? nA : cA + (size_t)(t + 2) * kstep; const char* b2 = last ? nB : cB + (size_t)(t + 2) * kstep;
            const char* a3 = a2 + kstep; const char* b3 = b2 + kstep;
            G8_LDB(B0, 0, 0); G8_LDB(B1, 0, 1); G8_SCHED; G8_LDA(At, 0, 0); G8_STAGE(G8_SA(1, 1), a1 + hstep, voffA);
            G8_WAIT_V(8); G8_WAIT_L(0); G8_BAR; G8_MMA(0, 0, At, B0); G8_MMA(0, 1, At, B1); G8_BAR; G8_SCHED;
            G8_LDA(At, 0, 1); G8_STAGE(G8_SB(0, 0), b2, voffB); G8_STAGE(G8_SB(0, 1), b2 + hstep, voffB); G8_STAGE(G8_SA(0, 0), a2, voffA);
            G8_WAIT_V(8); G8_WAIT_L(0); G8_BAR; G8_MMA(1, 0, At, B0); G8_MMA(1, 1, At, B1); G8_BAR; G8_SCHED;
            G8_LDB(B0, 1, 0); G8_LDB(B1, 1, 1); G8_SCHED; G8_LDA(At, 1, 0); G8_STAGE(G8_SA(0, 1), a2 + hstep, voffA);
            G8_WAIT_V(8); G8_WAIT_L(0); G8_BAR; G8_MMA(0, 0, At, B0); G8_MMA(0, 1, At, B1); G8_BAR; G8_SCHED;
            G8_LDA(At, 1, 1); G8_STAGE(G8_SB(1, 0), b3, voffB); G8_STAGE(G8_SB(1, 1), b3 + hstep, voffB); G8_STAGE(G8_SA(1, 0), a3, voffA);
            G8_WAIT_V(8); G8_WAIT_L(0); G8_BAR; G8_MMA(1, 0, At, B0); G8_MMA(1, 1, At, B1); G8_BAR; G8_SCHED;
        }
        if (wr == 0) G8_BAR;
        { int fr_e = fr, fq_e = fq; asm volatile("" : "+v"(fr_e), "+v"(fq_e)); E(acc, cur, wr, wc, fr_e, fq_e); }
        if (!has_next) break;
#pragma unroll
        for (int a = 0; a < 2; ++a)
#pragma unroll
            for (int b = 0; b < 2; ++b)
#pragma unroll
                for (int m = 0; m < 4; ++m)
#pragma unroll
                    for (int n = 0; n < 2; ++n) acc[a][b][m][n] = (f32x4){0.f, 0.f, 0.f, 0.f};
        cur = nxt; cA = nA; cB = nB; ++ui;
        if (wr == 1) G8_BAR;
    }
    G8_WAIT_V(0);
    G8_BAR;
#undef G8_SA
#undef G8_SB
#undef G8_STAGE
#undef G8_LDA
#undef G8_LDB
#undef G8_MMA
#undef G8_WAIT_V
#undef G8_WAIT_L
#undef G8_BAR
#undef G8_SCHED
}
}


#define XB_TMO      128
#define XB_XCNT(j)  (256  + 64 * (j))
#define XB_XSUB(j)  (1280 + 64 * (j))
#define XB_XGEN(j)  (2304 + 64 * (j))
#define XB_TOP      3328
#define XB_TOPGEN   3392
#define XCD_BAR_WORDS 3456
#define XB_SPIN_CAP (1u << 18)
__device__ __forceinline__ unsigned xb_ld(unsigned* p)              { return __hip_atomic_load(p, __ATOMIC_RELAXED, __HIP_MEMORY_SCOPE_AGENT); }
__device__ __forceinline__ unsigned xb_add(unsigned* p, unsigned v) { return __hip_atomic_fetch_add(p, v, __ATOMIC_RELAXED, __HIP_MEMORY_SCOPE_AGENT); }
__device__ __forceinline__ unsigned xb_xcc_id() { return (unsigned)__builtin_amdgcn_s_getreg((3 << 11) | 20) & 0xFu; }
#define XB_SPIN(cond, bar) do { unsigned _sp = 0; while (cond) { __builtin_amdgcn_s_sleep(1); \
    if ((++_sp & 255u) == 0u) { if (xb_ld(&(bar)[XB_TMO])) break; if (_sp > XB_SPIN_CAP) { atomicAdd(&(bar)[XB_TMO], 1u); break; } } } } while (0)
struct XcdBarrier { unsigned* bar; unsigned x; volatile LAS unsigned* st; };
__device__ __forceinline__ XcdBarrier xcd_barrier_post(unsigned* bar, volatile LAS unsigned* st) {
    XcdBarrier b; b.bar = bar; b.x = xb_xcc_id(); b.st = st;
    if (threadIdx.x == 0) (void)xb_add(&bar[XB_XCNT(b.x)], 1u);
    return b;
}
__device__ __forceinline__ void xcd_barrier_complete(unsigned* bar, unsigned x, unsigned& nloc, unsigned& nx) {
    const unsigned G = gridDim.x * gridDim.y * gridDim.z;
    unsigned sum, cnt, mine, sp = 0u;
    for (;;) {
        sum = 0u; cnt = 0u; mine = 0u;
#pragma unroll
        for (unsigned j = 0; j < 16; ++j) { const unsigned c = xb_ld(&bar[XB_XCNT(j)]); sum += c; cnt += (c > 0u) ? 1u : 0u; mine = (j == x) ? c : mine; }
        if (sum == G) break;
        __builtin_amdgcn_s_sleep(1);
        if ((++sp & 255u) == 0u) { if (xb_ld(&bar[XB_TMO])) break; if (sp > XB_SPIN_CAP) { atomicAdd(&bar[XB_TMO], 1u); break; } }
    }
    nloc = mine > 0u ? mine : 1u; nx = cnt > 0u ? cnt : 1u;
}
__device__ __forceinline__ void xcd_barrier(const XcdBarrier& b) {
    asm volatile("s_waitcnt vmcnt(0)" ::: "memory");
    __syncthreads();
    if (threadIdx.x == 0) {
        unsigned* bar = b.bar;
        __builtin_amdgcn_s_waitcnt(0);
        unsigned nloc = b.st[0], nx = b.st[1];
        if (nloc == 0u) { xcd_barrier_complete(bar, b.x, nloc, nx); b.st[0] = nloc; b.st[1] = nx; }
        const unsigned old = xb_add(&bar[XB_XSUB(b.x)], 1u);
        const unsigned gen = old / nloc;
        if (old + 1u == (gen + 1u) * nloc) {
            __builtin_amdgcn_fence(__ATOMIC_RELEASE, "agent");
            asm volatile("s_waitcnt vmcnt(0)" ::: "memory");
            const unsigned og = xb_add(&bar[XB_TOP], 1u);
            const unsigned tg = og / nx;
            if (og + 1u == (tg + 1u) * nx) xb_add(&bar[XB_TOPGEN], 1u);
            else XB_SPIN(xb_ld(&bar[XB_TOPGEN]) == tg, bar);
            __builtin_amdgcn_fence(__ATOMIC_ACQUIRE, "agent");
            xb_add(&bar[XB_XGEN(b.x)], 1u);
            asm volatile("s_waitcnt vmcnt(0)" ::: "memory");
        } else {
            XB_SPIN(xb_ld(&bar[XB_XGEN(b.x)]) == gen, bar);
            __builtin_amdgcn_fence(__ATOMIC_ACQUIRE, "agent");
            asm volatile("s_waitcnt vmcnt(0)" ::: "memory");
        }
    }
    __syncthreads();
}

struct Frame {
    unsigned char* lds; int tid, lane, wave, G, bid;
    const Params* pp;
    unsigned char* ws;
};
#define WSP(T, off) ((T*)(F.ws + (off)))

struct MapId { __device__ __forceinline__ int operator()(int n) const { return n; } };
struct MapGU { int half; __device__ __forceinline__ int operator()(int n) const { const int up = n >= half, j = up ? n - half : n; return 8 * (j >> 2) + 4 * up + (j & 3); } };

template <class RowMap>
__device__ __forceinline__ void xpose_tile(const float* __restrict__ W, int N, h16* __restrict__ WT, int K, int k0, int n0, float* scr, int lane, RowMap rm) {
    f32x4 v[16];
    const int r4 = lane >> 4, c4 = (lane & 15) * 4;
#pragma unroll
    for (int i = 0; i < 16; ++i) v[i] = *(const f32x4*)(W + (size_t)(k0 + i * 4 + r4) * N + n0 + c4);
#pragma unroll
    for (int i = 0; i < 16; ++i) { float* s = scr + (i * 4 + r4) * 65 + c4; s[0] = v[i].x; s[1] = v[i].y; s[2] = v[i].z; s[3] = v[i].w; }
    LDS_WAIT();
    const int c = lane & 7;
#pragma unroll
    for (int j = 0; j < 8; ++j) { const int n = (lane >> 3) + 8 * j; const float* s = scr + (8 * c) * 65 + n;
        u32x4 o; o.x = pk2(s[0], s[65]); o.y = pk2(s[130], s[195]); o.z = pk2(s[260], s[325]); o.w = pk2(s[390], s[455]);
        *(u32x4*)(WT + (size_t)rm(n0 + n) * K + k0 + 8 * c) = o; }
    LDS_WAIT();
}
template <class RowMap>
__device__ __forceinline__ void xpose_matrix(Frame& F, const float* W, int K, int N, h16* WT, RowMap rm, int& tbase) {
    const int gw = F.bid * NWAVES + F.wave, NGW = F.G * NWAVES;
    const int nkt = K / 64, nnt = N / 64, ntile = nkt * nnt;
    float* scr = (float*)(F.lds) + F.wave * (64 * 65);
    int first = gw - (tbase % NGW); if (first < 0) first += NGW;
    for (int t = first; t < ntile; t += NGW) { const int kt = t / nnt, ntt = t % nnt; xpose_tile(W, N, WT, K, kt * 64, ntt * 64, scr, F.lane, rm); }
    tbase += ntile;
}
__device__ __forceinline__ void step_pre(Frame& F) {
    const Params& p = *F.pp;
    { float* modout = (float*)(F.ws + OFF_CTL) + CW_MOD; f32x4* red = (f32x4*)F.lds;
      for (int it = F.bid; it < 256; it += F.G) {
          const int l = it >> 7, c0 = (it & 127) * 48;
          if (F.tid < 480) { const int cg4 = F.tid % 12, dg = F.tid / 12; f32x4 a = {0.f, 0.f, 0.f, 0.f};
#pragma unroll
              for (int i = 0; i < 26; ++i) { const int d = dg + 40 * i; if (d < D) { const f32x4 w = *(const f32x4*)(p.w_ada + ((size_t)(l * 1024 + d)) * 6144 + c0 + cg4 * 4); a += w * siluf_(p.c[d]); } }
              red[dg * 12 + cg4] = a; }
          __syncthreads();
          if (F.tid < 48) { float sum = 0.f; const float* rf = (const float*)red;
              for (int dg = 0; dg < 40; ++dg) sum += rf[dg * 48 + F.tid];
              modout[l * 6144 + c0 + F.tid] = sum + p.b_ada[l * 6144 + c0 + F.tid]; }
          __syncthreads();
      } }
    { f32x2* tab = WSP(f32x2, OFF_TAB);
      for (int idx = F.bid * NTHREADS + F.tid; idx < M * 8; idx += F.G * NTHREADS) { const int t = idx >> 3, i = idx & 7;
          const float fhi = i == 0 ? 1.0f : i == 1 ? 0.1939227432012558f : i == 2 ? 0.03760603070259094f : i == 3 ? 0.007292664609849453f : i == 4 ? 0.0014142135623842478f : i == 5 ? 0.00027424818836152554f : i == 6 ? 5.3182957344688475e-05f : 1.0313385246263351e-05f;
          const float flo = i == 0 ? 0.0f : i == 1 ? 1.5474299619455678e-09f : i == 2 ? 2.2827298384875405e-10f : i == 3 ? 1.2736765808707418e-10f : i == 4 ? -1.115275406748939e-14f : i == 5 ? -1.2685318073746288e-11f : i == 6 ? 1.624761414818765e-12f : 1.309491116886427e-13f;
          const float ps = (float)p.pos[t];
          const float ph = ps * fhi, pe = fmaf(ps, fhi, -ph) + ps * flo;
          const float kk = rintf(ph * 0.15915494309189535f);
          float r = fmaf(-kk, 6.2831854820251465f, ph); r = fmaf(-kk, -1.7484555314695172e-07f, r); r += pe;
          float sn, cs; sincosf(r, &sn, &cs); tab[idx] = (f32x2){(float)cs, (float)sn}; } }
    for (int rep_ = 0; rep_ < ((PROBE_DUP & 8) ? 2 : 1); ++rep_) {
    int tb = 0;
    for (int l = 0; l < 2; ++l) xpose_matrix(F, p.w_in + (size_t)l * D * INW, D, INW, WSP(h16, OFF_WT_IN) + (size_t)l * INW * D, MapId{}, tb);
    for (int l = 0; l < 2; ++l) xpose_matrix(F, p.w_out + (size_t)l * D * D, D, D, WSP(h16, OFF_WT_OUT) + (size_t)l * D * D, MapId{}, tb);
    xpose_matrix(F, p.fup, D, 2 * FFN, WSP(h16, OFF_WT_UP), MapGU{FFN}, tb);
    xpose_matrix(F, p.fdown, FFN, D, WSP(h16, OFF_WT_DOWN), MapId{}, tb);
    for (int e = 0; e < NE; ++e) xpose_matrix(F, p.mup + (size_t)e * D * 2 * EDIM, D, 2 * EDIM, WSP(h16, OFF_WT_MUP) + (size_t)e * 2 * EDIM * D, MapGU{EDIM}, tb);
    for (int e = 0; e < NE; ++e) xpose_matrix(F, p.mdown + (size_t)e * EDIM * D, EDIM, D, WSP(h16, OFF_WT_MDOWN) + (size_t)e * D * EDIM, MapId{}, tb);
    }
}

__device__ __forceinline__ void step_h0(Frame& F) {
    const float* mod = (const float*)(F.ws + OFF_CTL) + CW_MOD;
    h16* H = WSP(h16, OFF_H);
    for (size_t i = (size_t)F.bid * NTHREADS + F.tid; i < (size_t)M * D / 8; i += (size_t)F.G * NTHREADS) {
        const int col = (int)(i & 127) * 8;
        const f32x4 a = *(const f32x4*)(F.pp->x + i * 8), b = *(const f32x4*)(F.pp->x + i * 8 + 4);
        const f32x4 sh0 = *(const f32x4*)(mod + col), sh1 = *(const f32x4*)(mod + col + 4), sc0 = *(const f32x4*)(mod + 1024 + col), sc1 = *(const f32x4*)(mod + 1024 + col + 4);
        const f32x4 r0 = a * (sc0 + 1.0f) + sh0, r1 = b * (sc1 + 1.0f) + sh1;
        u32x4 w; w.x = pk2(r0[0], r0[1]); w.y = pk2(r0[2], r0[3]); w.z = pk2(r1[0], r1[1]); w.w = pk2(r1[2], r1[3]);
        *(u32x4*)(H + i * 8) = w;
    }
}

constexpr int SSEG = 128, NSS = M / SSEG, NCH = SSEG / 16;
constexpr size_t SCR_SE = OFF_BIG, SCR_SI = OFF_BIG + 32 * MiB, SCR_LP = OFF_BIG + 64 * MiB, SCR_OA = OFF_BIG + 80 * MiB;
__device__ __forceinline__ void step_rot(Frame& F, int layer) {
    h16* P = WSP(h16, OFF_PROJ); const f32x2* tab = WSP(f32x2, OFF_TAB);
    for (int idx = F.bid * NTHREADS + F.tid; idx < M * 14; idx += F.G * NTHREADS) {
        const int t = idx / 14, hh = idx % 14;
        const int cb = hh < 4 ? PC_Q + hh * 64 : hh < 8 ? PC_K + (hh - 4) * 64 : hh < 12 ? PD_Q + (hh - 8) * 64 : PD_K + (hh - 12) * 64;
        h16* ptr = P + (size_t)t * INW + cb;
        const h16x8 x1 = *(const h16x8*)ptr, x2 = *(const h16x8*)(ptr + 8);
        h16x8 o1, o2;
#pragma unroll
        for (int i = 0; i < 8; ++i) { const f32x2 cs = tab[t * 8 + i]; const float a = (float)x1[i], b = (float)x2[i]; o1[i] = (h16)(a * cs.x - b * cs.y); o2[i] = (h16)(b * cs.x + a * cs.y); }
        *(h16x8*)ptr = o1; *(h16x8*)(ptr + 8) = o2;
    }
}

template <int N> __device__ __forceinline__ float row_shr(float v) { return __builtin_bit_cast(float, __builtin_amdgcn_update_dpp(0, __builtin_bit_cast(int, v), 0x110 | N, 0xF, 0xF, true)); }
__device__ __forceinline__ float row_scan16(float v) { v += row_shr<1>(v); v += row_shr<2>(v); v += row_shr<4>(v); v += row_shr<8>(v); return v; }
__device__ __forceinline__ h16x4 cvt4(const f32x4 v) { h16x4 r; r[0] = (h16)v[0]; r[1] = (h16)v[1]; r[2] = (h16)v[2]; r[3] = (h16)v[3]; return r; }
#define MFMA16(a, b, c) __builtin_amdgcn_mfma_f32_16x16x16f16((a), (b), (c), 0, 0, 0)
template <bool FULL>
__device__ __forceinline__ void hg_chunk(const h16* __restrict__ P, const int h, const int dir, const int c0, const int lane, const float (&lb)[4][4], f32x4 (&S)[4][4], float (&lp)[4][4], float* __restrict__ OAdir, const h16x4 ident) {
    const int tau = lane & 15, g = lane >> 4;
    const h16* row = P + (size_t)(c0 + (dir ? 15 - tau : tau)) * INW + h * 64 + 4 * g;
    h16x4 zr[4], qr[4], vr[4];
#pragma unroll
    for (int kt = 0; kt < 4; ++kt) { zr[kt] = *(const h16x4*)(row + (dir ? PA_FB : PA_FF) + 16 * kt); vr[kt] = *(const h16x4*)(row + PA_I + 16 * kt); if (FULL) qr[kt] = *(const h16x4*)(row + PA_Q + 16 * kt); }
    float cum[4][4], kkv[4][4], tot[4][4];
#pragma unroll
    for (int kt = 0; kt < 4; ++kt)
#pragma unroll
        for (int j = 0; j < 4; ++j) { const float z = (float)zr[kt][j]; const float e = __expf(-fabsf(z)), r = 1.0f / (1.0f + e); const float sg = z >= 0.f ? r : e * r, nsg = z >= 0.f ? e * r : r;
            const float oml = 1.0f - lb[kt][j]; cum[kt][j] = row_scan16(__logf(lb[kt][j] + oml * sg)); kkv[kt][j] = oml * nsg; }
#pragma unroll
    for (int kt = 0; kt < 4; ++kt)
#pragma unroll
        for (int j = 0; j < 4; ++j) tot[kt][j] = __shfl(cum[kt][j], (lane & 48) | 15);
    const f32x4 zero4 = {0.f, 0.f, 0.f, 0.f};
    h16x4 KT[4], VT[4];
#pragma unroll
    for (int kt = 0; kt < 4; ++kt) { h16x4 kh;
#pragma unroll
        for (int j = 0; j < 4; ++j) kh[j] = (h16)(kkv[kt][j] * __expf(tot[kt][j] - cum[kt][j]));
        KT[kt] = cvt4(MFMA16(kh, ident, zero4)); VT[kt] = cvt4(MFMA16(vr[kt], ident, zero4)); }
    if (FULL) {
        f32x4 sc = zero4; h16x4 QA[4];
#pragma unroll
        for (int kt = 0; kt < 4; ++kt)
#pragma unroll
            for (int j = 0; j < 4; ++j) { const float ref = __shfl(cum[kt][j], (lane & 48) | 7); const float qs = siluf_((float)qr[kt][j]);
                QA[kt][j] = (h16)(qs * __expf(cum[kt][j]));
                sc = __builtin_amdgcn_mfma_f32_16x16x4f32(kkv[kt][j] * __expf(ref - cum[kt][j]), qs * __expf(cum[kt][j] - ref), sc, 0, 0, 0); }
        h16x4 AA;
#pragma unroll
        for (int j = 0; j < 4; ++j) AA[j] = (h16)((4 * g + j <= tau) ? sc[j] : 0.f);
#pragma unroll
        for (int dt = 0; dt < 4; ++dt) { f32x4 o = MFMA16(AA, VT[dt], zero4);
#pragma unroll
            for (int kt = 0; kt < 4; ++kt) o = MFMA16(QA[kt], cvt4(S[kt][dt]), o);
#pragma unroll
            for (int j = 0; j < 4; ++j) { const int to = 4 * g + j; OAdir[(size_t)(c0 + (dir ? 15 - to : to)) * 256 + h * 64 + 16 * dt + tau] = o[j]; } }
    }
#pragma unroll
    for (int kt = 0; kt < 4; ++kt) { float dec[4];
#pragma unroll
        for (int j = 0; j < 4; ++j) { dec[j] = __expf(tot[kt][j]); lp[kt][j] += tot[kt][j]; }
#pragma unroll
        for (int dt = 0; dt < 4; ++dt) { f32x4 sv = S[kt][dt]; sv[0] *= dec[0]; sv[1] *= dec[1]; sv[2] *= dec[2]; sv[3] *= dec[3]; S[kt][dt] = MFMA16(KT[kt], VT[dt], sv); } }
}
__device__ __forceinline__ void hg_setup(const Frame& F, int layer, int h, float (&lb)[4][4], h16x4& ident) {
    const int tau = F.lane & 15, g = F.lane >> 4;
#pragma unroll
    for (int kt = 0; kt < 4; ++kt)
#pragma unroll
        for (int j = 0; j < 4; ++j) { const int c = h * 64 + 16 * kt + 4 * g + j; lb[kt][j] = (layer == 0 ? 0.f : 1.f) * sigmoidf_(F.pp->alb[256 + c] - F.pp->alb[c]); }
#pragma unroll
    for (int j = 0; j < 4; ++j) ident[j] = (h16)((4 * g + j == tau) ? 1.0f : 0.0f);
}
__device__ __forceinline__ void hg_pass1(Frame& F, int layer) {
    const int gw = F.bid * NWAVES + F.wave, NGW = F.G * NWAVES; const int tau = F.lane & 15, g = F.lane >> 4;
    const h16* P = WSP(h16, OFF_PROJ); float* SE = WSP(float, SCR_SE); float* LP = WSP(float, SCR_LP);
    for (int it = gw; it < 8 * NSS; it += NGW) { const int ss = it % NSS, hd = it / NSS, dir = hd & 1, h = hd >> 1;
        float lb[4][4], lp[4][4]; h16x4 ident; f32x4 S[4][4]; hg_setup(F, layer, h, lb, ident);
#pragma unroll
        for (int kt = 0; kt < 4; ++kt)
#pragma unroll
            for (int j = 0; j < 4; ++j) { lp[kt][j] = 0.f; S[kt][j] = (f32x4){0.f, 0.f, 0.f, 0.f}; }
#pragma unroll 1
        for (int ci = 0; ci < NCH; ++ci) hg_chunk<false>(P, h, dir, ss * SSEG + (dir ? NCH - 1 - ci : ci) * 16, F.lane, lb, S, lp, nullptr, ident);
        int l2 = F.lane; asm volatile("" : "+v"(l2));
        float* se = SE + (size_t)it * 4096 + (4 * (l2 >> 4)) * 64 + (l2 & 15);
#pragma unroll
        for (int kt = 0; kt < 4; ++kt)
#pragma unroll
            for (int j = 0; j < 4; ++j) {
#pragma unroll
                for (int dt = 0; dt < 4; ++dt) se[(16 * kt + j) * 64 + 16 * dt] = S[kt][dt][j]; }
        if ((l2 & 15) == 0) {
#pragma unroll
            for (int kt = 0; kt < 4; ++kt)
#pragma unroll
                for (int j = 0; j < 4; ++j) LP[(size_t)it * 64 + 16 * kt + 4 * (l2 >> 4) + j] = lp[kt][j]; }
    }
}
__device__ __forceinline__ void step_hg2(Frame& F) {
    const float* SE = WSP(float, SCR_SE); const float* LP = WSP(float, SCR_LP); float* SI = WSP(float, SCR_SI);
    for (int e = F.bid * NTHREADS + F.tid; e < 8 * 4096; e += F.G * NTHREADS) { const int hd = e >> 12, cd = e & 4095, c = cd >> 6, dir = hd & 1;
        float st = 0.f;
        for (int n0 = 0; n0 < NSS; n0 += 8) { float se[8], lpv[8];
#pragma unroll
            for (int u = 0; u < 8; ++u) { const int n = dir ? NSS - 1 - (n0 + u) : n0 + u; se[u] = SE[((size_t)hd * NSS + n) * 4096 + cd]; lpv[u] = LP[((size_t)hd * NSS + n) * 64 + c]; }
#pragma unroll
            for (int u = 0; u < 8; ++u) { const int n = dir ? NSS - 1 - (n0 + u) : n0 + u; SI[((size_t)hd * NSS + n) * 4096 + cd] = st; st = __expf(lpv[u]) * st + se[u]; } }
    }
}
__device__ __forceinline__ void step_hg3(Frame& F, int layer) {
    const int gw = F.bid * NWAVES + F.wave, NGW = F.G * NWAVES; const int tau = F.lane & 15, g = F.lane >> 4;
    const h16* P = WSP(h16, OFF_PROJ); const float* SI = WSP(float, SCR_SI);
    for (int it = gw; it < 8 * NSS; it += NGW) { const int ss = it % NSS, hd = it / NSS, dir = hd & 1, h = hd >> 1;
        float lb[4][4], lp[4][4]; h16x4 ident; f32x4 S[4][4]; hg_setup(F, layer, h, lb, ident);
        const float* si = SI + (size_t)it * 4096 + (4 * g) * 64 + tau;
#pragma unroll
        for (int kt = 0; kt < 4; ++kt)
#pragma unroll
            for (int dt = 0; dt < 4; ++dt) {
#pragma unroll
                for (int j = 0; j < 4; ++j) S[kt][dt][j] = si[(16 * kt + j) * 64 + 16 * dt];
                lp[kt][dt] = 0.f; }
        float* OAdir = WSP(float, SCR_OA) + (size_t)dir * M * 256;
#pragma unroll 1
        for (int ci = 0; ci < NCH; ++ci) hg_chunk<true>(P, h, dir, ss * SSEG + (dir ? NCH - 1 - ci : ci) * 16, F.lane, lb, S, lp, OAdir, ident);
    }
}
__device__ __forceinline__ void conv_item(Frame& F, int item, int layer) {
    const Params& p = *F.pp;
    float* U = (float*)F.lds;
    float* Yt = U + 62 * 256;
    const h16* P = WSP(h16, OFF_PROJ);
    const int t0 = item * 32;
    for (int i = F.tid; i < 62 * 256; i += NTHREADS) { const int r = i >> 8, c = i & 255, t = t0 - 15 + r; float u = 0.f;
        if (t >= 0 && t < M) { const h16* row = P + (size_t)t * INW; u = (float)row[PB_V + c] * sigmoidf_((float)row[PB_G + c]); }
        U[i] = u; }
    __syncthreads();
    { const int c = F.tid & 255, tg = F.tid >> 8;
      float w[31];
#pragma unroll
      for (int j = 0; j < 31; ++j) w[j] = p.cw[(size_t)layer * 31 * 256 + j * 256 + c];
      const float bias = p.cb[layer * 256 + c];
      for (int tt = tg * 16; tt < tg * 16 + 16; ++tt) { float a = bias;
#pragma unroll
          for (int j = 0; j < 31; ++j) a += w[j] * U[(tt + j) * 256 + c];
          Yt[tt * 256 + c] = a; } }
    __syncthreads();
    { h16* Y = WSP(h16, OFF_Y);
      for (int r = F.wave * 4; r < F.wave * 4 + 4; ++r) {
          const f32x4 v = *(const f32x4*)(Yt + r * 256 + F.lane * 4);
          const float mean = wave_sum((v.x + v.y) + (v.z + v.w)) * (1.f / 256.f);
          const f32x4 d = v - mean;
          const float var = wave_sum((d.x * d.x + d.y * d.y) + (d.z * d.z + d.w * d.w)) * (1.f / 256.f);
          const float rstd = 1.0f / sqrtf(var + LN_EPS);
          const f32x4 nw = *(const f32x4*)(p.cnw + layer * 256 + F.lane * 4), nb = *(const f32x4*)(p.cnb + layer * 256 + F.lane * 4);
          const f32x4 o = d * rstd * nw + nb;
          u32x2 w2; w2.x = pk2(siluf_(o.x), siluf_(o.y)); w2.y = pk2(siluf_(o.z), siluf_(o.w));
          *(u32x2*)(Y + (size_t)(t0 + r) * D + 256 + F.lane * 4) = w2; } }
    __syncthreads();
}
#define ATT_KEY(sidx) do { const int s_ = (sidx); if (s_ >= 0 && s_ < M) { const h16* kr = Pk + (size_t)s_ * INW; const h16* vr = Pv + (size_t)s_ * INW; float sc = 0.f; \
    _Pragma("unroll") for (int c8 = 0; c8 < 8; ++c8) { const h16x8 kk = *(const h16x8*)(kr + 8 * c8); _Pragma("unroll") for (int e = 0; e < 4; ++e) sc = __builtin_amdgcn_fdot2((h16x2){qv[c8][2 * e], qv[c8][2 * e + 1]}, (h16x2){kk[2 * e], kk[2 * e + 1]}, sc, false); } \
    const float mn = fmaxf(m, sc), corr = __expf(m - mn), pw = __expf(sc - mn); l = l * corr + pw; m = mn; \
    _Pragma("unroll") for (int c8 = 0; c8 < 8; ++c8) { const h16x8 vv = *(const h16x8*)(vr + 8 * c8); _Pragma("unroll") for (int e = 0; e < 8; ++e) acc[8 * c8 + e] = acc[8 * c8 + e] * corr + pw * (float)vv[e]; } } } while (0)
__device__ __forceinline__ void attn_naive_item(Frame& F, int item, int layer, int which  ) {
    const int idx = item * NTHREADS + F.tid; const int h = idx >> 14, t = idx & (M - 1);
    const h16* P = WSP(h16, OFF_PROJ);
    const h16* Pq = P + (size_t)t * INW + (which ? PD_Q : PC_Q) + h * 64;
    const h16* Pk = P + (which ? PD_K + (h >> 1) * 64 : PC_K + h * 64);
    const h16* Pv = P + (which ? PD_V + (h >> 1) * 64 : PC_V + h * 64);
    h16x8 qv[8]; float acc[64]; float m = -1e30f, l = 0.f;
#pragma unroll
    for (int c8 = 0; c8 < 8; ++c8) { qv[c8] = *(const h16x8*)(Pq + 8 * c8) * (h16)0.125f;
#pragma unroll
        for (int e = 0; e < 8; ++e) acc[8 * c8 + e] = 0.f; }
    h16* Y = WSP(h16, OFF_Y) + (size_t)t * D + (which ? 768 : 512) + h * 64;
    float scale;
    if (which == 0) {
        for (int j = -64; j <= 64; ++j) ATT_KEY(t + j);
        for (int j = -64; j <= 64; ++j) ATT_KEY(t + 4 * j);
        for (int j = -64; j <= 64; ++j) ATT_KEY(t + 16 * j);
        scale = 1.0f / l;
    } else {
        for (int j = -128; j <= 128; ++j) ATT_KEY(t + j);
        const float sk = F.pp->sink[layer * 4 + h]; const float mt = fmaxf(m, sk), w = __expf(m - mt), den = l * w + __expf(sk - mt);
        scale = w / den;
    }
#pragma unroll
    for (int c8 = 0; c8 < 8; ++c8) { u32x4 w; w.x = pk2(acc[8 * c8] * scale, acc[8 * c8 + 1] * scale); w.y = pk2(acc[8 * c8 + 2] * scale, acc[8 * c8 + 3] * scale);
        w.z = pk2(acc[8 * c8 + 4] * scale, acc[8 * c8 + 5] * scale); w.w = pk2(acc[8 * c8 + 6] * scale, acc[8 * c8 + 7] * scale); *(u32x4*)(Y + 8 * c8) = w; }
}
typedef __attribute__((__vector_size__(4 * sizeof(short)))) short vs4;
typedef __attribute__((address_space(3))) vs4 lds_vs4;
constexpr int ATT_PITCH = 144, ATT_WAVE_LDS = 32 * ATT_PITCH;
struct AttLoad { h16x8 kf[2][2]; u32x4 vc[4]; };
__device__ __forceinline__ void att_load(AttLoad& L, const h16* __restrict__ Kp, const h16* __restrict__ Vp, int tkb, int st, int lane) {
    const int r = lane & 15, g = lane >> 4;
#pragma unroll
    for (int sb = 0; sb < 2; ++sb) { int tk = tkb + (16 * sb + r) * st; tk = tk < 0 ? 0 : (tk > M - 1 ? M - 1 : tk); const h16* kr = Kp + (size_t)tk * INW + 8 * g;
        L.kf[sb][0] = *(const h16x8*)kr; L.kf[sb][1] = *(const h16x8*)(kr + 32); }
#pragma unroll
    for (int n = 0; n < 4; ++n) { int tk = tkb + ((lane >> 3) + 8 * n) * st; tk = tk < 0 ? 0 : (tk > M - 1 ? M - 1 : tk); L.vc[n] = *(const u32x4*)(Vp + (size_t)tk * INW + 8 * (lane & 7)); }
}
template <int WIN>
__device__ __forceinline__ void att_seg(const h16* __restrict__ Kp, const h16* __restrict__ Vp, const int tk0, const int st, const int nblk, const int qo, const h16x8 (&Qf)[2],
                                        float& m, float& l, f32x4 (&O)[4], unsigned char* vlds, const int lane) {
    const int g = lane >> 4;
    AttLoad cur, nxt; att_load(cur, Kp, Vp, tk0, st, lane);
    const f32x4 zero4 = {0.f, 0.f, 0.f, 0.f};
#pragma unroll 1
    for (int blk = 0; blk < nblk; ++blk) {
        const int nb = blk + 1 < nblk ? blk + 1 : blk;
        att_load(nxt, Kp, Vp, tk0 + 32 * nb * st, st, lane);
        LDS_WAIT();
#pragma unroll
        for (int n = 0; n < 4; ++n) *(u32x4*)(vlds + ((lane >> 3) + 8 * n) * ATT_PITCH + 16 * (lane & 7)) = cur.vc[n];
        f32x4 sa = __builtin_amdgcn_mfma_f32_16x16x32_f16(cur.kf[0][0], Qf[0], zero4, 0, 0, 0); sa = __builtin_amdgcn_mfma_f32_16x16x32_f16(cur.kf[0][1], Qf[1], sa, 0, 0, 0);
        f32x4 sb = __builtin_amdgcn_mfma_f32_16x16x32_f16(cur.kf[1][0], Qf[0], zero4, 0, 0, 0); sb = __builtin_amdgcn_mfma_f32_16x16x32_f16(cur.kf[1][1], Qf[1], sb, 0, 0, 0);
        float sv[8]; bool ok[8]; float bm = -1e30f;
#pragma unroll
        for (int e = 0; e < 8; ++e) { const int kk = 32 * blk + 16 * (e >> 2) + 4 * g + (e & 3); const int tk = tk0 + kk * st;
            ok[e] = ((unsigned)(kk - qo) <= (unsigned)WIN) && ((unsigned)tk < (unsigned)M); sv[e] = e < 4 ? sa[e & 3] : sb[e & 3]; bm = ok[e] ? fmaxf(bm, sv[e]) : bm; }
        bm = fmaxf(bm, __shfl_xor(bm, 16)); bm = fmaxf(bm, __shfl_xor(bm, 32));
        const float mn = fmaxf(m, bm), corr = __expf(m - mn); m = mn;
        float ps = 0.f; h16x8 pf;
#pragma unroll
        for (int e = 0; e < 8; ++e) { const float pe = ok[e] ? __expf(sv[e] - mn) : 0.f; ps += pe; pf[e] = (h16)pe; }
        l = l * corr + ps;
        LDS_WAIT();
#pragma unroll
        for (int dt = 0; dt < 4; ++dt) {
            const int q4 = (lane >> 2) & 3, p4 = lane & 3;
            const vs4 r0 = __builtin_amdgcn_ds_read_tr16_b64_v4i16((lds_vs4*)(vlds + (4 * g + q4) * ATT_PITCH + (16 * dt + 4 * p4) * 2));
            const vs4 r1 = __builtin_amdgcn_ds_read_tr16_b64_v4i16((lds_vs4*)(vlds + (16 + 4 * g + q4) * ATT_PITCH + (16 * dt + 4 * p4) * 2));
            typedef short s16x8 __attribute__((ext_vector_type(8)));
            s16x8 vv; vv[0] = r0[0]; vv[1] = r0[1]; vv[2] = r0[2]; vv[3] = r0[3]; vv[4] = r1[0]; vv[5] = r1[1]; vv[6] = r1[2]; vv[7] = r1[3];
            f32x4 o = O[dt]; o[0] *= corr; o[1] *= corr; o[2] *= corr; o[3] *= corr;
            O[dt] = __builtin_amdgcn_mfma_f32_16x16x32_f16(__builtin_bit_cast(h16x8, vv), pf, o, 0, 0, 0); }
        cur = nxt;
    }
}
__device__ __forceinline__ void att_unit(Frame& F, int u, int layer) {
    const int lane = F.lane, i = lane & 15, g = lane >> 4;
    const h16* P = WSP(h16, OFF_PROJ); h16* Y = WSP(h16, OFF_Y);
    unsigned char* vlds = F.lds + F.wave * ATT_WAVE_LDS;
    float m = -1e30f, l = 0.f; f32x4 O[4];
#pragma unroll
    for (int dt = 0; dt < 4; ++dt) O[dt] = (f32x4){0.f, 0.f, 0.f, 0.f};
    h16x8 Qf[2]; int tq, h; float scale;
    if (u < 4096) {
        const int r = u & 15; h = (u >> 4) & 3; const int b = u >> 6; const int tq0 = 256 * b + r; tq = tq0 + 16 * i;
        const h16* qp = P + (size_t)tq * INW + PC_Q + h * 64 + 8 * g; Qf[0] = *(const h16x8*)qp * (h16)0.125f; Qf[1] = *(const h16x8*)(qp + 32) * (h16)0.125f;
        const h16* Kp = P + PC_K + h * 64; const h16* Vp = P + PC_V + h * 64;
        att_seg<128>(Kp, Vp, tq0 - 64 * 16, 16, 5, i, Qf, m, l, O, vlds, lane);
        att_seg<128>(Kp, Vp, tq0 - 64 * 4, 4, 6, 4 * i, Qf, m, l, O, vlds, lane);
        att_seg<128>(Kp, Vp, tq0 - 64, 1, 12, 16 * i, Qf, m, l, O, vlds, lane);
        l += __shfl_xor(l, 16); l += __shfl_xor(l, 32);
        scale = 1.0f / l;
    } else {
        const int v = u - 4096; h = v >> 10; const int tq0 = (v & 1023) * 16; tq = tq0 + i;
        const h16* qp = P + (size_t)tq * INW + PD_Q + h * 64 + 8 * g; Qf[0] = *(const h16x8*)qp * (h16)0.125f; Qf[1] = *(const h16x8*)(qp + 32) * (h16)0.125f;
        const h16* Kp = P + PD_K + (h >> 1) * 64; const h16* Vp = P + PD_V + (h >> 1) * 64;
        att_seg<256>(Kp, Vp, tq0 - 128, 1, 9, i, Qf, m, l, O, vlds, lane);
        l += __shfl_xor(l, 16); l += __shfl_xor(l, 32);
        const float sk = F.pp->sink[layer * 4 + h]; const float mt = fmaxf(m, sk), w = __expf(m - mt), den = l * w + __expf(sk - mt);
        scale = w / den;
    }
    h16* yo = Y + (size_t)tq * D + (u < 4096 ? 512 : 768) + h * 64 + 4 * g;
#pragma unroll
    for (int dt = 0; dt < 4; ++dt) { u32x2 w2; w2.x = pk2(O[dt][0] * scale, O[dt][1] * scale); w2.y = pk2(O[dt][2] * scale, O[dt][3] * scale); *(u32x2*)(yo + 16 * dt) = w2; }
}
__device__ __forceinline__ void step_mix(Frame& F, int layer) {
    constexpr int N_CONV = M / 32;
    hg_pass1(F, layer);
    for (int it = F.bid; it < N_CONV; it += F.G) conv_item(F, it, layer);
#if ATT_NAIVE
    for (int it = F.bid; it < 256; it += F.G) attn_naive_item(F, it & 127, layer, it >> 7);
#else
    { const int gw = F.bid * NWAVES + F.wave, NGW = F.G * NWAVES;
#pragma unroll 1
      for (int u = gw; u < 8192; u += NGW) att_unit(F, u, layer); }
#endif
}
__device__ __forceinline__ void step_afin(Frame& F, int layer) {
    const float* OA = WSP(float, SCR_OA); const h16* P = WSP(h16, OFF_PROJ); h16* Y = WSP(h16, OFF_Y);
    const int gw = F.bid * NWAVES + F.wave, NGW = F.G * NWAVES;
    const float nw = F.pp->anw[layer * 64 + F.lane];
    for (int it = gw; it < M * 4; it += NGW) { const int t = it >> 2, h = it & 3;
        const float o = OA[(size_t)t * 256 + h * 64 + F.lane] + OA[(size_t)M * 256 + (size_t)t * 256 + h * 64 + F.lane];
        const float ms = wave_sum(o * o) * (1.f / 64.f);
        const float g = (float)P[(size_t)t * INW + PA_G + h * 64 + F.lane];
        Y[(size_t)t * D + h * 64 + F.lane] = (h16)(o * (1.0f / sqrtf(ms + RMS_EPS)) * nw * siluf_(g)); }
}

struct LnArgs { const float* xin; const float* gate; const float* lw; const float* lb; const float* nscale; const float* nshift; float* xout; h16* hout; };
__device__ __forceinline__ void ln_core(const Frame& F, const LnArgs& a, int row, const f32x4 (&fv)[4], f32x4 (&hv)[4]) {
    f32x4 tv[4]; float s = 0.f;
#pragma unroll
    for (int j = 0; j < 4; ++j) { const int col = F.lane * 4 + 256 * j; const f32x4 xi = *(const f32x4*)(a.xin + (size_t)row * D + col), g = *(const f32x4*)(a.gate + col);
        tv[j] = xi * ALPHA + (g + 1.0f) * fv[j]; s += (tv[j].x + tv[j].y) + (tv[j].z + tv[j].w); }
    const float mean = wave_sum(s) * (1.f / D); float s2 = 0.f;
#pragma unroll
    for (int j = 0; j < 4; ++j) { tv[j] = tv[j] - mean; s2 += (tv[j].x * tv[j].x + tv[j].y * tv[j].y) + (tv[j].z * tv[j].z + tv[j].w * tv[j].w); }
    const float rstd = 1.0f / sqrtf(wave_sum(s2) * (1.f / D) + LN_EPS);
#pragma unroll
    for (int j = 0; j < 4; ++j) { const int col = F.lane * 4 + 256 * j; const f32x4 w = *(const f32x4*)(a.lw + col), b = *(const f32x4*)(a.lb + col);
        const f32x4 xo = tv[j] * rstd * w + b;
        *(f32x4*)(a.xout + (size_t)row * D + col) = xo;
        if (a.hout) { const f32x4 sc = *(const f32x4*)(a.nscale + col), sh = *(const f32x4*)(a.nshift + col); hv[j] = xo * (sc + 1.0f) + sh;
            u32x2 w2; w2.x = pk2(hv[j].x, hv[j].y); w2.y = pk2(hv[j].z, hv[j].w); *(u32x2*)(a.hout + (size_t)row * D + col) = w2; } }
}
__device__ __forceinline__ void step_ln_dense(Frame& F, const LnArgs& a, const float* Z, bool router) {
    const int gw = F.bid * NWAVES + F.wave, NGW = F.G * NWAVES;
    unsigned* cnt = (unsigned*)(F.ws + OFF_CTL) + CW_CNT; unsigned* tok = WSP(unsigned, OFF_TOK);
    unsigned* lcnt = (unsigned*)F.lds;
    if (router) { if (F.tid < 8) lcnt[F.tid] = 0u; __syncthreads(); }
    for (int row = gw; row < M; row += NGW) {
        f32x4 fv[4], hv[4];
#pragma unroll
        for (int j = 0; j < 4; ++j) fv[j] = *(const f32x4*)(Z + (size_t)row * D + F.lane * 4 + 256 * j);
        ln_core(F, a, row, fv, hv);
        if (router) {
            float lg[8];
#pragma unroll
            for (int e = 0; e < 8; ++e) lg[e] = 0.f;
#pragma unroll
            for (int j = 0; j < 4; ++j)
#pragma unroll
                for (int i = 0; i < 4; ++i) { const int col = F.lane * 4 + 256 * j + i; const f32x4 w0 = *(const f32x4*)(F.pp->rout + (size_t)col * 8), w1 = *(const f32x4*)(F.pp->rout + (size_t)col * 8 + 4); const float hval = hv[j][i];
                    lg[0] += hval * w0.x; lg[1] += hval * w0.y; lg[2] += hval * w0.z; lg[3] += hval * w0.w; lg[4] += hval * w1.x; lg[5] += hval * w1.y; lg[6] += hval * w1.z; lg[7] += hval * w1.w; }
#pragma unroll
            for (int e = 0; e < 8; ++e) lg[e] = wave_sum(lg[e]);
            int e1 = 0; float l1 = lg[0];
#pragma unroll
            for (int e = 1; e < 8; ++e) if (lg[e] > l1) { l1 = lg[e]; e1 = e; }
            int e2 = -1; float l2 = -3.0e38f;
#pragma unroll
            for (int e = 0; e < 8; ++e) if (e != e1 && lg[e] > l2) { l2 = lg[e]; e2 = e; }
            const float g1 = 1.0f / (1.0f + __expf(l2 - l1)), g2 = 1.0f - g1;
            if (F.lane == 0) { tok[row * 8 + 0] = (unsigned)e1; tok[row * 8 + 1] = (unsigned)e2; tok[row * 8 + 2] = __float_as_uint(g1); tok[row * 8 + 3] = __float_as_uint(g2);
                atomicAdd(lcnt + e1, 1u); atomicAdd(lcnt + e2, 1u); }
        }
    }
    if (router) { __syncthreads(); if (F.tid < 8) atomicAdd(cnt + F.tid, lcnt[F.tid]); }
}
__device__ __forceinline__ void step_slot(Frame& F) {
    const unsigned* cnt = (const unsigned*)(F.ws + OFF_CTL) + CW_CNT; unsigned* cur = (unsigned*)(F.ws + OFF_CTL) + CW_CUR; unsigned* tok = WSP(unsigned, OFF_TOK);
    const h16* H = WSP(h16, OFF_H); h16* HG = WSP(h16, OFF_PROJ);
    unsigned off[8]; { unsigned o = 0;
#pragma unroll
        for (int e = 0; e < 8; ++e) { off[e] = o; o += ((cnt[e] + 255u) >> 8) << 8; } }
    const int gw = F.bid * NWAVES + F.wave, NGW = F.G * NWAVES;
    unsigned* lw = (unsigned*)F.lds;
    if (F.tid < 16) lw[F.tid] = 0u;
    __syncthreads();
    for (int row = gw; row < M; row += NGW) if (F.lane == 0) { atomicAdd(lw + tok[row * 8 + 0], 1u); atomicAdd(lw + tok[row * 8 + 1], 1u); }
    __syncthreads();
    if (F.tid < 8) { unsigned o = 0;
#pragma unroll
        for (int e = 0; e < 8; ++e) o = ((unsigned)F.tid == (unsigned)e) ? off[e] : o;
        lw[8 + F.tid] = o + atomicAdd(cur + F.tid, lw[F.tid]); }
    __syncthreads();
    for (int row = gw; row < M; row += NGW) {
        const unsigned e1 = tok[row * 8 + 0], e2 = tok[row * 8 + 1];
        unsigned s1 = 0, s2 = 0;
        if (F.lane == 0) { s1 = atomicAdd(lw + 8 + e1, 1u); s2 = atomicAdd(lw + 8 + e2, 1u); tok[row * 8 + 4] = s1; tok[row * 8 + 5] = s2; }
        s1 = __shfl(s1, 0); s2 = __shfl(s2, 0);
        const u32x4 a = *(const u32x4*)(H + (size_t)row * D + F.lane * 8), b = *(const u32x4*)(H + (size_t)row * D + 512 + F.lane * 8);
        *(u32x4*)(HG + (size_t)s1 * D + F.lane * 8) = a; *(u32x4*)(HG + (size_t)s1 * D + 512 + F.lane * 8) = b;
        *(u32x4*)(HG + (size_t)s2 * D + F.lane * 8) = a; *(u32x4*)(HG + (size_t)s2 * D + 512 + F.lane * 8) = b;
    }
    __syncthreads();
}
__device__ __forceinline__ void step_ln_moe(Frame& F, const LnArgs& a) {
    const int gw = F.bid * NWAVES + F.wave, NGW = F.G * NWAVES;
    const unsigned* tok = WSP(unsigned, OFF_TOK); const float* YS = WSP(float, OFF_PROJ);
    for (int row = gw; row < M; row += NGW) {
        const float g1 = __uint_as_float(tok[row * 8 + 2]), g2 = __uint_as_float(tok[row * 8 + 3]); const unsigned s1 = tok[row * 8 + 4], s2 = tok[row * 8 + 5];
        f32x4 fv[4], hv[4];
#pragma unroll
        for (int j = 0; j < 4; ++j) { const int col = F.lane * 4 + 256 * j; fv[j] = *(const f32x4*)(YS + (size_t)s1 * D + col) * g1 + *(const f32x4*)(YS + (size_t)s2 * D + col) * g2; }
        ln_core(F, a, row, fv, hv);
    }
}

constexpr int N_STEPS = 25;
#ifndef KMASK
#define KMASK 0xFFFFF
#endif
#define KON(k) ((KMASK >> (k)) & 1)
__global__ void __launch_bounds__(NTHREADS, 2) fwd_kernel(Params kp) {
    extern __shared__ __attribute__((aligned(16))) unsigned char lds[];
    Frame F; F.lds = lds; F.tid = threadIdx.x; F.lane = F.tid & 63; F.wave = __builtin_amdgcn_readfirstlane(F.tid >> 6); F.G = gridDim.x; F.bid = blockIdx.x; F.ws = kp.ws;
    LAS unsigned char* ldsl = (LAS unsigned char*)lds;
    const int lo = kp.lo, hi = kp.hi; int rep1 = 0;
    if (threadIdx.x < 4) ((LAS unsigned*)(ldsl + LDS_BARST))[threadIdx.x] = 0u;
    __syncthreads();
    const XcdBarrier xbar = xcd_barrier_post((unsigned*)(kp.ws + OFF_CTL) + CW_BAR, (volatile LAS unsigned*)(ldsl + LDS_BARST));
    for (int s = lo; s < hi; ++s) {
        { const Params* pp_ = (const Params*)__builtin_amdgcn_kernarg_segment_ptr(); asm volatile("" : "+s"(pp_) :: "memory"); F.pp = pp_; unsigned char* ws_ = kp.ws; asm volatile("" : "+s"(ws_)); F.ws = ws_; }
        const Params& p = *F.pp;
        { int tid_ = threadIdx.x; asm volatile("" : "+v"(tid_)); F.tid = tid_; F.lane = tid_ & 63; F.wave = __builtin_amdgcn_readfirstlane(tid_ >> 6); }
        int layer = 0, kind = s;
        if (s >= 13) { layer = 1; kind = s - 11; }
        const float* mod = (const float*)(F.ws + OFF_CTL) + CW_MOD;
        const float* modl = mod + layer * 6144;
        if (KON(0) && s == 0) step_pre(F);
        else if (KON(1) && s == 1) step_h0(F);
        else if (KON(2) && kind == 2) { g8::DenseOrder S; S.init(WSP(h16, OFF_H), WSP(h16, OFF_WT_IN) + (size_t)layer * INW * D, M, INW, D, F.G, F.bid); g8::EpiF16 E{WSP(h16, OFF_PROJ), INW}; g8::gemm_phase(ldsl, F.tid, D, S, E); }
        else if (KON(3) && kind == 3) step_rot(F, layer);
        else if (KON(4) && kind == 4) { step_mix(F, layer); if (PROBE_DUP & 4) { __syncthreads(); step_mix(F, layer); } }
        else if (KON(5) && kind == 5) { step_hg2(F); if (PROBE_DUP & 4) step_hg2(F); }
        else if (KON(6) && kind == 6) { step_hg3(F, layer); if (PROBE_DUP & 4) step_hg3(F, layer); }
        else if (KON(7) && kind == 7) { step_afin(F, layer); if (PROBE_DUP & 4) step_afin(F, layer); }
        else if (KON(8) && kind == 8) { g8::DenseOrder S; S.init(WSP(h16, OFF_Y), WSP(h16, OFF_WT_OUT) + (size_t)layer * D * D, M, D, D, F.G, F.bid); g8::EpiF32 E{WSP(float, OFF_Z), D}; g8::gemm_phase(ldsl, F.tid, D, S, E); }
        else if (KON(9) && kind == 9) { LnArgs a{layer == 0 ? p.x : WSP(float, OFF_X), modl + 2048, p.lnw + (size_t)(layer * 2) * D, p.lnb + (size_t)(layer * 2) * D, modl + 4096, modl + 3072, WSP(float, OFF_X), WSP(h16, OFF_H)};
            step_ln_dense(F, a, WSP(float, OFF_Z), layer == 1); }
        else if (KON(10) && layer == 0 && kind == 10) { g8::DenseOrder S; S.init(WSP(h16, OFF_H), WSP(h16, OFF_WT_UP), M, 2 * FFN, D, F.G, F.bid); g8::EpiSwiGLU E{WSP(h16, OFF_PROJ), FFN}; g8::gemm_phase(ldsl, F.tid, D, S, E); }
        else if (KON(11) && layer == 0 && kind == 11) { g8::DenseOrder S; S.init(WSP(h16, OFF_PROJ), WSP(h16, OFF_WT_DOWN), M, D, FFN, F.G, F.bid); g8::EpiF32 E{WSP(float, OFF_Z), D}; g8::gemm_phase(ldsl, F.tid, FFN, S, E); }
        else if (KON(12) && layer == 0 && kind == 12) { LnArgs a{WSP(float, OFF_X), modl + 5120, p.lnw + (size_t)1 * D, p.lnb + (size_t)1 * D, mod + 6144 + 1024, mod + 6144 + 0, WSP(float, OFF_X), WSP(h16, OFF_H)};
            step_ln_dense(F, a, WSP(float, OFF_Z), false); }
        else if (KON(13) && layer == 1 && kind == 10) step_slot(F);
        else if (KON(14) && layer == 1 && kind == 11) { g8::MoeOrder S; S.init(WSP(h16, OFF_PROJ), WSP(h16, OFF_WT_MUP), (size_t)2 * EDIM * D * 2, 2 * EDIM, D, F.G, F.bid, (const unsigned*)(F.ws + OFF_CTL) + CW_CNT);
            g8::EpiSwiGLU E{WSP(h16, OFF_BIG), EDIM}; g8::gemm_phase(ldsl, F.tid, D, S, E); }
        else if (KON(15) && layer == 1 && kind == 12) { g8::MoeOrder S; S.init(WSP(h16, OFF_BIG), WSP(h16, OFF_WT_MDOWN), (size_t)D * EDIM * 2, D, EDIM, F.G, F.bid, (const unsigned*)(F.ws + OFF_CTL) + CW_CNT);
            g8::EpiF32 E{WSP(float, OFF_PROJ), D}; g8::gemm_phase(ldsl, F.tid, EDIM, S, E); }
        else if (KON(16) && layer == 1 && kind == 13) { LnArgs a{WSP(float, OFF_X), modl + 5120, p.lnw + (size_t)3 * D, p.lnb + (size_t)3 * D, nullptr, nullptr, p.out, nullptr}; step_ln_moe(F, a); }
        if (s + 1 < hi) { if (s == lo) cg::this_grid().sync(); else xcd_barrier(xbar); if (PROBE_DUP & 2) xcd_barrier(xbar); }
        if (PROBE_DUP & 1) { const bool isg = (kind == 2 || kind == 8 || (layer == 0 && (kind == 10 || kind == 11)) || (layer == 1 && (kind == 11 || kind == 12))) && s >= 2; if (isg && rep1 == 0) { rep1 = 1; --s; } else rep1 = 0; }
    }
}

extern "C" void kernel_launch(void* const* d_in, const int* in_sizes, int n_in, void* d_out, int out_size, void* d_ws, size_t ws_size, hipStream_t stream) {
    static int grid = 0;
    if (grid == 0) {
        if (n_in != 21 || in_sizes[0] != M * D || out_size != M * D || ws_size < OFF_END) { fprintf(stderr, "kernel_launch: unexpected shapes / workspace (%d inputs, ws %zu, need %zu)\n", n_in, ws_size, (size_t)OFF_END); grid = -1; return; }
        int dev = 0, cus = 0, per_cu = 0;
        hipGetDevice(&dev); hipDeviceGetAttribute(&cus, hipDeviceAttributeMultiprocessorCount, dev);
        hipFuncSetAttribute((const void*)fwd_kernel, hipFuncAttributeMaxDynamicSharedMemorySize, LDS_BYTES);
        hipOccupancyMaxActiveBlocksPerMultiprocessor(&per_cu, (const void*)fwd_kernel, NTHREADS, LDS_BYTES);
        if (per_cu < 1) { fprintf(stderr, "kernel_launch: occupancy query says %d blocks per CU\n", per_cu); per_cu = 1; }
        grid = cus * 1;
        fprintf(stderr, "kernel_launch: grid %d (cus %d, per_cu %d), ws %zu\n", grid, cus, per_cu, ws_size);
    }
    if (grid < 0) return;
    hipMemsetAsync((char*)d_ws + OFF_CTL, 0, CTL_BYTES, stream);
    Params p{};
    p.x = (const float*)d_in[0]; p.c = (const float*)d_in[1]; p.pos = (const int*)d_in[2]; p.w_ada = (const float*)d_in[3]; p.b_ada = (const float*)d_in[4];
    p.w_in = (const float*)d_in[5]; p.w_out = (const float*)d_in[6]; p.alb = (const float*)d_in[7]; p.anw = (const float*)d_in[8]; p.cw = (const float*)d_in[9];
    p.cb = (const float*)d_in[10]; p.cnw = (const float*)d_in[11]; p.cnb = (const float*)d_in[12]; p.sink = (const float*)d_in[13]; p.lnw = (const float*)d_in[14];
    p.lnb = (const float*)d_in[15]; p.fup = (const float*)d_in[16]; p.fdown = (const float*)d_in[17]; p.rout = (const float*)d_in[18]; p.mup = (const float*)d_in[19];
    p.mdown = (const float*)d_in[20]; p.out = (float*)d_out; p.ws = (unsigned char*)d_ws;
#if MK_ONE_LAUNCH
    p.lo = 0; p.hi = N_STEPS;
    { void* args[] = {&p}; hipError_t e = hipLaunchCooperativeKernel((const void*)fwd_kernel, dim3(grid), dim3(NTHREADS), args, LDS_BYTES, stream);
      if (e != hipSuccess) fprintf(stderr, "cooperative launch failed: %s\n", hipGetErrorString(e)); }
#else
    for (int s = 0; s < N_STEPS; ++s) { p.lo = s; p.hi = s + 1;
        void* args[] = {&p}; hipError_t e = hipLaunchCooperativeKernel((const void*)fwd_kernel, dim3(grid), dim3(NTHREADS), args, LDS_BYTES, stream);
        if (e != hipSuccess) { fprintf(stderr, "launch %d failed: %s\n", s, hipGetErrorString(e)); break; } }
#endif
}
```

```cpp
#include <hip/hip_runtime.h>
#include <hip/hip_cooperative_groups.h>
#include <cstdio>
#include <cstdint>
namespace cg = cooperative_groups;

#ifndef ATT_NAIVE
#define ATT_NAIVE 0
#endif
#ifndef PROBE_DUP
#define PROBE_DUP 0
#endif
#ifndef MK_ONE_LAUNCH
#define MK_ONE_LAUNCH 1
#endif

#define LAS __attribute__((address_space(3)))
typedef _Float16 h16;
typedef h16 h16x8 __attribute__((ext_vector_type(8)));
typedef h16 h16x4 __attribute__((ext_vector_type(4)));
typedef h16 h16x2 __attribute__((ext_vector_type(2)));
typedef float f32x4 __attribute__((ext_vector_type(4)));
typedef float f32x2 __attribute__((ext_vector_type(2)));
typedef unsigned u32x4 __attribute__((ext_vector_type(4)));
typedef unsigned u32x2 __attribute__((ext_vector_type(2)));

constexpr int M = 16384, D = 1024, INW = 3072, FFN = 2816, NE = 8, EDIM = 3584;
constexpr int MOE_ROWS = 2 * M + NE * 256;
constexpr float ALPHA = 1.41421356237309515f;
constexpr float LN_EPS = 1e-5f, RMS_EPS = 1e-6f;
constexpr int NTHREADS = 512, NWAVES = 8;
constexpr int LDS_BYTES = 139264;

constexpr int PA_Q = 0, PA_FF = 256, PA_FB = 512, PA_I = 768, PA_G = 1024, PB_V = 1280, PB_G = 1536;
constexpr int PC_Q = 1792, PC_K = 2048, PC_V = 2304, PD_Q = 2560, PD_K = 2816, PD_V = 2944;

constexpr size_t MiB = 1u << 20;
constexpr size_t OFF_CTL = 0, CTL_BYTES = 1 * MiB;
constexpr size_t OFF_TAB = 1 * MiB;
constexpr size_t OFF_TOK = 2 * MiB;
constexpr size_t OFF_WT_IN = 4 * MiB;
constexpr size_t OFF_WT_OUT = 16 * MiB;
constexpr size_t OFF_WT_UP = 20 * MiB;
constexpr size_t OFF_WT_DOWN = 31 * MiB;
constexpr size_t OFF_WT_MUP = 37 * MiB;
constexpr size_t OFF_WT_MDOWN = 149 * MiB;
constexpr size_t OFF_X = 205 * MiB;
constexpr size_t OFF_H = 269 * MiB;
constexpr size_t OFF_Y = 301 * MiB;
constexpr size_t OFF_Z = 333 * MiB;
constexpr size_t OFF_PROJ = 397 * MiB;
constexpr size_t OFF_BIG = 533 * MiB;
constexpr size_t OFF_END = 775 * MiB;
constexpr int CW_MOD = 1024;
constexpr int CW_CNT = 64;
constexpr int CW_CUR = 128;
constexpr int CW_BAR = 16384;
constexpr int LDS_BARST = LDS_BYTES - 16;

struct Params {
    const float* x; const float* c; const int* pos; const float* w_ada; const float* b_ada; const float* w_in; const float* w_out;
    const float* alb; const float* anw; const float* cw; const float* cb; const float* cnw; const float* cnb; const float* sink;
    const float* lnw; const float* lnb; const float* fup; const float* fdown; const float* rout; const float* mup; const float* mdown;
    float* out; unsigned char* ws; int lo, hi;
};

__device__ __forceinline__ unsigned pk2(float lo, float hi) { h16x2 v; v.x = (h16)lo; v.y = (h16)hi; return __builtin_bit_cast(unsigned, v); }
__device__ __forceinline__ float sigmoidf_(float v) { return 1.0f / (1.0f + __expf(-v)); }
__device__ __forceinline__ float siluf_(float v) { return v / (1.0f + __expf(-v)); }
__device__ __forceinline__ float wave_sum(float v) {
#pragma unroll
    for (int o = 1; o < 64; o <<= 1) v += __shfl_xor(v, o);
    return v;
}
#define LDS_WAIT() asm volatile("s_waitcnt lgkmcnt(0)" ::: "memory")

namespace g8 {
constexpr int BM = 256, BK = 64, HALF = 128, HTB = HALF * BK * 2, STAGE_BYTES = 8 * HTB, NXCD = 8, WGM = 8;
__device__ __forceinline__ int lds_byte(int r, int c) { const int st = (r >> 4) * 2 + (c >> 5), rr = r & 15, cc = c & 31, ob = rr * 64 + cc * 2; return st * 1024 + (ob ^ (((ob >> 9) & 1) << 5)); }
__device__ __forceinline__ void stage_rc(int b, int& R, int& C) { const int st = b / 1024, sb = b % 1024, swz = sb ^ (((sb >> 9) & 1) << 5); R = (st >> 1) * 16 + swz / 64; C = (st & 1) * 32 + (swz % 64) / 2; }
__device__ __forceinline__ int perm32(int rho) { const int n = rho >> 4, i = rho & 15; return 8 * (i >> 2) + 4 * n + (i & 3); }

struct Unit { const char* A; const char* B; int pm, pn; };

__device__ __forceinline__ void tile_of(int L, int nM, int nN, int& pm, int& pn) {
    const int nwg = nM * nN; int wgid = L;
    { const int q = nwg / NXCD, r = nwg % NXCD, xcd = wgid % NXCD, off = wgid / NXCD; wgid = (xcd < r ? xcd * (q + 1) : r * (q + 1) + (xcd - r) * q) + off; }
    const int nig = WGM * nN, gid = wgid / nig, fm = gid * WGM, gsz = (nM - fm) < WGM ? (nM - fm) : WGM;
    pm = fm + ((wgid % nig) % gsz); pn = (wgid % nig) / gsz;
}
struct DenseOrder {
    const char* A; const char* B; int K, nM, nN, G, c;
    __device__ void init(const void* A_, const void* B_, int Mr, int N, int K_, int G_, int c_) { A = (const char*)A_; B = (const char*)B_; K = K_; nM = Mr / BM; nN = N / BM; G = G_; c = c_; }
    __device__ __forceinline__ bool next(int i, Unit& u) const {
        const long L = (long)i * G + c; if (L >= (long)nM * nN) return false;
        tile_of((int)L, nM, nN, u.pm, u.pn);
        u.A = A + (size_t)u.pm * BM * K * 2; u.B = B + (size_t)u.pn * BM * K * 2; return true;
    }
};
struct MoeOrder {
    const char* A; const char* B; size_t bstride; int K, nM, nN, G, c; int t1, t2, t3, t4, t5, t6, t7;
    __device__ void init(const void* A_, const void* B_, size_t bstride_, int N, int K_, int G_, int c_, const unsigned* cnt) {
        A = (const char*)A_; B = (const char*)B_; bstride = bstride_; K = K_; nN = N / BM; G = G_; c = c_;
        int t = 0;
#define RT_(e) ((int)((__builtin_amdgcn_readfirstlane((int)cnt[e]) + 255) >> 8))
        t += RT_(0); t1 = t; t += RT_(1); t2 = t; t += RT_(2); t3 = t; t += RT_(3); t4 = t; t += RT_(4); t5 = t; t += RT_(5); t6 = t; t += RT_(6); t7 = t; t += RT_(7); nM = t;
#undef RT_
    }
    __device__ __forceinline__ bool next(int i, Unit& u) const {
        const long L = (long)i * G + c; if (L >= (long)nM * nN) return false;
        tile_of((int)L, nM, nN, u.pm, u.pn);
        const int e = (u.pm >= t1) + (u.pm >= t2) + (u.pm >= t3) + (u.pm >= t4) + (u.pm >= t5) + (u.pm >= t6) + (u.pm >= t7);
        u.A = A + (size_t)u.pm * BM * K * 2; u.B = B + (size_t)e * bstride + (size_t)u.pn * BM * K * 2; return true;
    }
};

struct EpiF16 {
    static constexpr bool PERM = true;
    h16* O; int ldc;
    __device__ __forceinline__ void operator()(const f32x4 (&acc)[2][2][4][2], const Unit& u, int wr, int wc, int fr, int fq) const {
        const int row0 = u.pm * BM + wr * 64 + fr, col0 = u.pn * BM + wc * 32 + 8 * fq;
#pragma unroll
        for (int ai = 0; ai < 2; ++ai)
#pragma unroll
            for (int m = 0; m < 4; ++m) { h16* rowp = O + (size_t)(row0 + ai * HALF + m * 16) * ldc + col0;
#pragma unroll
                for (int bj = 0; bj < 2; ++bj) { const f32x4 v0 = acc[ai][bj][m][0], v1 = acc[ai][bj][m][1];
                    u32x4 w; w.x = pk2(v0[0], v0[1]); w.y = pk2(v0[2], v0[3]); w.z = pk2(v1[0], v1[1]); w.w = pk2(v1[2], v1[3]);
                    *(u32x4*)(rowp + bj * HALF) = w; } }
    }
};
struct EpiSwiGLU {
    static constexpr bool PERM = true;
    h16* O; int ldh;
    __device__ __forceinline__ void operator()(const f32x4 (&acc)[2][2][4][2], const Unit& u, int wr, int wc, int fr, int fq) const {
        const int row0 = u.pm * BM + wr * 64 + fr, col0 = u.pn * (BM / 2) + wc * 16 + 4 * fq;
#pragma unroll
        for (int ai = 0; ai < 2; ++ai)
#pragma unroll
            for (int m = 0; m < 4; ++m) { h16* rowp = O + (size_t)(row0 + ai * HALF + m * 16) * ldh + col0;
#pragma unroll
                for (int bj = 0; bj < 2; ++bj) { const f32x4 g = acc[ai][bj][m][0], up = acc[ai][bj][m][1];
                    u32x2 w; w.x = pk2(siluf_(g[0]) * up[0], siluf_(g[1]) * up[1]); w.y = pk2(siluf_(g[2]) * up[2], siluf_(g[3]) * up[3]);
                    *(u32x2*)(rowp + bj * (HALF / 2)) = w; } }
    }
};
struct EpiF32 {
    static constexpr bool PERM = false;
    float* C; int ldc;
    __device__ __forceinline__ void operator()(const f32x4 (&acc)[2][2][4][2], const Unit& u, int wr, int wc, int fr, int fq) const {
        const int row0 = u.pm * BM + wr * 64 + fr, col0 = u.pn * BM + wc * 32 + 4 * fq;
#pragma unroll
        for (int ai = 0; ai < 2; ++ai)
#pragma unroll
            for (int m = 0; m < 4; ++m) { float* rowp = C + (size_t)(row0 + ai * HALF + m * 16) * ldc + col0;
#pragma unroll
                for (int bj = 0; bj < 2; ++bj)
#pragma unroll
                    for (int n = 0; n < 2; ++n) *(f32x4*)(rowp + bj * HALF + n * 16) = acc[ai][bj][m][n]; }
    }
};

template <class Epi, class Sched>
__device__ __forceinline__ void gemm_phase(LAS unsigned char* lds, const int tid, const int K, const Sched& S, const Epi& E) {
    const int wid = __builtin_amdgcn_readfirstlane(tid >> 6), lane = tid & 63, wr = wid >> 2, wc = wid & 3, fr = lane & 15, fq = lane >> 4;
    const int nt = K / BK;
    unsigned voffA[2], voffB[2];
#pragma unroll
    for (int i = 0; i < 2; ++i) { int R, C; stage_rc(tid * 16 + i * 8192, R, C); const int Rb = Epi::PERM ? ((R & ~31) + perm32(R & 31)) : R;
        voffA[i] = (unsigned)(R * K + C) * 2u; voffB[i] = (unsigned)(Rb * K + C) * 2u; }
    const size_t kstep = (size_t)(BK * 2);
    const size_t hstep = (size_t)HALF * K * 2;
    const unsigned ldsw = (unsigned)wid * 1024u;
    const int aoff = lds_byte(wr * 64 + fr, fq * 8), boff = lds_byte(wc * 32 + fr, fq * 8);
#define G8_SA(b, h) (((b) * 2 + (h)) * HTB)
#define G8_SB(b, h) ((4 + (b) * 2 + (h)) * HTB)
#define G8_STAGE(bufoff, gbase, voff) do { _Pragma("unroll") for (int _i = 0; _i < 2; ++_i) \
        __builtin_amdgcn_global_load_lds((const unsigned*)((const char*)(gbase) + (voff)[_i]), (LAS unsigned*)(lds + (bufoff) + ldsw + _i * 8192), 16, 0, 0); } while (0)
#define G8_LDA(dst, b, h) do { _Pragma("unroll") for (int m = 0; m < 4; ++m) _Pragma("unroll") for (int k = 0; k < 2; ++k) dst[m][k] = *(const LAS h16x8*)(lds + G8_SA(b, h) + aoff + m * 2048 + k * 1024); } while (0)
#define G8_LDB(dst, b, h) do { _Pragma("unroll") for (int n = 0; n < 2; ++n) _Pragma("unroll") for (int k = 0; k < 2; ++k) dst[n][k] = *(const LAS h16x8*)(lds + G8_SB(b, h) + boff + n * 2048 + k * 1024); } while (0)
#define G8_MMA(ai, bj, At, Bt) do { __builtin_amdgcn_s_setprio(1); _Pragma("unroll") for (int m = 0; m < 4; ++m) _Pragma("unroll") for (int n = 0; n < 2; ++n) _Pragma("unroll") for (int k = 0; k < 2; ++k) \
        acc[ai][bj][m][n] = __builtin_amdgcn_mfma_f32_16x16x32_f16(Bt[n][k], At[m][k], acc[ai][bj][m][n], 0, 0, 0); __builtin_amdgcn_s_setprio(0); } while (0)
#define G8_WAIT_V(n) asm volatile("s_waitcnt vmcnt(" #n ")" ::: "memory")
#define G8_WAIT_L(n) asm volatile("s_waitcnt lgkmcnt(" #n ")" ::: "memory")
#define G8_BAR __builtin_amdgcn_s_barrier()
#define G8_SCHED __builtin_amdgcn_sched_barrier(0)
    Unit cur, nxt; int ui = 0;
    if (!S.next(0, cur)) return;
    f32x4 acc[2][2][4][2];
#pragma unroll
    for (int a = 0; a < 2; ++a)
#pragma unroll
        for (int b = 0; b < 2; ++b)
#pragma unroll
            for (int m = 0; m < 4; ++m)
#pragma unroll
                for (int n = 0; n < 2; ++n) acc[a][b][m][n] = (f32x4){0.f, 0.f, 0.f, 0.f};
    h16x8 At[4][2], B0[2][2], B1[2][2];
    const char* cA = cur.A; const char* cB = cur.B;
    G8_STAGE(G8_SB(0, 0), cB, voffB); G8_STAGE(G8_SB(0, 1), cB + hstep, voffB); G8_STAGE(G8_SA(0, 0), cA, voffA); G8_STAGE(G8_SA(0, 1), cA + hstep, voffA);
    if (wr == 1) G8_BAR;
    G8_WAIT_V(2); G8_BAR;
    G8_STAGE(G8_SB(1, 0), cB + kstep, voffB); G8_STAGE(G8_SA(1, 0), cA + kstep, voffA); G8_STAGE(G8_SB(1, 1), cB + hstep + kstep, voffB);
    G8_WAIT_V(6); G8_BAR;
    for (;;) {
        const bool has_next = S.next(ui + 1, nxt);
        const char* nA = has_next ? nxt.A : cA; const char* nB = has_next ? nxt.B : cB;
        for (int t = 0; t < nt; t += 2) {
            const bool last = (t == nt - 2);
            const char* a1 = cA + (size_t)(t + 1) * kstep;
            const char* a2 = last ? nA : cA + (size_t)(t + 2) * kstep; const char* b2 = last ? nB : cB + (size_t)(t + 2) * kstep;
            const char* a3 = a2 + kstep; const char* b3 = b2 + kstep;
            G8_LDB(B0, 0, 0); G8_LDB(B1, 0, 1); G8_SCHED; G8_LDA(At, 0, 0); G8_STAGE(G8_SA(1, 1), a1 + hstep, voffA);
            G8_WAIT_V(8); G8_WAIT_L(0); G8_BAR; G8_MMA(0, 0, At, B0); G8_MMA(0, 1, At, B1); G8_BAR; G8_SCHED;
            G8_LDA(At, 0, 1); G8_STAGE(G8_SB(0, 0), b2, voffB); G8_STAGE(G8_SB(0, 1), b2 + hstep, voffB); G8_STAGE(G8_SA(0, 0), a2, voffA);
            G8_WAIT_V(8); G8_WAIT_L(0); G8_BAR; G8_MMA(1, 0, At, B0); G8_MMA(1, 1, At, B1); G8_BAR; G8_SCHED;
            G8_LDB(B0, 1, 0); G8_LDB(B1, 1, 1); G8_SCHED; G8_LDA(At, 1, 0); G8_STAGE(G8_SA(0, 1), a2 + hstep, voffA);
            G8_WAIT_V(8); G8_WAIT_L(0); G8_BAR; G8_MMA(0, 0, At, B0); G8_MMA(0, 1, At, B1); G8_BAR; G8_SCHED;
            G8_LDA(At, 1, 1); G8_STAGE(G8_SB(1, 0), b3, voffB); G8_STAGE(G8_SB(1, 1), b3 + hstep, voffB); G8_STAGE(G8_SA(1, 0), a3, voffA);
            G8_WAIT_V(8); G8_WAIT_L(0); G8_BAR; G8_MMA(1, 0, At, B0); G8_MMA(1, 1, At, B1); G8_BAR; G8_SCHED;
        }
        if (wr == 0) G8_BAR;
        { int fr_e = fr, fq_e = fq; asm volatile("" : "+v"(fr_e), "+v"(fq_e)); E(acc, cur, wr, wc, fr_e, fq_e); }
        if (!has_next) break;
#pragma unroll
        for (int a = 0; a < 2; ++a)
#pragma unroll
            for (int b = 0; b < 2; ++b)
#pragma unroll
                for (int m = 0; m < 4; ++m)
#pragma unroll
                    for (int n = 0; n < 2; ++n) acc[a][b][m][n] = (f32x4){0.f, 0.f, 0.f, 0.f};
        cur = nxt; cA = nA; cB = nB; ++ui;
        if (wr == 1) G8_BAR;
    }
    G8_WAIT_V(0);
    G8_BAR;
#undef G8_SA
#undef G8_SB
#undef G8_STAGE
#undef G8_LDA
#undef G8_LDB
#undef G8_MMA
#undef G8_WAIT_V
#undef G8_WAIT_L
#undef G8_BAR
#undef G8_SCHED
}
}


#define XB_TMO      128
#define XB_XCNT(j)  (256  + 64 * (j))
#define XB_XSUB(j)  (1280 + 64 * (j))
#define XB_XGEN(j)  (2304 + 64 * (j))
#define XB_TOP      3328
#define XB_TOPGEN   3392
#define XCD_BAR_WORDS 3456
#define XB_SPIN_CAP (1u << 18)
__device__ __forceinline__ unsigned xb_ld(unsigned* p)              { return __hip_atomic_load(p, __ATOMIC_RELAXED, __HIP_MEMORY_SCOPE_AGENT); }
__device__ __forceinline__ unsigned xb_add(unsigned* p, unsigned v) { return __hip_atomic_fetch_add(p, v, __ATOMIC_RELAXED, __HIP_MEMORY_SCOPE_AGENT); }
__device__ __forceinline__ unsigned xb_xcc_id() { return (unsigned)__builtin_amdgcn_s_getreg((3 << 11) | 20) & 0xFu; }
#define XB_SPIN(cond, bar) do { unsigned _sp = 0; while (cond) { __builtin_amdgcn_s_sleep(1); \
    if ((++_sp & 255u) == 0u) { if (xb_ld(&(bar)[XB_TMO])) break; if (_sp > XB_SPIN_CAP) { atomicAdd(&(bar)[XB_TMO], 1u); break; } } } } while (0)
struct XcdBarrier { unsigned* bar; unsigned x; volatile LAS unsigned* st; };
__device__ __forceinline__ XcdBarrier xcd_barrier_post(unsigned* bar, volatile LAS unsigned* st) {
    XcdBarrier b; b.bar = bar; b.x = xb_xcc_id(); b.st = st;
    if (threadIdx.x == 0) (void)xb_add(&bar[XB_XCNT(b.x)], 1u);
    return b;
}
__device__ __forceinline__ void xcd_barrier_complete(unsigned* bar, unsigned x, unsigned& nloc, unsigned& nx) {
    const unsigned G = gridDim.x * gridDim.y * gridDim.z;
    unsigned sum, cnt, mine, sp = 0u;
    for (;;) {
        sum = 0u; cnt = 0u; mine = 0u;
#pragma unroll
        for (unsigned j = 0; j < 16; ++j) { const unsigned c = xb_ld(&bar[XB_XCNT(j)]); sum += c; cnt += (c > 0u) ? 1u : 0u; mine = (j == x) ? c : mine; }
        if (sum == G) break;
        __builtin_amdgcn_s_sleep(1);
        if ((++sp & 255u) == 0u) { if (xb_ld(&bar[XB_TMO])) break; if (sp > XB_SPIN_CAP) { atomicAdd(&bar[XB_TMO], 1u); break; } }
    }
    nloc = mine > 0u ? mine : 1u; nx = cnt > 0u ? cnt : 1u;
}
__device__ __forceinline__ void xcd_barrier(const XcdBarrier& b) {
    asm volatile("s_waitcnt vmcnt(0)" ::: "memory");
    __syncthreads();
    if (threadIdx.x == 0) {
        unsigned* bar = b.bar;
        __builtin_amdgcn_s_waitcnt(0);
        unsigned nloc = b.st[0], nx = b.st[1];
        if (nloc == 0u) { xcd_barrier_complete(bar, b.x, nloc, nx); b.st[0] = nloc; b.st[1] = nx; }
        const unsigned old = xb_add(&bar[XB_XSUB(b.x)], 1u);
        const unsigned gen = old / nloc;
        if (old + 1u == (gen + 1u) * nloc) {
            __builtin_amdgcn_fence(__ATOMIC_RELEASE, "agent");
            asm volatile("s_waitcnt vmcnt(0)" ::: "memory");
            const unsigned og = xb_add(&bar[XB_TOP], 1u);
            const unsigned tg = og / nx;
            if (og + 1u == (tg + 1u) * nx) xb_add(&bar[XB_TOPGEN], 1u);
            else XB_SPIN(xb_ld(&bar[XB_TOPGEN]) == tg, bar);
            __builtin_amdgcn_fence(__ATOMIC_ACQUIRE, "agent");
            xb_add(&bar[XB_XGEN(b.x)], 1u);
            asm volatile("s_waitcnt vmcnt(0)" ::: "memory");
        } else {
            XB_SPIN(xb_ld(&bar[XB_XGEN(b.x)]) == gen, bar);
            __builtin_amdgcn_fence(__ATOMIC_ACQUIRE, "agent");
            asm volatile("s_waitcnt vmcnt(0)" ::: "memory");
        }
    }
    __syncthreads();
}

struct Frame {
    unsigned char* lds; int tid, lane, wave, G, bid;
    const Params* pp;
    unsigned char* ws;
};
#define WSP(T, off) ((T*)(F.ws + (off)))

struct MapId { __device__ __forceinline__ int operator()(int n) const { return n; } };
struct MapGU { int half; __device__ __forceinline__ int operator()(int n) const { const int up = n >= half, j = up ? n - half : n; return 8 * (j >> 2) + 4 * up + (j & 3); } };

template <class RowMap>
__device__ __forceinline__ void xpose_tile(const float* __restrict__ W, int N, h16* __restrict__ WT, int K, int k0, int n0, float* scr, int lane, RowMap rm) {
    f32x4 v[16];
    const int r4 = lane >> 4, c4 = (lane & 15) * 4;
#pragma unroll
    for (int i = 0; i < 16; ++i) v[i] = *(const f32x4*)(W + (size_t)(k0 + i * 4 + r4) * N + n0 + c4);
#pragma unroll
    for (int i = 0; i < 16; ++i) { float* s = scr + (i * 4 + r4) * 65 + c4; s[0] = v[i].x; s[1] = v[i].y; s[2] = v[i].z; s[3] = v[i].w; }
    LDS_WAIT();
    const int c = lane & 7;
#pragma unroll
    for (int j = 0; j < 8; ++j) { const int n = (lane >> 3) + 8 * j; const float* s = scr + (8 * c) * 65 + n;
        u32x4 o; o.x = pk2(s[0], s[65]); o.y = pk2(s[130], s[195]); o.z = pk2(s[260], s[325]); o.w = pk2(s[390], s[455]);
        *(u32x4*)(WT + (size_t)rm(n0 + n) * K + k0 + 8 * c) = o; }
    LDS_WAIT();
}
template <class RowMap>
__device__ __forceinline__ void xpose_matrix(Frame& F, const float* W, int K, int N, h16* WT, RowMap rm, int& tbase) {
    const int gw = F.bid * NWAVES + F.wave, NGW = F.G * NWAVES;
    const int nkt = K / 64, nnt = N / 64, ntile = nkt * nnt;
    float* scr = (float*)(F.lds) + F.wave * (64 * 65);
    int first = gw - (tbase % NGW); if (first < 0) first += NGW;
    for (int t = first; t < ntile; t += NGW) { const int kt = t / nnt, ntt = t % nnt; xpose_tile(W, N, WT, K, kt * 64, ntt * 64, scr, F.lane, rm); }
    tbase += ntile;
}
__device__ __forceinline__ void step_pre(Frame& F) {
    const Params& p = *F.pp;
    { float* modout = (float*)(F.ws + OFF_CTL) + CW_MOD; f32x4* red = (f32x4*)F.lds;
      for (int it = F.bid; it < 256; it += F.G) {
          const int l = it >> 7, c0 = (it & 127) * 48;
          if (F.tid < 480) { const int cg4 = F.tid % 12, dg = F.tid / 12; f32x4 a = {0.f, 0.f, 0.f, 0.f};
#pragma unroll
              for (int i = 0; i < 26; ++i) { const int d = dg + 40 * i; if (d < D) { const f32x4 w = *(const f32x4*)(p.w_ada + ((size_t)(l * 1024 + d)) * 6144 + c0 + cg4 * 4); a += w * siluf_(p.c[d]); } }
              red[dg * 12 + cg4] = a; }
          __syncthreads();
          if (F.tid < 48) { float sum = 0.f; const float* rf = (const float*)red;
              for (int dg = 0; dg < 40; ++dg) sum += rf[dg * 48 + F.tid];
              modout[l * 6144 + c0 + F.tid] = sum + p.b_ada[l * 6144 + c0 + F.tid]; }
          __syncthreads();
      } }
    { f32x2* tab = WSP(f32x2, OFF_TAB);
      for (int idx = F.bid * NTHREADS + F.tid; idx < M * 8; idx += F.G * NTHREADS) { const int t = idx >> 3, i = idx & 7;
          const float fhi = i == 0 ? 1.0f : i == 1 ? 0.1939227432012558f : i == 2 ? 0.03760603070259094f : i == 3 ? 0.007292664609849453f : i == 4 ? 0.0014142135623842478f : i == 5 ? 0.00027424818836152554f : i == 6 ? 5.3182957344688475e-05f : 1.0313385246263351e-05f;
          const float flo = i == 0 ? 0.0f : i == 1 ? 1.5474299619455678e-09f : i == 2 ? 2.2827298384875405e-10f : i == 3 ? 1.2736765808707418e-10f : i == 4 ? -1.115275406748939e-14f : i == 5 ? -1.2685318073746288e-11f : i == 6 ? 1.624761414818765e-12f : 1.309491116886427e-13f;
          const float ps = (float)p.pos[t];
          const float ph = ps * fhi, pe = fmaf(ps, fhi, -ph) + ps * flo;
          const float kk = rintf(ph * 0.15915494309189535f);
          float r = fmaf(-kk, 6.2831854820251465f, ph); r = fmaf(-kk, -1.7484555314695172e-07f, r); r += pe;
          float sn, cs; sincosf(r, &sn, &cs); tab[idx] = (f32x2){(float)cs, (float)sn}; } }
    for (int rep_ = 0; rep_ < ((PROBE_DUP & 8) ? 2 : 1); ++rep_) {
    int tb = 0;
    for (int l = 0; l < 2; ++l) xpose_matrix(F, p.w_in + (size_t)l * D * INW, D, INW, WSP(h16, OFF_WT_IN) + (size_t)l * INW * D, MapId{}, tb);
    for (int l = 0; l < 2; ++l) xpose_matrix(F, p.w_out + (size_t)l * D * D, D, D, WSP(h16, OFF_WT_OUT) + (size_t)l * D * D, MapId{}, tb);
    xpose_matrix(F, p.fup, D, 2 * FFN, WSP(h16, OFF_WT_UP), MapGU{FFN}, tb);
    xpose_matrix(F, p.fdown, FFN, D, WSP(h16, OFF_WT_DOWN), MapId{}, tb);
    for (int e = 0; e < NE; ++e) xpose_matrix(F, p.mup + (size_t)e * D * 2 * EDIM, D, 2 * EDIM, WSP(h16, OFF_WT_MUP) + (size_t)e * 2 * EDIM * D, MapGU{EDIM}, tb);
    for (int e = 0; e < NE; ++e) xpose_matrix(F, p.mdown + (size_t)e * EDIM * D, EDIM, D, WSP(h16, OFF_WT_MDOWN) + (size_t)e * D * EDIM, MapId{}, tb);
    }
}

__device__ __forceinline__ void step_h0(Frame& F) {
    const float* mod = (const float*)(F.ws + OFF_CTL) + CW_MOD;
    h16* H = WSP(h16, OFF_H);
    for (size_t i = (size_t)F.bid * NTHREADS + F.tid; i < (size_t)M * D / 8; i += (size_t)F.G * NTHREADS) {
        const int col = (int)(i & 127) * 8;
        const f32x4 a = *(const f32x4*)(F.pp->x + i * 8), b = *(const f32x4*)(F.pp->x + i * 8 + 4);
        const f32x4 sh0 = *(const f32x4*)(mod + col), sh1 = *(const f32x4*)(mod + col + 4), sc0 = *(const f32x4*)(mod + 1024 + col), sc1 = *(const f32x4*)(mod + 1024 + col + 4);
        const f32x4 r0 = a * (sc0 + 1.0f) + sh0, r1 = b * (sc1 + 1.0f) + sh1;
        u32x4 w; w.x = pk2(r0[0], r0[1]); w.y = pk2(r0[2], r0[3]); w.z = pk2(r1[0], r1[1]); w.w = pk2(r1[2], r1[3]);
        *(u32x4*)(H + i * 8) = w;
    }
}

constexpr int SSEG = 128, NSS = M / SSEG, NCH = SSEG / 16;
constexpr size_t SCR_SE = OFF_BIG, SCR_SI = OFF_BIG + 32 * MiB, SCR_LP = OFF_BIG + 64 * MiB, SCR_OA = OFF_BIG + 80 * MiB;
__device__ __forceinline__ void step_rot(Frame& F, int layer) {
    h16* P = WSP(h16, OFF_PROJ); const f32x2* tab = WSP(f32x2, OFF_TAB);
    for (int idx = F.bid * NTHREADS + F.tid; idx < M * 14; idx += F.G * NTHREADS) {
        const int t = idx / 14, hh = idx % 14;
        const int cb = hh < 4 ? PC_Q + hh * 64 : hh < 8 ? PC_K + (hh - 4) * 64 : hh < 12 ? PD_Q + (hh - 8) * 64 : PD_K + (hh - 12) * 64;
        h16* ptr = P + (size_t)t * INW + cb;
        const h16x8 x1 = *(const h16x8*)ptr, x2 = *(const h16x8*)(ptr + 8);
        h16x8 o1, o2;
#pragma unroll
        for (int i = 0; i < 8; ++i) { const f32x2 cs = tab[t * 8 + i]; const float a = (float)x1[i], b = (float)x2[i]; o1[i] = (h16)(a * cs.x - b * cs.y); o2[i] = (h16)(b * cs.x + a * cs.y); }
        *(h16x8*)ptr = o1; *(h16x8*)(ptr + 8) = o2;
    }
}

template <int N> __device__ __forceinline__ float row_shr(float v) { return __builtin_bit_cast(float, __builtin_amdgcn_update_dpp(0, __builtin_bit_cast(int, v), 0x110 | N, 0xF, 0xF, true)); }
__device__ __forceinline__ float row_scan16(float v) { v += row_shr<1>(v); v += row_shr<2>(v); v += row_shr<4>(v); v += row_shr<8>(v); return v; }
__device__ __forceinline__ h16x4 cvt4(const f32x4 v) { h16x4 r; r[0] = (h16)v[0]; r[1] = (h16)v[1]; r[2] = (h16)v[2]; r[3] = (h16)v[3]; return r; }
#define MFMA16(a, b, c) __builtin_amdgcn_mfma_f32_16x16x16f16((a), (b), (c), 0, 0, 0)
template <bool FULL>
__device__ __forceinline__ void hg_chunk(const h16* __restrict__ P, const int h, const int dir, const int c0, const int lane, const float (&lb)[4][4], f32x4 (&S)[4][4], float (&lp)[4][4], float* __restrict__ OAdir, const h16x4 ident) {
    const int tau = lane & 15, g = lane >> 4;
    const h16* row = P + (size_t)(c0 + (dir ? 15 - tau : tau)) * INW + h * 64 + 4 * g;
    h16x4 zr[4], qr[4], vr[4];
#pragma unroll
    for (int kt = 0; kt < 4; ++kt) { zr[kt] = *(const h16x4*)(row + (dir ? PA_FB : PA_FF) + 16 * kt); vr[kt] = *(const h16x4*)(row + PA_I + 16 * kt); if (FULL) qr[kt] = *(const h16x4*)(row + PA_Q + 16 * kt); }
    float cum[4][4], kkv[4][4], tot[4][4];
#pragma unroll
    for (int kt = 0; kt < 4; ++kt)
#pragma unroll
        for (int j = 0; j < 4; ++j) { const float z = (float)zr[kt][j]; const float e = __expf(-fabsf(z)), r = 1.0f / (1.0f + e); const float sg = z >= 0.f ? r : e * r, nsg = z >= 0.f ? e * r : r;
            const float oml = 1.0f - lb[kt][j]; cum[kt][j] = row_scan16(__logf(lb[kt][j] + oml * sg)); kkv[kt][j] = oml * nsg; }
#pragma unroll
    for (int kt = 0; kt < 4; ++kt)
#pragma unroll
        for (int j = 0; j < 4; ++j) tot[kt][j] = __shfl(cum[kt][j], (lane & 48) | 15);
    const f32x4 zero4 = {0.f, 0.f, 0.f, 0.f};
    h16x4 KT[4], VT[4];
#pragma unroll
    for (int kt = 0; kt < 4; ++kt) { h16x4 kh;
#pragma unroll
        for (int j = 0; j < 4; ++j) kh[j] = (h16)(kkv[kt][j] * __expf(tot[kt][j] - cum[kt][j]));
        KT[kt] = cvt4(MFMA16(kh, ident, zero4)); VT[kt] = cvt4(MFMA16(vr[kt], ident, zero4)); }
    if (FULL) {
        f32x4 sc = zero4; h16x4 QA[4];
#pragma unroll
        for (int kt = 0; kt < 4; ++kt)
#pragma unroll
            for (int j = 0; j < 4; ++j) { const float ref = __shfl(cum[kt][j], (lane & 48) | 7); const float qs = siluf_((float)qr[kt][j]);
                QA[kt][j] = (h16)(qs * __expf(cum[kt][j]));
                sc = __builtin_amdgcn_mfma_f32_16x16x4f32(kkv[kt][j] * __expf(ref - cum[kt][j]), qs * __expf(cum[kt][j] - ref), sc, 0, 0, 0); }
        h16x4 AA;
#pragma unroll
        for (int j = 0; j < 4; ++j) AA[j] = (h16)((4 * g + j <= tau) ? sc[j] : 0.f);
#pragma unroll
        for (int dt = 0; dt < 4; ++dt) { f32x4 o = MFMA16(AA, VT[dt], zero4);
#pragma unroll
            for (int kt = 0; kt < 4; ++kt) o = MFMA16(QA[kt], cvt4(S[kt][dt]), o);
#pragma unroll
            for (int j = 0; j < 4; ++j) { const int to = 4 * g + j; OAdir[(size_t)(c0 + (dir ? 15 - to : to)) * 256 + h * 64 + 16 * dt + tau] = o[j]; } }
    }
#pragma unroll
    for (int kt = 0; kt < 4; ++kt) { float dec[4];
#pragma unroll
        for (int j = 0; j < 4; ++j) { dec[j] = __expf(tot[kt][j]); lp[kt][j] += tot[kt][j]; }
#pragma unroll
        for (int dt = 0; dt < 4; ++dt) { f32x4 sv = S[kt][dt]; sv[0] *= dec[0]; sv[1] *= dec[1]; sv[2] *= dec[2]; sv[3] *= dec[3]; S[kt][dt] = MFMA16(KT[kt], VT[dt], sv); } }
}
__device__ __forceinline__ void hg_setup(const Frame& F, int layer, int h, float (&lb)[4][4], h16x4& ident) {
    const int tau = F.lane & 15, g = F.lane >> 4;
#pragma unroll
    for (int kt = 0; kt < 4; ++kt)
#pragma unroll
        for (int j = 0; j < 4; ++j) { const int c = h * 64 + 16 * kt + 4 * g + j; lb[kt][j] = (layer == 0 ? 0.f : 1.f) * sigmoidf_(F.pp->alb[256 + c] - F.pp->alb[c]); }
#pragma unroll
    for (int j = 0; j < 4; ++j) ident[j] = (h16)((4 * g + j == tau) ? 1.0f : 0.0f);
}
__device__ __forceinline__ void hg_pass1(Frame& F, int layer) {
    const int gw = F.bid * NWAVES + F.wave, NGW = F.G * NWAVES; const int tau = F.lane & 15, g = F.lane >> 4;
    const h16* P = WSP(h16, OFF_PROJ); float* SE = WSP(float, SCR_SE); float* LP = WSP(float, SCR_LP);
    for (int it = F.wave * F.G + F.bid; it < 8 * NSS; it += NGW) { const int ss = it % NSS, hd = it / NSS, dir = hd & 1, h = hd >> 1;
        float lb[4][4], lp[4][4]; h16x4 ident; f32x4 S[4][4]; hg_setup(F, layer, h, lb, ident);
#pragma unroll
        for (int kt = 0; kt < 4; ++kt)
#pragma unroll
            for (int j = 0; j < 4; ++j) { lp[kt][j] = 0.f; S[kt][j] = (f32x4){0.f, 0.f, 0.f, 0.f}; }
#pragma unroll 1
        for (int ci = 0; ci < NCH; ++ci) hg_chunk<false>(P, h, dir, ss * SSEG + (dir ? NCH - 1 - ci : ci) * 16, F.lane, lb, S, lp, nullptr, ident);
        int l2 = F.lane; asm volatile("" : "+v"(l2));
        float* se = SE + (size_t)it * 4096 + (4 * (l2 >> 4)) * 64 + (l2 & 15);
#pragma unroll
        for (int kt = 0; kt < 4; ++kt)
#pragma unroll
            for (int j = 0; j < 4; ++j) {
#pragma unroll
                for (int dt = 0; dt < 4; ++dt) se[(16 * kt + j) * 64 + 16 * dt] = S[kt][dt][j]; }
        if ((l2 & 15) == 0) {
#pragma unroll
            for (int kt = 0; kt < 4; ++kt)
#pragma unroll
                for (int j = 0; j < 4; ++j) LP[(size_t)it * 64 + 16 * kt + 4 * (l2 >> 4) + j] = lp[kt][j]; }
    }
}
__device__ __forceinline__ void step_hg2(Frame& F) {
    const float* SE = WSP(float, SCR_SE); const float* LP = WSP(float, SCR_LP); float* SI = WSP(float, SCR_SI);
    for (int e = F.bid * 32 + (F.tid & 31) + (F.tid >> 5) * 32 * F.G; e < 8 * 1024; e += 32 * F.G * 16) { const int hd = e >> 10, cd4 = e & 1023, c = cd4 >> 4;
        f32x4 st = {0.f, 0.f, 0.f, 0.f}; const int dir = hd & 1;
        for (int n0 = 0; n0 < NSS; n0 += 16) { f32x4 se[16]; float lpv[16];
#pragma unroll
            for (int u = 0; u < 16; ++u) { const int n = dir ? NSS - 1 - (n0 + u) : n0 + u; se[u] = *(const f32x4*)(SE + ((size_t)hd * NSS + n) * 4096 + cd4 * 4); lpv[u] = LP[((size_t)hd * NSS + n) * 64 + c]; }
#pragma unroll
            for (int u = 0; u < 16; ++u) { const int n = dir ? NSS - 1 - (n0 + u) : n0 + u; *(f32x4*)(SI + ((size_t)hd * NSS + n) * 4096 + cd4 * 4) = st; st = st * __expf(lpv[u]) + se[u]; } }
    }
}
__device__ __forceinline__ void step_hg3(Frame& F, int layer) {
    const int gw = F.bid * NWAVES + F.wave, NGW = F.G * NWAVES; const int tau = F.lane & 15, g = F.lane >> 4;
    const h16* P = WSP(h16, OFF_PROJ); const float* SI = WSP(float, SCR_SI);
    for (int it = F.wave * F.G + F.bid; it < 8 * NSS; it += NGW) { const int ss = it % NSS, hd = it / NSS, dir = hd & 1, h = hd >> 1;
        float lb[4][4], lp[4][4]; h16x4 ident; f32x4 S[4][4]; hg_setup(F, layer, h, lb, ident);
        const float* si = SI + (size_t)it * 4096 + (4 * g) * 64 + tau;
#pragma unroll
        for (int kt = 0; kt < 4; ++kt)
#pragma unroll
            for (int dt = 0; dt < 4; ++dt) {
#pragma unroll
                for (int j = 0; j < 4; ++j) S[kt][dt][j] = si[(16 * kt + j) * 64 + 16 * dt];
                lp[kt][dt] = 0.f; }
        float* OAdir = WSP(float, SCR_OA) + (size_t)dir * M * 256;
#pragma unroll 1
        for (int ci = 0; ci < NCH; ++ci) hg_chunk<true>(P, h, dir, ss * SSEG + (dir ? NCH - 1 - ci : ci) * 16, F.lane, lb, S, lp, OAdir, ident);
    }
}
__device__ __forceinline__ void conv_item(Frame& F, int item, int layer) {
    const Params& p = *F.pp;
    float* U = (float*)F.lds;
    float* Yt = U + 62 * 256;
    const h16* P = WSP(h16, OFF_PROJ);
    const int t0 = item * 32;
    { h16x8 vv[4], gg[4];
#pragma unroll
      for (int n = 0; n < 4; ++n) { const int ch = F.tid + NTHREADS * n, r = ch >> 5, c8 = (ch & 31) * 8; int t = t0 - 15 + r; t = t < 0 ? 0 : (t > M - 1 ? M - 1 : t);
          const h16* row = P + (size_t)t * INW; vv[n] = *(const h16x8*)(row + PB_V + c8); gg[n] = *(const h16x8*)(row + PB_G + c8); }
#pragma unroll
      for (int n = 0; n < 4; ++n) { const int ch = F.tid + NTHREADS * n, r = ch >> 5, c8 = (ch & 31) * 8; const int t = t0 - 15 + r; const bool ok = (t >= 0) && (t < M) && (r < 62);
          if (r < 62) {
#pragma unroll
              for (int e = 0; e < 8; ++e) U[r * 256 + c8 + e] = ok ? (float)vv[n][e] * sigmoidf_((float)gg[n][e]) : 0.f; } } }
    __syncthreads();
    { const int c = F.tid & 255, tg = F.tid >> 8;
      float w[31];
#pragma unroll
      for (int j = 0; j < 31; ++j) w[j] = p.cw[(size_t)layer * 31 * 256 + j * 256 + c];
      const float bias = p.cb[layer * 256 + c];
      for (int tt = tg * 16; tt < tg * 16 + 16; ++tt) { float a = bias;
#pragma unroll
          for (int j = 0; j < 31; ++j) a += w[j] * U[(tt + j) * 256 + c];
          Yt[tt * 256 + c] = a; } }
    __syncthreads();
    { h16* Y = WSP(h16, OFF_Y);
      for (int r = F.wave * 4; r < F.wave * 4 + 4; ++r) {
          const f32x4 v = *(const f32x4*)(Yt + r * 256 + F.lane * 4);
          const float mean = wave_sum((v.x + v.y) + (v.z + v.w)) * (1.f / 256.f);
          const f32x4 d = v - mean;
          const float var = wave_sum((d.x * d.x + d.y * d.y) + (d.z * d.z + d.w * d.w)) * (1.f / 256.f);
          const float rstd = 1.0f / sqrtf(var + LN_EPS);
          const f32x4 nw = *(const f32x4*)(p.cnw + layer * 256 + F.lane * 4), nb = *(const f32x4*)(p.cnb + layer * 256 + F.lane * 4);
          const f32x4 o = d * rstd * nw + nb;
          u32x2 w2; w2.x = pk2(siluf_(o.x), siluf_(o.y)); w2.y = pk2(siluf_(o.z), siluf_(o.w));
          *(u32x2*)(Y + (size_t)(t0 + r) * D + 256 + F.lane * 4) = w2; } }
    __syncthreads();
}
#define ATT_KEY(sidx) do { const int s_ = (sidx); if (s_ >= 0 && s_ < M) { const h16* kr = Pk + (size_t)s_ * INW; const h16* vr = Pv + (size_t)s_ * INW; float sc = 0.f; \
    _Pragma("unroll") for (int c8 = 0; c8 < 8; ++c8) { const h16x8 kk = *(const h16x8*)(kr + 8 * c8); _Pragma("unroll") for (int e = 0; e < 4; ++e) sc = __builtin_amdgcn_fdot2((h16x2){qv[c8][2 * e], qv[c8][2 * e + 1]}, (h16x2){kk[2 * e], kk[2 * e + 1]}, sc, false); } \
    const float mn = fmaxf(m, sc), corr = __expf(m - mn), pw = __expf(sc - mn); l = l * corr + pw; m = mn; \
    _Pragma("unroll") for (int c8 = 0; c8 < 8; ++c8) { const h16x8 vv = *(const h16x8*)(vr + 8 * c8); _Pragma("unroll") for (int e = 0; e < 8; ++e) acc[8 * c8 + e] = acc[8 * c8 + e] * corr + pw * (float)vv[e]; } } } while (0)
__device__ __forceinline__ void attn_naive_item(Frame& F, int item, int layer, int which  ) {
    const int idx = item * NTHREADS + F.tid; const int h = idx >> 14, t = idx & (M - 1);
    const h16* P = WSP(h16, OFF_PROJ);
    const h16* Pq = P + (size_t)t * INW + (which ? PD_Q : PC_Q) + h * 64;
    const h16* Pk = P + (which ? PD_K + (h >> 1) * 64 : PC_K + h * 64);
    const h16* Pv = P + (which ? PD_V + (h >> 1) * 64 : PC_V + h * 64);
    h16x8 qv[8]; float acc[64]; float m = -1e30f, l = 0.f;
#pragma unroll
    for (int c8 = 0; c8 < 8; ++c8) { qv[c8] = *(const h16x8*)(Pq + 8 * c8) * (h16)0.125f;
#pragma unroll
        for (int e = 0; e < 8; ++e) acc[8 * c8 + e] = 0.f; }
    h16* Y = WSP(h16, OFF_Y) + (size_t)t * D + (which ? 768 : 512) + h * 64;
    float scale;
    if (which == 0) {
        for (int j = -64; j <= 64; ++j) ATT_KEY(t + j);
        for (int j = -64; j <= 64; ++j) ATT_KEY(t + 4 * j);
        for (int j = -64; j <= 64; ++j) ATT_KEY(t + 16 * j);
        scale = 1.0f / l;
    } else {
        for (int j = -128; j <= 128; ++j) ATT_KEY(t + j);
        const float sk = F.pp->sink[layer * 4 + h]; const float mt = fmaxf(m, sk), w = __expf(m - mt), den = l * w + __expf(sk - mt);
        scale = w / den;
    }
#pragma unroll
    for (int c8 = 0; c8 < 8; ++c8) { u32x4 w; w.x = pk2(acc[8 * c8] * scale, acc[8 * c8 + 1] * scale); w.y = pk2(acc[8 * c8 + 2] * scale, acc[8 * c8 + 3] * scale);
        w.z = pk2(acc[8 * c8 + 4] * scale, acc[8 * c8 + 5] * scale); w.w = pk2(acc[8 * c8 + 6] * scale, acc[8 * c8 + 7] * scale); *(u32x4*)(Y + 8 * c8) = w; }
}
typedef __attribute__((__vector_size__(4 * sizeof(short)))) short vs4;
typedef __attribute__((address_space(3))) vs4 lds_vs4;
constexpr int ATT_PITCH = 144, ATT_WAVE_LDS = 32 * ATT_PITCH;
struct AttLoad { h16x8 kf[2][2]; u32x4 vc[4]; };
__device__ __forceinline__ void att_load(AttLoad& L, const h16* __restrict__ Kp, const h16* __restrict__ Vp, int tkb, int st, int lane) {
    const int r = lane & 15, g = lane >> 4;
#pragma unroll
    for (int sb = 0; sb < 2; ++sb) { int tk = tkb + (16 * sb + r) * st; tk = tk < 0 ? 0 : (tk > M - 1 ? M - 1 : tk); const h16* kr = Kp + (size_t)tk * INW + 8 * g;
        L.kf[sb][0] = *(const h16x8*)kr; L.kf[sb][1] = *(const h16x8*)(kr + 32); }
#pragma unroll
    for (int n = 0; n < 4; ++n) { int tk = tkb + ((lane >> 3) + 8 * n) * st; tk = tk < 0 ? 0 : (tk > M - 1 ? M - 1 : tk); L.vc[n] = *(const u32x4*)(Vp + (size_t)tk * INW + 8 * (lane & 7)); }
}
template <int WIN>
__device__ __forceinline__ void att_seg(const h16* __restrict__ Kp, const h16* __restrict__ Vp, const int tk0, const int st, const int nblk, const int qo, const h16x8 (&Qf)[2],
                                        float& m, float& l, f32x4 (&O)[4], unsigned char* vlds, const int lane) {
    const int g = lane >> 4;
    AttLoad cur, nxt; att_load(cur, Kp, Vp, tk0, st, lane);
    const f32x4 zero4 = {0.f, 0.f, 0.f, 0.f};
#pragma unroll 1
    for (int blk = 0; blk < nblk; ++blk) {
        const int nb = blk + 1 < nblk ? blk + 1 : blk;
        att_load(nxt, Kp, Vp, tk0 + 32 * nb * st, st, lane);
        LDS_WAIT();
#pragma unroll
        for (int n = 0; n < 4; ++n) *(u32x4*)(vlds + ((lane >> 3) + 8 * n) * ATT_PITCH + 16 * (lane & 7)) = cur.vc[n];
        f32x4 sa = __builtin_amdgcn_mfma_f32_16x16x32_f16(cur.kf[0][0], Qf[0], zero4, 0, 0, 0); sa = __builtin_amdgcn_mfma_f32_16x16x32_f16(cur.kf[0][1], Qf[1], sa, 0, 0, 0);
        f32x4 sb = __builtin_amdgcn_mfma_f32_16x16x32_f16(cur.kf[1][0], Qf[0], zero4, 0, 0, 0); sb = __builtin_amdgcn_mfma_f32_16x16x32_f16(cur.kf[1][1], Qf[1], sb, 0, 0, 0);
        float sv[8]; bool ok[8]; float bm = -1e30f;
#pragma unroll
        for (int e = 0; e < 8; ++e) { const int kk = 32 * blk + 16 * (e >> 2) + 4 * g + (e & 3); const int tk = tk0 + kk * st;
            ok[e] = ((unsigned)(kk - qo) <= (unsigned)WIN) && ((unsigned)tk < (unsigned)M); sv[e] = e < 4 ? sa[e & 3] : sb[e & 3]; bm = ok[e] ? fmaxf(bm, sv[e]) : bm; }
        bm = fmaxf(bm, __shfl_xor(bm, 16)); bm = fmaxf(bm, __shfl_xor(bm, 32));
        const float mn = fmaxf(m, bm), corr = __expf(m - mn); m = mn;
        float ps = 0.f; h16x8 pf;
#pragma unroll
        for (int e = 0; e < 8; ++e) { const float pe = ok[e] ? __expf(sv[e] - mn) : 0.f; ps += pe; pf[e] = (h16)pe; }
        l = l * corr + ps;
        LDS_WAIT();
#pragma unroll
        for (int dt = 0; dt < 4; ++dt) {
            const int q4 = (lane >> 2) & 3, p4 = lane & 3;
            const vs4 r0 = __builtin_amdgcn_ds_read_tr16_b64_v4i16((lds_vs4*)(vlds + (4 * g + q4) * ATT_PITCH + (16 * dt + 4 * p4) * 2));
            const vs4 r1 = __builtin_amdgcn_ds_read_tr16_b64_v4i16((lds_vs4*)(vlds + (16 + 4 * g + q4) * ATT_PITCH + (16 * dt + 4 * p4) * 2));
            typedef short s16x8 __attribute__((ext_vector_type(8)));
            s16x8 vv; vv[0] = r0[0]; vv[1] = r0[1]; vv[2] = r0[2]; vv[3] = r0[3]; vv[4] = r1[0]; vv[5] = r1[1]; vv[6] = r1[2]; vv[7] = r1[3];
            f32x4 o = O[dt]; o[0] *= corr; o[1] *= corr; o[2] *= corr; o[3] *= corr;
            O[dt] = __builtin_amdgcn_mfma_f32_16x16x32_f16(__builtin_bit_cast(h16x8, vv), pf, o, 0, 0, 0); }
        cur = nxt;
    }
}
__device__ __forceinline__ void att_unit(Frame& F, int u, int layer) {
    const int lane = F.lane, i = lane & 15, g = lane >> 4;
    const h16* P = WSP(h16, OFF_PROJ); h16* Y = WSP(h16, OFF_Y);
    unsigned char* vlds = F.lds + F.wave * ATT_WAVE_LDS;
    float m = -1e30f, l = 0.f; f32x4 O[4];
#pragma unroll
    for (int dt = 0; dt < 4; ++dt) O[dt] = (f32x4){0.f, 0.f, 0.f, 0.f};
    h16x8 Qf[2]; int tq, h; float scale;
    if (u < 4096) {
        const int r = u & 15; h = (u >> 4) & 3; const int b = u >> 6; const int tq0 = 256 * b + r; tq = tq0 + 16 * i;
        const h16* qp = P + (size_t)tq * INW + PC_Q + h * 64 + 8 * g; Qf[0] = *(const h16x8*)qp * (h16)0.125f; Qf[1] = *(const h16x8*)(qp + 32) * (h16)0.125f;
        const h16* Kp = P + PC_K + h * 64; const h16* Vp = P + PC_V + h * 64;
        att_seg<128>(Kp, Vp, tq0 - 64 * 16, 16, 5, i, Qf, m, l, O, vlds, lane);
        att_seg<128>(Kp, Vp, tq0 - 64 * 4, 4, 6, 4 * i, Qf, m, l, O, vlds, lane);
        att_seg<128>(Kp, Vp, tq0 - 64, 1, 12, 16 * i, Qf, m, l, O, vlds, lane);
        l += __shfl_xor(l, 16); l += __shfl_xor(l, 32);
        scale = 1.0f / l;
    } else {
        const int v = u - 4096; h = v >> 10; const int tq0 = (v & 1023) * 16; tq = tq0 + i;
        const h16* qp = P + (size_t)tq * INW + PD_Q + h * 64 + 8 * g; Qf[0] = *(const h16x8*)qp * (h16)0.125f; Qf[1] = *(const h16x8*)(qp + 32) * (h16)0.125f;
        const h16* Kp = P + PD_K + (h >> 1) * 64; const h16* Vp = P + PD_V + (h >> 1) * 64;
        att_seg<256>(Kp, Vp, tq0 - 128, 1, 9, i, Qf, m, l, O, vlds, lane);
        l += __shfl_xor(l, 16); l += __shfl_xor(l, 32);
        const float sk = F.pp->sink[layer * 4 + h]; const float mt = fmaxf(m, sk), w = __expf(m - mt), den = l * w + __expf(sk - mt);
        scale = w / den;
    }
    h16* yo = Y + (size_t)tq * D + (u < 4096 ? 512 : 768) + h * 64 + 4 * g;
#pragma unroll
    for (int dt = 0; dt < 4; ++dt) { u32x2 w2; w2.x = pk2(O[dt][0] * scale, O[dt][1] * scale); w2.y = pk2(O[dt][2] * scale, O[dt][3] * scale); *(u32x2*)(yo + 16 * dt) = w2; }
}
__device__ __forceinline__ void step_mix(Frame& F, int layer) {
    constexpr int N_CONV = M / 32;
    hg_pass1(F, layer);
    for (int it = F.bid; it < N_CONV; it += F.G) conv_item(F, it, layer);
#if ATT_NAIVE
    for (int it = F.bid; it < 256; it += F.G) attn_naive_item(F, it & 127, layer, it >> 7);
#else
    { const int gw = F.bid * NWAVES + F.wave, NGW = F.G * NWAVES;
#pragma unroll 1
      for (int u = gw; u < 8192; u += NGW) att_unit(F, u, layer); }
#endif
}
__device__ __forceinline__ void step_afin(Frame& F, int layer) {
    const float* OA = WSP(float, SCR_OA); const h16* P = WSP(h16, OFF_PROJ); h16* Y = WSP(h16, OFF_Y);
    const int gw = F.bid * NWAVES + F.wave, NGW = F.G * NWAVES;
    const f32x4 nw = *(const f32x4*)(F.pp->anw + layer * 64 + (F.lane & 15) * 4);
    for (int r0 = gw * 4; r0 < M; r0 += NGW * 4) {
        f32x4 of[4], ob[4]; h16x4 gg[4];
#pragma unroll
        for (int u = 0; u < 4; ++u) { const size_t t = (size_t)(r0 + u); of[u] = *(const f32x4*)(OA + t * 256 + F.lane * 4); ob[u] = *(const f32x4*)(OA + (size_t)M * 256 + t * 256 + F.lane * 4); gg[u] = *(const h16x4*)(P + t * INW + PA_G + F.lane * 4); }
#pragma unroll
        for (int u = 0; u < 4; ++u) { const f32x4 o = of[u] + ob[u]; float ss = (o.x * o.x + o.y * o.y) + (o.z * o.z + o.w * o.w);
            ss += __shfl_xor(ss, 1); ss += __shfl_xor(ss, 2); ss += __shfl_xor(ss, 4); ss += __shfl_xor(ss, 8);
            const float rs = 1.0f / sqrtf(ss * (1.f / 64.f) + RMS_EPS);
            u32x2 w2; w2.x = pk2(o.x * rs * nw.x * siluf_((float)gg[u][0]), o.y * rs * nw.y * siluf_((float)gg[u][1])); w2.y = pk2(o.z * rs * nw.z * siluf_((float)gg[u][2]), o.w * rs * nw.w * siluf_((float)gg[u][3]));
            *(u32x2*)(Y + (size_t)(r0 + u) * D + F.lane * 4) = w2; }
    }
}

struct LnArgs { const float* xin; const float* gate; const float* lw; const float* lb; const float* nscale; const float* nshift; float* xout; h16* hout; };
__device__ __forceinline__ void ln_core(const Frame& F, const LnArgs& a, int row, const f32x4 (&fv)[4], f32x4 (&hv)[4]) {
    f32x4 tv[4]; float s = 0.f;
#pragma unroll
    for (int j = 0; j < 4; ++j) { const int col = F.lane * 4 + 256 * j; const f32x4 xi = *(const f32x4*)(a.xin + (size_t)row * D + col), g = *(const f32x4*)(a.gate + col);
        tv[j] = xi * ALPHA + (g + 1.0f) * fv[j]; s += (tv[j].x + tv[j].y) + (tv[j].z + tv[j].w); }
    const float mean = wave_sum(s) * (1.f / D); float s2 = 0.f;
#pragma unroll
    for (int j = 0; j < 4; ++j) { tv[j] = tv[j] - mean; s2 += (tv[j].x * tv[j].x + tv[j].y * tv[j].y) + (tv[j].z * tv[j].z + tv[j].w * tv[j].w); }
    const float rstd = 1.0f / sqrtf(wave_sum(s2) * (1.f / D) + LN_EPS);
#pragma unroll
    for (int j = 0; j < 4; ++j) { const int col = F.lane * 4 + 256 * j; const f32x4 w = *(const f32x4*)(a.lw + col), b = *(const f32x4*)(a.lb + col);
        const f32x4 xo = tv[j] * rstd * w + b;
        *(f32x4*)(a.xout + (size_t)row * D + col) = xo;
        if (a.hout) { const f32x4 sc = *(const f32x4*)(a.nscale + col), sh = *(const f32x4*)(a.nshift + col); hv[j] = xo * (sc + 1.0f) + sh;
            u32x2 w2; w2.x = pk2(hv[j].x, hv[j].y); w2.y = pk2(hv[j].z, hv[j].w); *(u32x2*)(a.hout + (size_t)row * D + col) = w2; } }
}
__device__ __forceinline__ void step_ln_dense(Frame& F, const LnArgs& a, const float* Z, bool router) {
    const int gw = F.bid * NWAVES + F.wave, NGW = F.G * NWAVES;
    unsigned* cnt = (unsigned*)(F.ws + OFF_CTL) + CW_CNT; unsigned* tok = WSP(unsigned, OFF_TOK);
    unsigned* lcnt = (unsigned*)F.lds;
    if (router) { if (F.tid < 8) lcnt[F.tid] = 0u; __syncthreads(); }
    for (int row = gw; row < M; row += NGW) {
        f32x4 fv[4], hv[4];
#pragma unroll
        for (int j = 0; j < 4; ++j) fv[j] = *(const f32x4*)(Z + (size_t)row * D + F.lane * 4 + 256 * j);
        ln_core(F, a, row, fv, hv);
        if (router) {
            float lg[8];
#pragma unroll
            for (int e = 0; e < 8; ++e) lg[e] = 0.f;
#pragma unroll
            for (int j = 0; j < 4; ++j)
#pragma unroll
                for (int i = 0; i < 4; ++i) { const int col = F.lane * 4 + 256 * j + i; const f32x4 w0 = *(const f32x4*)(F.pp->rout + (size_t)col * 8), w1 = *(const f32x4*)(F.pp->rout + (size_t)col * 8 + 4); const float hval = hv[j][i];
                    lg[0] += hval * w0.x; lg[1] += hval * w0.y; lg[2] += hval * w0.z; lg[3] += hval * w0.w; lg[4] += hval * w1.x; lg[5] += hval * w1.y; lg[6] += hval * w1.z; lg[7] += hval * w1.w; }
#pragma unroll
            for (int e = 0; e < 8; ++e) lg[e] = wave_sum(lg[e]);
            int e1 = 0; float l1 = lg[0];
#pragma unroll
            for (int e = 1; e < 8; ++e) if (lg[e] > l1) { l1 = lg[e]; e1 = e; }
            int e2 = -1; float l2 = -3.0e38f;
#pragma unroll
            for (int e = 0; e < 8; ++e) if (e != e1 && lg[e] > l2) { l2 = lg[e]; e2 = e; }
            const float g1 = 1.0f / (1.0f + __expf(l2 - l1)), g2 = 1.0f - g1;
            if (F.lane == 0) { tok[row * 8 + 0] = (unsigned)e1; tok[row * 8 + 1] = (unsigned)e2; tok[row * 8 + 2] = __float_as_uint(g1); tok[row * 8 + 3] = __float_as_uint(g2);
                atomicAdd(lcnt + e1, 1u); atomicAdd(lcnt + e2, 1u); }
        }
    }
    if (router) { __syncthreads(); if (F.tid < 8) atomicAdd(cnt + F.tid, lcnt[F.tid]); }
}
__device__ __forceinline__ void step_slot(Frame& F) {
    const unsigned* cnt = (const unsigned*)(F.ws + OFF_CTL) + CW_CNT; unsigned* cur = (unsigned*)(F.ws + OFF_CTL) + CW_CUR; unsigned* tok = WSP(unsigned, OFF_TOK);
    const h16* H = WSP(h16, OFF_H); h16* HG = WSP(h16, OFF_PROJ);
    unsigned off[8]; { unsigned o = 0;
#pragma unroll
        for (int e = 0; e < 8; ++e) { off[e] = o; o += ((cnt[e] + 255u) >> 8) << 8; } }
    const int gw = F.bid * NWAVES + F.wave, NGW = F.G * NWAVES;
    unsigned* lw = (unsigned*)F.lds;
    if (F.tid < 16) lw[F.tid] = 0u;
    __syncthreads();
    for (int row = gw; row < M; row += NGW) if (F.lane == 0) { atomicAdd(lw + tok[row * 8 + 0], 1u); atomicAdd(lw + tok[row * 8 + 1], 1u); }
    __syncthreads();
    if (F.tid < 8) { unsigned o = 0;
#pragma unroll
        for (int e = 0; e < 8; ++e) o = ((unsigned)F.tid == (unsigned)e) ? off[e] : o;
        lw[8 + F.tid] = o + atomicAdd(cur + F.tid, lw[F.tid]); }
    __syncthreads();
    for (int row = gw; row < M; row += NGW) {
        const unsigned e1 = tok[row * 8 + 0], e2 = tok[row * 8 + 1];
        unsigned s1 = 0, s2 = 0;
        if (F.lane == 0) { s1 = atomicAdd(lw + 8 + e1, 1u); s2 = atomicAdd(lw + 8 + e2, 1u); tok[row * 8 + 4] = s1; tok[row * 8 + 5] = s2; }
        s1 = __shfl(s1, 0); s2 = __shfl(s2, 0);
        const u32x4 a = *(const u32x4*)(H + (size_t)row * D + F.lane * 8), b = *(const u32x4*)(H + (size_t)row * D + 512 + F.lane * 8);
        *(u32x4*)(HG + (size_t)s1 * D + F.lane * 8) = a; *(u32x4*)(HG + (size_t)s1 * D + 512 + F.lane * 8) = b;
        *(u32x4*)(HG + (size_t)s2 * D + F.lane * 8) = a; *(u32x4*)(HG + (size_t)s2 * D + 512 + F.lane * 8) = b;
    }
    __syncthreads();
}
__device__ __forceinline__ void step_ln_moe(Frame& F, const LnArgs& a) {
    const int gw = F.bid * NWAVES + F.wave, NGW = F.G * NWAVES;
    const unsigned* tok = WSP(unsigned, OFF_TOK); const float* YS = WSP(float, OFF_PROJ);
    for (int row = gw; row < M; row += NGW) {
        const float g1 = __uint_as_float(tok[row * 8 + 2]), g2 = __uint_as_float(tok[row * 8 + 3]); const unsigned s1 = tok[row * 8 + 4], s2 = tok[row * 8 + 5];
        f32x4 fv[4], hv[4];
#pragma unroll
        for (int j = 0; j < 4; ++j) { const int col = F.lane * 4 + 256 * j; fv[j] = *(const f32x4*)(YS + (size_t)s1 * D + col) * g1 + *(const f32x4*)(YS + (size_t)s2 * D + col) * g2; }
        ln_core(F, a, row, fv, hv);
    }
}

constexpr int N_STEPS = 25;
#ifndef KMASK
#define KMASK 0xFFFFF
#endif
#define KON(k) ((KMASK >> (k)) & 1)
__global__ void __launch_bounds__(NTHREADS, 2) fwd_kernel(Params kp) {
    extern __shared__ __attribute__((aligned(16))) unsigned char lds[];
    Frame F; F.lds = lds; F.tid = threadIdx.x; F.lane = F.tid & 63; F.wave = __builtin_amdgcn_readfirstlane(F.tid >> 6); F.G = gridDim.x; F.bid = blockIdx.x; F.ws = kp.ws;
    LAS unsigned char* ldsl = (LAS unsigned char*)lds;
    const int lo = kp.lo, hi = kp.hi; int rep1 = 0;
    if (threadIdx.x < 4) ((LAS unsigned*)(ldsl + LDS_BARST))[threadIdx.x] = 0u;
    __syncthreads();
    const XcdBarrier xbar = xcd_barrier_post((unsigned*)(kp.ws + OFF_CTL) + CW_BAR, (volatile LAS unsigned*)(ldsl + LDS_BARST));
    for (int s = lo; s < hi; ++s) {
        { const Params* pp_ = (const Params*)__builtin_amdgcn_kernarg_segment_ptr(); asm volatile("" : "+s"(pp_) :: "memory"); F.pp = pp_; unsigned char* ws_ = kp.ws; asm volatile("" : "+s"(ws_)); F.ws = ws_; }
        const Params& p = *F.pp;
        { int tid_ = threadIdx.x; asm volatile("" : "+v"(tid_)); F.tid = tid_; F.lane = tid_ & 63; F.wave = __builtin_amdgcn_readfirstlane(tid_ >> 6); }
        int layer = 0, kind = s;
        if (s >= 13) { layer = 1; kind = s - 11; }
        const float* mod = (const float*)(F.ws + OFF_CTL) + CW_MOD;
        const float* modl = mod + layer * 6144;
        if (KON(0) && s == 0) step_pre(F);
        else if (KON(1) && s == 1) step_h0(F);
        else if (KON(2) && kind == 2) { g8::DenseOrder S; S.init(WSP(h16, OFF_H), WSP(h16, OFF_WT_IN) + (size_t)layer * INW * D, M, INW, D, F.G, F.bid); g8::EpiF16 E{WSP(h16, OFF_PROJ), INW}; g8::gemm_phase(ldsl, F.tid, D, S, E); }
        else if (KON(3) && kind == 3) step_rot(F, layer);
        else if (KON(4) && kind == 4) { step_mix(F, layer); if (PROBE_DUP & 4) { __syncthreads(); step_mix(F, layer); } }
        else if (KON(5) && kind == 5) { step_hg2(F); if (PROBE_DUP & 4) step_hg2(F); }
        else if (KON(6) && kind == 6) { step_hg3(F, layer); if (PROBE_DUP & 4) step_hg3(F, layer); }
        else if (KON(7) && kind == 7) { step_afin(F, layer); if (PROBE_DUP & 4) step_afin(F, layer); }
        else if (KON(8) && kind == 8) { g8::DenseOrder S; S.init(WSP(h16, OFF_Y), WSP(h16, OFF_WT_OUT) + (size_t)layer * D * D, M, D, D, F.G, F.bid); g8::EpiF32 E{WSP(float, OFF_Z), D}; g8::gemm_phase(ldsl, F.tid, D, S, E); }
        else if (KON(9) && kind == 9) { LnArgs a{layer == 0 ? p.x : WSP(float, OFF_X), modl + 2048, p.lnw + (size_t)(layer * 2) * D, p.lnb + (size_t)(layer * 2) * D, modl + 4096, modl + 3072, WSP(float, OFF_X), WSP(h16, OFF_H)};
            step_ln_dense(F, a, WSP(float, OFF_Z), layer == 1); }
        else if (KON(10) && layer == 0 && kind == 10) { g8::DenseOrder S; S.init(WSP(h16, OFF_H), WSP(h16, OFF_WT_UP), M, 2 * FFN, D, F.G, F.bid); g8::EpiSwiGLU E{WSP(h16, OFF_PROJ), FFN}; g8::gemm_phase(ldsl, F.tid, D, S, E); }
        else if (KON(11) && layer == 0 && kind == 11) { g8::DenseOrder S; S.init(WSP(h16, OFF_PROJ), WSP(h16, OFF_WT_DOWN), M, D, FFN, F.G, F.bid); g8::EpiF32 E{WSP(float, OFF_Z), D}; g8::gemm_phase(ldsl, F.tid, FFN, S, E); }
        else if (KON(12) && layer == 0 && kind == 12) { LnArgs a{WSP(float, OFF_X), modl + 5120, p.lnw + (size_t)1 * D, p.lnb + (size_t)1 * D, mod + 6144 + 1024, mod + 6144 + 0, WSP(float, OFF_X), WSP(h16, OFF_H)};
            step_ln_dense(F, a, WSP(float, OFF_Z), false); }
        else if (KON(13) && layer == 1 && kind == 10) step_slot(F);
        else if (KON(14) && layer == 1 && kind == 11) { g8::MoeOrder S; S.init(WSP(h16, OFF_PROJ), WSP(h16, OFF_WT_MUP), (size_t)2 * EDIM * D * 2, 2 * EDIM, D, F.G, F.bid, (const unsigned*)(F.ws + OFF_CTL) + CW_CNT);
            g8::EpiSwiGLU E{WSP(h16, OFF_BIG), EDIM}; g8::gemm_phase(ldsl, F.tid, D, S, E); }
        else if (KON(15) && layer == 1 && kind == 12) { g8::MoeOrder S; S.init(WSP(h16, OFF_BIG), WSP(h16, OFF_WT_MDOWN), (size_t)D * EDIM * 2, D, EDIM, F.G, F.bid, (const unsigned*)(F.ws + OFF_CTL) + CW_CNT);
            g8::EpiF32 E{WSP(float, OFF_PROJ), D}; g8::gemm_phase(ldsl, F.tid, EDIM, S, E); }
        else if (KON(16) && layer == 1 && kind == 13) { LnArgs a{WSP(float, OFF_X), modl + 5120, p.lnw + (size_t)3 * D, p.lnb + (size_t)3 * D, nullptr, nullptr, p.out, nullptr}; step_ln_moe(F, a); }
        if (s + 1 < hi) { if (s == lo) cg::this_grid().sync(); else xcd_barrier(xbar); if (PROBE_DUP & 2) xcd_barrier(xbar); }
        if (PROBE_DUP & 1) { const bool isg = (kind == 2 || kind == 8 || (layer == 0 && (kind == 10 || kind == 11)) || (layer == 1 && (kind == 11 || kind == 12))) && s >= 2; if (isg && rep1 == 0) { rep1 = 1; --s; } else rep1 = 0; }
    }
}

extern "C" void kernel_launch(void* const* d_in, const int* in_sizes, int n_in, void* d_out, int out_size, void* d_ws, size_t ws_size, hipStream_t stream) {
    static int grid = 0;
    if (grid == 0) {
        if (n_in != 21 || in_sizes[0] != M * D || out_size != M * D || ws_size < OFF_END) { fprintf(stderr, "kernel_launch: unexpected shapes / workspace (%d inputs, ws %zu, need %zu)\n", n_in, ws_size, (size_t)OFF_END); grid = -1; return; }
        int dev = 0, cus = 0, per_cu = 0;
        hipGetDevice(&dev); hipDeviceGetAttribute(&cus, hipDeviceAttributeMultiprocessorCount, dev);
        hipFuncSetAttribute((const void*)fwd_kernel, hipFuncAttributeMaxDynamicSharedMemorySize, LDS_BYTES);
        hipOccupancyMaxActiveBlocksPerMultiprocessor(&per_cu, (const void*)fwd_kernel, NTHREADS, LDS_BYTES);
        if (per_cu < 1) { fprintf(stderr, "kernel_launch: occupancy query says %d blocks per CU\n", per_cu); per_cu = 1; }
        grid = cus * 1;
        fprintf(stderr, "kernel_launch: grid %d (cus %d, per_cu %d), ws %zu\n", grid, cus, per_cu, ws_size);
    }
    if (grid < 0) return;
    hipMemsetAsync((char*)d_ws + OFF_CTL, 0, CTL_BYTES, stream);
    Params p{};
    p.x = (const float*)d_in[0]; p.c = (const float*)d_in[1]; p.pos = (const int*)d_in[2]; p.w_ada = (const float*)d_in[3]; p.b_ada = (const float*)d_in[4];
    p.w_in = (const float*)d_in[5]; p.w_out = (const float*)d_in[6]; p.alb = (const float*)d_in[7]; p.anw = (const float*)d_in[8]; p.cw = (const float*)d_in[9];
    p.cb = (const float*)d_in[10]; p.cnw = (const float*)d_in[11]; p.cnb = (const float*)d_in[12]; p.sink = (const float*)d_in[13]; p.lnw = (const float*)d_in[14];
    p.lnb = (const float*)d_in[15]; p.fup = (const float*)d_in[16]; p.fdown = (const float*)d_in[17]; p.rout = (const float*)d_in[18]; p.mup = (const float*)d_in[19];
    p.mdown = (const float*)d_in[20]; p.out = (float*)d_out; p.ws = (unsigned char*)d_ws;
#if MK_ONE_LAUNCH
    p.lo = 0; p.hi = N_STEPS;
    { void* args[] = {&p}; hipError_t e = hipLaunchCooperativeKernel((const void*)fwd_kernel, dim3(grid), dim3(NTHREADS), args, LDS_BYTES, stream);
      if (e != hipSuccess) fprintf(stderr, "cooperative launch failed: %s\n", hipGetErrorString(e)); }
#else
    for (int s = 0; s < N_STEPS; ++s) { p.lo = s; p.hi = s + 1;
        void* args[] = {&p}; hipError_t e = hipLaunchCooperativeKernel((const void*)fwd_kernel, dim3(grid), dim3(NTHREADS), args, LDS_BYTES, stream);
        if (e != hipSuccess) { fprintf(stderr, "launch %d failed: %s\n", s, hipGetErrorString(e)); break; } }
#endif
}
```

```cpp
#include <hip/hip_runtime.h>
#include <hip/hip_cooperative_groups.h>
#include <cstdio>
#include <cstdint>
namespace cg = cooperative_groups;

#ifndef ATT_NAIVE
#define ATT_NAIVE 0
#endif
#ifndef PROBE_DUP
#define PROBE_DUP 0
#endif
#ifndef MK_ONE_LAUNCH
#define MK_ONE_LAUNCH 1
#endif

#define LAS __attribute__((address_space(3)))
typedef _Float16 h16;
typedef h16 h16x8 __attribute__((ext_vector_type(8)));
typedef h16 h16x4 __attribute__((ext_vector_type(4)));
typedef h16 h16x2 __attribute__((ext_vector_type(2)));
typedef float f32x4 __attribute__((ext_vector_type(4)));
typedef float f32x2 __attribute__((ext_vector_type(2)));
typedef unsigned u32x4 __attribute__((ext_vector_type(4)));
typedef unsigned u32x2 __attribute__((ext_vector_type(2)));

constexpr int M = 16384, D = 1024, INW = 3072, FFN = 2816, NE = 8, EDIM = 3584;
constexpr int MOE_ROWS = 2 * M + NE * 256;
constexpr float ALPHA = 1.41421356237309515f;
constexpr float LN_EPS = 1e-5f, RMS_EPS = 1e-6f;
constexpr int NTHREADS = 512, NWAVES = 8;
constexpr int LDS_BYTES = 139264;

constexpr int PA_Q = 0, PA_FF = 256, PA_FB = 512, PA_I = 768, PA_G = 1024, PB_V = 1280, PB_G = 1536;
constexpr int PC_Q = 1792, PC_K = 2048, PC_V = 2304, PD_Q = 2560, PD_K = 2816, PD_V = 2944;

constexpr size_t MiB = 1u << 20;
constexpr size_t OFF_CTL = 0, CTL_BYTES = 1 * MiB;
constexpr size_t OFF_TAB = 1 * MiB;
constexpr size_t OFF_TOK = 2 * MiB;
constexpr size_t OFF_WT_IN = 4 * MiB;
constexpr size_t OFF_WT_OUT = 16 * MiB;
constexpr size_t OFF_WT_UP = 20 * MiB;
constexpr size_t OFF_WT_DOWN = 31 * MiB;
constexpr size_t OFF_WT_MUP = 37 * MiB;
constexpr size_t OFF_WT_MDOWN = 149 * MiB;
constexpr size_t OFF_X = 205 * MiB;
constexpr size_t OFF_H = 269 * MiB;
constexpr size_t OFF_Y = 301 * MiB;
constexpr size_t OFF_Z = 333 * MiB;
constexpr size_t OFF_PROJ = 397 * MiB;
constexpr size_t OFF_BIG = 533 * MiB;
constexpr size_t OFF_END = 775 * MiB;
constexpr int CW_MOD = 1024;
constexpr int CW_CNT = 64;
constexpr int CW_CUR = 128;
constexpr int CW_BAR = 16384;
constexpr int LDS_BARST = LDS_BYTES - 16;

struct Params {
    const float* x; const float* c; const int* pos; const float* w_ada; const float* b_ada; const float* w_in; const float* w_out;
    const float* alb; const float* anw; const float* cw; const float* cb; const float* cnw; const float* cnb; const float* sink;
    const float* lnw; const float* lnb; const float* fup; const float* fdown; const float* rout; const float* mup; const float* mdown;
    float* out; unsigned char* ws; int lo, hi;
};

__device__ __forceinline__ unsigned pk2(float lo, float hi) { h16x2 v; v.x = (h16)lo; v.y = (h16)hi; return __builtin_bit_cast(unsigned, v); }
__device__ __forceinline__ float sigmoidf_(float v) { return 1.0f / (1.0f + __expf(-v)); }
__device__ __forceinline__ float siluf_(float v) { return v / (1.0f + __expf(-v)); }
__device__ __forceinline__ float wave_sum(float v) {
#pragma unroll
    for (int o = 1; o < 64; o <<= 1) v += __shfl_xor(v, o);
    return v;
}
#define LDS_WAIT() asm volatile("s_waitcnt lgkmcnt(0)" ::: "memory")

namespace g8 {
constexpr int BM = 256, BK = 64, HALF = 128, HTB = HALF * BK * 2, STAGE_BYTES = 8 * HTB, NXCD = 8, WGM = 8;
__device__ __forceinline__ int lds_byte(int r, int c) { const int st = (r >> 4) * 2 + (c >> 5), rr = r & 15, cc = c & 31, ob = rr * 64 + cc * 2; return st * 1024 + (ob ^ (((ob >> 9) & 1) << 5)); }
__device__ __forceinline__ void stage_rc(int b, int& R, int& C) { const int st = b / 1024, sb = b % 1024, swz = sb ^ (((sb >> 9) & 1) << 5); R = (st >> 1) * 16 + swz / 64; C = (st & 1) * 32 + (swz % 64) / 2; }
__device__ __forceinline__ int perm32(int rho) { const int n = rho >> 4, i = rho & 15; return 8 * (i >> 2) + 4 * n + (i & 3); }

struct Unit { const char* A; const char* B; int pm, pn; };

__device__ __forceinline__ void tile_of(int L, int nM, int nN, int& pm, int& pn) {
    const int nwg = nM * nN; int wgid = L;
    { const int q = nwg / NXCD, r = nwg % NXCD, xcd = wgid % NXCD, off = wgid / NXCD; wgid = (xcd < r ? xcd * (q + 1) : r * (q + 1) + (xcd - r) * q) + off; }
    const int nig = WGM * nN, gid = wgid / nig, fm = gid * WGM, gsz = (nM - fm) < WGM ? (nM - fm) : WGM;
    pm = fm + ((wgid % nig) % gsz); pn = (wgid % nig) / gsz;
}
struct DenseOrder {
    const char* A; const char* B; int K, nM, nN, G, c;
    __device__ void init(const void* A_, const void* B_, int Mr, int N, int K_, int G_, int c_) { A = (const char*)A_; B = (const char*)B_; K = K_; nM = Mr / BM; nN = N / BM; G = G_; c = c_; }
    __device__ __forceinline__ bool next(int i, Unit& u) const {
        const long L = (long)i * G + c; if (L >= (long)nM * nN) return false;
        tile_of((int)L, nM, nN, u.pm, u.pn);
        u.A = A + (size_t)u.pm * BM * K * 2; u.B = B + (size_t)u.pn * BM * K * 2; return true;
    }
};
struct MoeOrder {
    const char* A; const char* B; size_t bstride; int K, nM, nN, G, c; int t1, t2, t3, t4, t5, t6, t7;
    __device__ void init(const void* A_, const void* B_, size_t bstride_, int N, int K_, int G_, int c_, const unsigned* cnt) {
        A = (const char*)A_; B = (const char*)B_; bstride = bstride_; K = K_; nN = N / BM; G = G_; c = c_;
        int t = 0;
#define RT_(e) ((int)((__builtin_amdgcn_readfirstlane((int)cnt[e]) + 255) >> 8))
        t += RT_(0); t1 = t; t += RT_(1); t2 = t; t += RT_(2); t3 = t; t += RT_(3); t4 = t; t += RT_(4); t5 = t; t += RT_(5); t6 = t; t += RT_(6); t7 = t; t += RT_(7); nM = t;
#undef RT_
    }
    __device__ __forceinline__ bool next(int i, Unit& u) const {
        const long L = (long)i * G + c; if (L >= (long)nM * nN) return false;
        tile_of((int)L, nM, nN, u.pm, u.pn);
        const int e = (u.pm >= t1) + (u.pm >= t2) + (u.pm >= t3) + (u.pm >= t4) + (u.pm >= t5) + (u.pm >= t6) + (u.pm >= t7);
        u.A = A + (size_t)u.pm * BM * K * 2; u.B = B + (size_t)e * bstride + (size_t)u.pn * BM * K * 2; return true;
    }
};

struct EpiF16 {
    static constexpr bool PERM = true;
    h16* O; int ldc;
    __device__ __forceinline__ void operator()(const f32x4 (&acc)[2][2][4][2], const Unit& u, int wr, int wc, int fr, int fq) const {
        const int row0 = u.pm * BM + wr * 64 + fr, col0 = u.pn * BM + wc * 32 + 8 * fq;
#pragma unroll
        for (int ai = 0; ai < 2; ++ai)
#pragma unroll
            for (int m = 0; m < 4; ++m) { h16* rowp = O + (size_t)(row0 + ai * HALF + m * 16) * ldc + col0;
#pragma unroll
                for (int bj = 0; bj < 2; ++bj) { const f32x4 v0 = acc[ai][bj][m][0], v1 = acc[ai][bj][m][1];
                    u32x4 w; w.x = pk2(v0[0], v0[1]); w.y = pk2(v0[2], v0[3]); w.z = pk2(v1[0], v1[1]); w.w = pk2(v1[2], v1[3]);
                    *(u32x4*)(rowp + bj * HALF) = w; } }
    }
};
struct EpiSwiGLU {
    static constexpr bool PERM = true;
    h16* O; int ldh;
    __device__ __forceinline__ void operator()(const f32x4 (&acc)[2][2][4][2], const Unit& u, int wr, int wc, int fr, int fq) const {
        const int row0 = u.pm * BM + wr * 64 + fr, col0 = u.pn * (BM / 2) + wc * 16 + 4 * fq;
#pragma unroll
        for (int ai = 0; ai < 2; ++ai)
#pragma unroll
            for (int m = 0; m < 4; ++m) { h16* rowp = O + (size_t)(row0 + ai * HALF + m * 16) * ldh + col0;
#pragma unroll
                for (int bj = 0; bj < 2; ++bj) { const f32x4 g = acc[ai][bj][m][0], up = acc[ai][bj][m][1];
                    u32x2 w; w.x = pk2(siluf_(g[0]) * up[0], siluf_(g[1]) * up[1]); w.y = pk2(siluf_(g[2]) * up[2], siluf_(g[3]) * up[3]);
                    *(u32x2*)(rowp + bj * (HALF / 2)) = w; } }
    }
};
struct EpiF32 {
    static constexpr bool PERM = false;
    float* C; int ldc;
    __device__ __forceinline__ void operator()(const f32x4 (&acc)[2][2][4][2], const Unit& u, int wr, int wc, int fr, int fq) const {
        const int row0 = u.pm * BM + wr * 64 + fr, col0 = u.pn * BM + wc * 32 + 4 * fq;
#pragma unroll
        for (int ai = 0; ai < 2; ++ai)
#pragma unroll
            for (int m = 0; m < 4; ++m) { float* rowp = C + (size_t)(row0 + ai * HALF + m * 16) * ldc + col0;
#pragma unroll
                for (int bj = 0; bj < 2; ++bj)
#pragma unroll
                    for (int n = 0; n < 2; ++n) *(f32x4*)(rowp + bj * HALF + n * 16) = acc[ai][bj][m][n]; }
    }
};

template <class Epi, class Sched>
__device__ __forceinline__ void gemm_phase(LAS unsigned char* lds, const int tid, const int K, const Sched& S, const Epi& E) {
    const int wid = __builtin_amdgcn_readfirstlane(tid >> 6), lane = tid & 63, wr = wid >> 2, wc = wid & 3, fr = lane & 15, fq = lane >> 4;
    const int nt = K / BK;
    unsigned voffA[2], voffB[2];
#pragma unroll
    for (int i = 0; i < 2; ++i) { int R, C; stage_rc(tid * 16 + i * 8192, R, C); const int Rb = Epi::PERM ? ((R & ~31) + perm32(R & 31)) : R;
        voffA[i] = (unsigned)(R * K + C) * 2u; voffB[i] = (unsigned)(Rb * K + C) * 2u; }
    const size_t kstep = (size_t)(BK * 2);
    const size_t hstep = (size_t)HALF * K * 2;
    const unsigned ldsw = (unsigned)wid * 1024u;
    const int aoff = lds_byte(wr * 64 + fr, fq * 8), boff = lds_byte(wc * 32 + fr, fq * 8);
#define G8_SA(b, h) (((b) * 2 + (h)) * HTB)
#define G8_SB(b, h) ((4 + (b) * 2 + (h)) * HTB)
#define G8_STAGE(bufoff, gbase, voff) do { _Pragma("unroll") for (int _i = 0; _i < 2; ++_i) \
        __builtin_amdgcn_global_load_lds((const unsigned*)((const char*)(gbase) + (voff)[_i]), (LAS unsigned*)(lds + (bufoff) + ldsw + _i * 8192), 16, 0, 0); } while (0)
#define G8_LDA(dst, b, h) do { _Pragma("unroll") for (int m = 0; m < 4; ++m) _Pragma("unroll") for (int k = 0; k < 2; ++k) dst[m][k] = *(const LAS h16x8*)(lds + G8_SA(b, h) + aoff + m * 2048 + k * 1024); } while (0)
#define G8_LDB(dst, b, h) do { _Pragma("unroll") for (int n = 0; n < 2; ++n) _Pragma("unroll") for (int k = 0; k < 2; ++k) dst[n][k] = *(const LAS h16x8*)(lds + G8_SB(b, h) + boff + n * 2048 + k * 1024); } while (0)
#define G8_MMA(ai, bj, At, Bt) do { __builtin_amdgcn_s_setprio(1); _Pragma("unroll") for (int m = 0; m < 4; ++m) _Pragma("unroll") for (int n = 0; n < 2; ++n) _Pragma("unroll") for (int k = 0; k < 2; ++k) \
        acc[ai][bj][m][n] = __builtin_amdgcn_mfma_f32_16x16x32_f16(Bt[n][k], At[m][k], acc[ai][bj][m][n], 0, 0, 0); __builtin_amdgcn_s_setprio(0); } while (0)
#define G8_WAIT_V(n) asm volatile("s_waitcnt vmcnt(" #n ")" ::: "memory")
#define G8_WAIT_L(n) asm volatile("s_waitcnt lgkmcnt(" #n ")" ::: "memory")
#define G8_BAR __builtin_amdgcn_s_barrier()
#define G8_SCHED __builtin_amdgcn_sched_barrier(0)
    Unit cur, nxt; int ui = 0;
    if (!S.next(0, cur)) return;
    f32x4 acc[2][2][4][2];
#pragma unroll
    for (int a = 0; a < 2; ++a)
#pragma unroll
        for (int b = 0; b < 2; ++b)
#pragma unroll
            for (int m = 0; m < 4; ++m)
#pragma unroll
                for (int n = 0; n < 2; ++n) acc[a][b][m][n] = (f32x4){0.f, 0.f, 0.f, 0.f};
    h16x8 At[4][2], B0[2][2], B1[2][2];
    const char* cA = cur.A; const char* cB = cur.B;
    G8_STAGE(G8_SB(0, 0), cB, voffB); G8_STAGE(G8_SB(0, 1), cB + hstep, voffB); G8_STAGE(G8_SA(0, 0), cA, voffA); G8_STAGE(G8_SA(0, 1), cA + hstep, voffA);
    if (wr == 1) G8_BAR;
    G8_WAIT_V(2); G8_BAR;
    G8_STAGE(G8_SB(1, 0), cB + kstep, voffB); G8_STAGE(G8_SA(1, 0), cA + kstep, voffA); G8_STAGE(G8_SB(1, 1), cB + hstep + kstep, voffB);
    G8_WAIT_V(6); G8_BAR;
    for (;;) {
        const bool has_next = S.next(ui + 1, nxt);
        const char* nA = has_next ? nxt.A : cA; const char* nB = has_next ? nxt.B : cB;
        for (int t = 0; t < nt; t += 2) {
            const bool last = (t == nt - 2);
            const char* a1 = cA + (size_t)(t + 1) * kstep;
            const char* a2 = last ? nA : cA + (size_t)(t + 2) * kstep; const char* b2 = last ? nB : cB + (size_t)(t + 2) * kstep;
            const char* a3 = a2 + kstep; const char* b3 = b2 + kstep;
            G8_LDB(B0, 0, 0); G8_LDB(B1, 0, 1); G8_SCHED; G8_LDA(At, 0, 0); G8_STAGE(G8_SA(1, 1), a1 + hstep, voffA);
            G8_WAIT_V(8); G8_WAIT_L(0); G8_BAR; G8_MMA(0, 0, At, B0); G8_MMA(0, 1, At, B1); G8_BAR; G8_SCHED;
            G8_LDA(At, 0, 1); G8_STAGE(G8_SB(0, 0), b2, voffB); G8_STAGE(G8_SB(0, 1), b2 + hstep, voffB); G8_STAGE(G8_SA(0, 0), a2, voffA);
            G8_WAIT_V(8); G8_WAIT_L(0); G8_BAR; G8_MMA(1, 0, At, B0); G8_MMA(1, 1, At, B1); G8_BAR; G8_SCHED;
            G8_LDB(B0, 1, 0); G8_LDB(B1, 1, 1); G8_SCHED; G8_LDA(At, 1, 0); G8_STAGE(G8_SA(0, 1), a2 + hstep, voffA);
            G8_WAIT_V(8); G8_WAIT_L(0); G8_BAR; G8_MMA(0, 0, At, B0); G8_MMA(0, 1, At, B1); G8_BAR; G8_SCHED;
            G8_LDA(At, 1, 1); G8_STAGE(G8_SB(1, 0), b3, voffB); G8_STAGE(G8_SB(1, 1), b3 + hstep, voffB); G8_STAGE(G8_SA(1, 0), a3, voffA);
            G8_WAIT_V(8); G8_WAIT_L(0); G8_BAR; G8_MMA(1, 0, At, B0); G8_MMA(1, 1, At, B1); G8_BAR; G8_SCHED;
        }
        if (wr == 0) G8_BAR;
        { int fr_e = fr, fq_e = fq; asm volatile("" : "+v"(fr_e), "+v"(fq_e)); E(acc, cur, wr, wc, fr_e, fq_e); }
        if (!has_next) break;
#pragma unroll
        for (int a = 0; a < 2; ++a)
#pragma unroll
            for (int b = 0; b < 2; ++b)
#pragma unroll
                for (int m = 0; m < 4; ++m)
#pragma unroll
                    for (int n = 0; n < 2; ++n) acc[a][b][m][n] = (f32x4){0.f, 0.f, 0.f, 0.f};
        cur = nxt; cA = nA; cB = nB; ++ui;
        if (wr == 1) G8_BAR;
    }
    G8_WAIT_V(0);
    G8_BAR;
#undef G8_SA
#undef G8_SB
#undef G8_STAGE
#undef G8_LDA
#undef G8_LDB
#undef G8_MMA
#undef G8_WAIT_V
#undef G8_WAIT_L
#undef G8_BAR
#undef G8_SCHED
}
}


#define XB_TMO      128
#define XB_XCNT(j)  (256  + 64 * (j))
#define XB_XSUB(j)  (1280 + 64 * (j))
#define XB_XGEN(j)  (2304 + 64 * (j))
#define XB_TOP      3328
#define XB_TOPGEN   3392
#define XCD_BAR_WORDS 3456
#define XB_SPIN_CAP (1u << 18)
__device__ __forceinline__ unsigned xb_ld(unsigned* p)              { return __hip_atomic_load(p, __ATOMIC_RELAXED, __HIP_MEMORY_SCOPE_AGENT); }
__device__ __forceinline__ unsigned xb_add(unsigned* p, unsigned v) { return __hip_atomic_fetch_add(p, v, __ATOMIC_RELAXED, __HIP_MEMORY_SCOPE_AGENT); }
__device__ __forceinline__ unsigned xb_xcc_id() { return (unsigned)__builtin_amdgcn_s_getreg((3 << 11) | 20) & 0xFu; }
#define XB_SPIN(cond, bar) do { unsigned _sp = 0; while (cond) { __builtin_amdgcn_s_sleep(1); \
    if ((++_sp & 255u) == 0u) { if (xb_ld(&(bar)[XB_TMO])) break; if (_sp > XB_SPIN_CAP) { atomicAdd(&(bar)[XB_TMO], 1u); break; } } } } while (0)
struct XcdBarrier { unsigned* bar; unsigned x; volatile LAS unsigned* st; };
__device__ __forceinline__ XcdBarrier xcd_barrier_post(unsigned* bar, volatile LAS unsigned* st) {
    XcdBarrier b; b.bar = bar; b.x = xb_xcc_id(); b.st = st;
    if (threadIdx.x == 0) (void)xb_add(&bar[XB_XCNT(b.x)], 1u);
    return b;
}
__device__ __forceinline__ void xcd_barrier_complete(unsigned* bar, unsigned x, unsigned& nloc, unsigned& nx) {
    const unsigned G = gridDim.x * gridDim.y * gridDim.z;
    unsigned sum, cnt, mine, sp = 0u;
    for (;;) {
        sum = 0u; cnt = 0u; mine = 0u;
#pragma unroll
        for (unsigned j = 0; j < 16; ++j) { const unsigned c = xb_ld(&bar[XB_XCNT(j)]); sum += c; cnt += (c > 0u) ? 1u : 0u; mine = (j == x) ? c : mine; }
        if (sum == G) break;
        __builtin_amdgcn_s_sleep(1);
        if ((++sp & 255u) == 0u) { if (xb_ld(&bar[XB_TMO])) break; if (sp > XB_SPIN_CAP) { atomicAdd(&bar[XB_TMO], 1u); break; } }
    }
    nloc = mine > 0u ? mine : 1u; nx = cnt > 0u ? cnt : 1u;
}
__device__ __forceinline__ void xcd_barrier(const XcdBarrier& b) {
    asm volatile("s_waitcnt vmcnt(0)" ::: "memory");
    __syncthreads();
    if (threadIdx.x == 0) {
        unsigned* bar = b.bar;
        __builtin_amdgcn_s_waitcnt(0);
        unsigned nloc = b.st[0], nx = b.st[1];
        if (nloc == 0u) { xcd_barrier_complete(bar, b.x, nloc, nx); b.st[0] = nloc; b.st[1] = nx; }
        const unsigned old = xb_add(&bar[XB_XSUB(b.x)], 1u);
        const unsigned gen = old / nloc;
        if (old + 1u == (gen + 1u) * nloc) {
            __builtin_amdgcn_fence(__ATOMIC_RELEASE, "agent");
            asm volatile("s_waitcnt vmcnt(0)" ::: "memory");
            const unsigned og = xb_add(&bar[XB_TOP], 1u);
            const unsigned tg = og / nx;
            if (og + 1u == (tg + 1u) * nx) xb_add(&bar[XB_TOPGEN], 1u);
            else XB_SPIN(xb_ld(&bar[XB_TOPGEN]) == tg, bar);
            __builtin_amdgcn_fence(__ATOMIC_ACQUIRE, "agent");
            xb_add(&bar[XB_XGEN(b.x)], 1u);
            asm volatile("s_waitcnt vmcnt(0)" ::: "memory");
        } else {
            XB_SPIN(xb_ld(&bar[XB_XGEN(b.x)]) == gen, bar);
            __builtin_amdgcn_fence(__ATOMIC_ACQUIRE, "agent");
            asm volatile("s_waitcnt vmcnt(0)" ::: "memory");
        }
    }
    __syncthreads();
}

struct Frame {
    unsigned char* lds; int tid, lane, wave, G, bid;
    const Params* pp;
    unsigned char* ws;
};
#define WSP(T, off) ((T*)(F.ws + (off)))

struct MapId { __device__ __forceinline__ int operator()(int n) const { return n; } };
struct MapGU { int half; __device__ __forceinline__ int operator()(int n) const { const int up = n >= half, j = up ? n - half : n; return 8 * (j >> 2) + 4 * up + (j & 3); } };

template <class RowMap>
__device__ __forceinline__ void xpose_tile(const float* __restrict__ W, int N, h16* __restrict__ WT, int K, int k0, int n0, float* scr, int lane, RowMap rm) {
    f32x4 v[16];
    const int r4 = lane >> 4, c4 = (lane & 15) * 4;
#pragma unroll
    for (int i = 0; i < 16; ++i) v[i] = *(const f32x4*)(W + (size_t)(k0 + i * 4 + r4) * N + n0 + c4);
#pragma unroll
    for (int i = 0; i < 16; ++i) { float* s = scr + (i * 4 + r4) * 65 + c4; s[0] = v[i].x; s[1] = v[i].y; s[2] = v[i].z; s[3] = v[i].w; }
    LDS_WAIT();
    const int c = lane & 7;
#pragma unroll
    for (int j = 0; j < 8; ++j) { const int n = (lane >> 3) + 8 * j; const float* s = scr + (8 * c) * 65 + n;
        u32x4 o; o.x = pk2(s[0], s[65]); o.y = pk2(s[130], s[195]); o.z = pk2(s[260], s[325]); o.w = pk2(s[390], s[455]);
        *(u32x4*)(WT + (size_t)rm(n0 + n) * K + k0 + 8 * c) = o; }
    LDS_WAIT();
}
template <class RowMap>
__device__ __forceinline__ void xpose_matrix(Frame& F, const float* W, int K, int N, h16* WT, RowMap rm, int& tbase) {
    const int gw = F.bid * NWAVES + F.wave, NGW = F.G * NWAVES;
    const int nkt = K / 64, nnt = N / 64, ntile = nkt * nnt;
    float* scr = (float*)(F.lds) + F.wave * (64 * 65);
    int first = gw - (tbase % NGW); if (first < 0) first += NGW;
    for (int t = first; t < ntile; t += NGW) { const int kt = t / nnt, ntt = t % nnt; xpose_tile(W, N, WT, K, kt * 64, ntt * 64, scr, F.lane, rm); }
    tbase += ntile;
}
__device__ __forceinline__ void step_pre(Frame& F) {
    const Params& p = *F.pp;
    for (int rep2_ = 0; rep2_ < ((PROBE_DUP & 64) ? 2 : 1); ++rep2_) {
    { float* modout = (float*)(F.ws + OFF_CTL) + CW_MOD; f32x4* red = (f32x4*)F.lds;
      for (int it = F.bid; it < 256; it += F.G) {
          const int l = it >> 7, c0 = (it & 127) * 48;
          if (F.tid < 480) { const int cg4 = F.tid % 12, dg = F.tid / 12; f32x4 a = {0.f, 0.f, 0.f, 0.f};
#pragma unroll
              for (int i = 0; i < 26; ++i) { const int d = dg + 40 * i; if (d < D) { const f32x4 w = *(const f32x4*)(p.w_ada + ((size_t)(l * 1024 + d)) * 6144 + c0 + cg4 * 4); a += w * siluf_(p.c[d]); } }
              red[dg * 12 + cg4] = a; }
          __syncthreads();
          if (F.tid < 48) { float sum = 0.f; const float* rf = (const float*)red;
              for (int dg = 0; dg < 40; ++dg) sum += rf[dg * 48 + F.tid];
              modout[l * 6144 + c0 + F.tid] = sum + p.b_ada[l * 6144 + c0 + F.tid]; }
          __syncthreads();
      } }
    { f32x2* tab = WSP(f32x2, OFF_TAB);
      for (int idx = F.bid * NTHREADS + F.tid; idx < M * 8; idx += F.G * NTHREADS) { const int t = idx >> 3, i = idx & 7;
          const float fhi = i == 0 ? 1.0f : i == 1 ? 0.1939227432012558f : i == 2 ? 0.03760603070259094f : i == 3 ? 0.007292664609849453f : i == 4 ? 0.0014142135623842478f : i == 5 ? 0.00027424818836152554f : i == 6 ? 5.3182957344688475e-05f : 1.0313385246263351e-05f;
          const float flo = i == 0 ? 0.0f : i == 1 ? 1.5474299619455678e-09f : i == 2 ? 2.2827298384875405e-10f : i == 3 ? 1.2736765808707418e-10f : i == 4 ? -1.115275406748939e-14f : i == 5 ? -1.2685318073746288e-11f : i == 6 ? 1.624761414818765e-12f : 1.309491116886427e-13f;
          const float ps = (float)p.pos[t];
          const float ph = ps * fhi, pe = fmaf(ps, fhi, -ph) + ps * flo;
          const float kk = rintf(ph * 0.15915494309189535f);
          float r = fmaf(-kk, 6.2831854820251465f, ph); r = fmaf(-kk, -1.7484555314695172e-07f, r); r += pe;
          float sn, cs; sincosf(r, &sn, &cs); tab[idx] = (f32x2){(float)cs, (float)sn}; } }
    }
    for (int rep_ = 0; rep_ < ((PROBE_DUP & 8) ? 2 : 1); ++rep_) {
    int tb = 0;
    for (int l = 0; l < 2; ++l) xpose_matrix(F, p.w_in + (size_t)l * D * INW, D, INW, WSP(h16, OFF_WT_IN) + (size_t)l * INW * D, MapId{}, tb);
    for (int l = 0; l < 2; ++l) xpose_matrix(F, p.w_out + (size_t)l * D * D, D, D, WSP(h16, OFF_WT_OUT) + (size_t)l * D * D, MapId{}, tb);
    xpose_matrix(F, p.fup, D, 2 * FFN, WSP(h16, OFF_WT_UP), MapGU{FFN}, tb);
    xpose_matrix(F, p.fdown, FFN, D, WSP(h16, OFF_WT_DOWN), MapId{}, tb);
    }
}

constexpr int MOE_TILES_UP = NE * 16 * 112, MOE_TILES = MOE_TILES_UP + NE * 56 * 16;
__device__ __forceinline__ void moe_xpose_range(Frame& F, int widx, int wcnt, int lo, int hi) {
    const Params& p = *F.pp;
    float* scr = (float*)(F.lds) + F.wave * (64 * 65);
#pragma unroll 1
    for (int T = lo + widx; T < hi; T += wcnt) {
        if (T < MOE_TILES_UP) { const int e = T / 1792, r = T % 1792, kt = r / 112, nt = r % 112;
            xpose_tile(p.mup + (size_t)e * D * 2 * EDIM, 2 * EDIM, WSP(h16, OFF_WT_MUP) + (size_t)e * 2 * EDIM * D, D, kt * 64, nt * 64, scr, F.lane, MapGU{EDIM}); }
        else { const int T2 = T - MOE_TILES_UP; const int e = T2 / 896, r = T2 % 896, kt = r >> 4, nt = r & 15;
            xpose_tile(p.mdown + (size_t)e * EDIM * D, D, WSP(h16, OFF_WT_MDOWN) + (size_t)e * D * EDIM, EDIM, kt * 64, nt * 64, scr, F.lane, MapId{}); }
    }
}
__device__ __forceinline__ void step_h0(Frame& F) {
    const float* mod = (const float*)(F.ws + OFF_CTL) + CW_MOD;
    h16* H = WSP(h16, OFF_H);
    for (size_t i = (size_t)F.bid * NTHREADS + F.tid; i < (size_t)M * D / 8; i += (size_t)F.G * NTHREADS) {
        const int col = (int)(i & 127) * 8;
        const f32x4 a = *(const f32x4*)(F.pp->x + i * 8), b = *(const f32x4*)(F.pp->x + i * 8 + 4);
        const f32x4 sh0 = *(const f32x4*)(mod + col), sh1 = *(const f32x4*)(mod + col + 4), sc0 = *(const f32x4*)(mod + 1024 + col), sc1 = *(const f32x4*)(mod + 1024 + col + 4);
        const f32x4 r0 = a * (sc0 + 1.0f) + sh0, r1 = b * (sc1 + 1.0f) + sh1;
        u32x4 w; w.x = pk2(r0[0], r0[1]); w.y = pk2(r0[2], r0[3]); w.z = pk2(r1[0], r1[1]); w.w = pk2(r1[2], r1[3]);
        *(u32x4*)(H + i * 8) = w;
    }
}

constexpr int SSEG = 128, NSS = M / SSEG, NCH = SSEG / 16;
constexpr size_t SCR_SE = OFF_BIG, SCR_SI = OFF_BIG + 32 * MiB, SCR_LP = OFF_BIG + 64 * MiB, SCR_OA = OFF_BIG + 80 * MiB;
__device__ __forceinline__ void step_rot(Frame& F, int layer) {
    h16* P = WSP(h16, OFF_PROJ); const f32x2* tab = WSP(f32x2, OFF_TAB);
    for (int idx = F.bid * NTHREADS + F.tid; idx < M * 14; idx += F.G * NTHREADS) {
        const int t = idx / 14, hh = idx % 14;
        const int cb = hh < 4 ? PC_Q + hh * 64 : hh < 8 ? PC_K + (hh - 4) * 64 : hh < 12 ? PD_Q + (hh - 8) * 64 : PD_K + (hh - 12) * 64;
        h16* ptr = P + (size_t)t * INW + cb;
        const h16x8 x1 = *(const h16x8*)ptr, x2 = *(const h16x8*)(ptr + 8);
        h16x8 o1, o2;
#pragma unroll
        for (int i = 0; i < 8; ++i) { const f32x2 cs = tab[t * 8 + i]; const float a = (float)x1[i], b = (float)x2[i]; o1[i] = (h16)(a * cs.x - b * cs.y); o2[i] = (h16)(b * cs.x + a * cs.y); }
        *(h16x8*)ptr = o1; *(h16x8*)(ptr + 8) = o2;
    }
}

template <int N> __device__ __forceinline__ float row_shr(float v) { return __builtin_bit_cast(float, __builtin_amdgcn_update_dpp(0, __builtin_bit_cast(int, v), 0x110 | N, 0xF, 0xF, true)); }
__device__ __forceinline__ float row_scan16(float v) { v += row_shr<1>(v); v += row_shr<2>(v); v += row_shr<4>(v); v += row_shr<8>(v); return v; }
__device__ __forceinline__ h16x4 cvt4(const f32x4 v) { h16x4 r; r[0] = (h16)v[0]; r[1] = (h16)v[1]; r[2] = (h16)v[2]; r[3] = (h16)v[3]; return r; }
#define MFMA16(a, b, c) __builtin_amdgcn_mfma_f32_16x16x16f16((a), (b), (c), 0, 0, 0)
template <bool FULL>
__device__ __forceinline__ void hg_chunk(const h16* __restrict__ P, const int h, const int dir, const int c0, const int lane, const float (&lb)[4][4], f32x4 (&S)[4][4], float (&lp)[4][4], float* __restrict__ OAdir, const h16x4 ident) {
    const int tau = lane & 15, g = lane >> 4;
    const h16* row = P + (size_t)(c0 + (dir ? 15 - tau : tau)) * INW + h * 64 + 4 * g;
    h16x4 zr[4], qr[4], vr[4];
#pragma unroll
    for (int kt = 0; kt < 4; ++kt) { zr[kt] = *(const h16x4*)(row + (dir ? PA_FB : PA_FF) + 16 * kt); vr[kt] = *(const h16x4*)(row + PA_I + 16 * kt); if (FULL) qr[kt] = *(const h16x4*)(row + PA_Q + 16 * kt); }
    float cum[4][4], kkv[4][4], tot[4][4];
#pragma unroll
    for (int kt = 0; kt < 4; ++kt)
#pragma unroll
        for (int j = 0; j < 4; ++j) { const float z = (float)zr[kt][j]; const float e = __expf(-fabsf(z)), r = 1.0f / (1.0f + e); const float sg = z >= 0.f ? r : e * r, nsg = z >= 0.f ? e * r : r;
            const float oml = 1.0f - lb[kt][j]; cum[kt][j] = row_scan16(__logf(lb[kt][j] + oml * sg)); kkv[kt][j] = oml * nsg; }
#pragma unroll
    for (int kt = 0; kt < 4; ++kt)
#pragma unroll
        for (int j = 0; j < 4; ++j) tot[kt][j] = __shfl(cum[kt][j], (lane & 48) | 15);
    const f32x4 zero4 = {0.f, 0.f, 0.f, 0.f};
    h16x4 KT[4], VT[4];
#pragma unroll
    for (int kt = 0; kt < 4; ++kt) { h16x4 kh;
#pragma unroll
        for (int j = 0; j < 4; ++j) kh[j] = (h16)(kkv[kt][j] * __expf(tot[kt][j] - cum[kt][j]));
        KT[kt] = cvt4(MFMA16(kh, ident, zero4)); VT[kt] = cvt4(MFMA16(vr[kt], ident, zero4)); }
    if (FULL) {
        f32x4 sc = zero4; h16x4 QA[4];
#pragma unroll
        for (int kt = 0; kt < 4; ++kt)
#pragma unroll
            for (int j = 0; j < 4; ++j) { const float ref = __shfl(cum[kt][j], (lane & 48) | 7); const float qs = siluf_((float)qr[kt][j]);
                QA[kt][j] = (h16)(qs * __expf(cum[kt][j]));
                sc = __builtin_amdgcn_mfma_f32_16x16x4f32(kkv[kt][j] * __expf(ref - cum[kt][j]), qs * __expf(cum[kt][j] - ref), sc, 0, 0, 0); }
        h16x4 AA;
#pragma unroll
        for (int j = 0; j < 4; ++j) AA[j] = (h16)((4 * g + j <= tau) ? sc[j] : 0.f);
#pragma unroll
        for (int dt = 0; dt < 4; ++dt) { f32x4 o = MFMA16(AA, VT[dt], zero4);
#pragma unroll
            for (int kt = 0; kt < 4; ++kt) o = MFMA16(QA[kt], cvt4(S[kt][dt]), o);
#pragma unroll
            for (int j = 0; j < 4; ++j) { const int to = 4 * g + j; OAdir[(size_t)(c0 + (dir ? 15 - to : to)) * 256 + h * 64 + 16 * dt + tau] = o[j]; } }
    }
#pragma unroll
    for (int kt = 0; kt < 4; ++kt) { float dec[4];
#pragma unroll
        for (int j = 0; j < 4; ++j) { dec[j] = __expf(tot[kt][j]); lp[kt][j] += tot[kt][j]; }
#pragma unroll
        for (int dt = 0; dt < 4; ++dt) { f32x4 sv = S[kt][dt]; sv[0] *= dec[0]; sv[1] *= dec[1]; sv[2] *= dec[2]; sv[3] *= dec[3]; S[kt][dt] = MFMA16(KT[kt], VT[dt], sv); } }
}
__device__ __forceinline__ void hg_setup(const Frame& F, int layer, int h, float (&lb)[4][4], h16x4& ident) {
    const int tau = F.lane & 15, g = F.lane >> 4;
#pragma unroll
    for (int kt = 0; kt < 4; ++kt)
#pragma unroll
        for (int j = 0; j < 4; ++j) { const int c = h * 64 + 16 * kt + 4 * g + j; lb[kt][j] = (layer == 0 ? 0.f : 1.f) * sigmoidf_(F.pp->alb[256 + c] - F.pp->alb[c]); }
#pragma unroll
    for (int j = 0; j < 4; ++j) ident[j] = (h16)((4 * g + j == tau) ? 1.0f : 0.0f);
}
__device__ __forceinline__ void hg_pass1(Frame& F, int layer) {
    const int gw = F.bid * NWAVES + F.wave, NGW = F.G * NWAVES; const int tau = F.lane & 15, g = F.lane >> 4;
    const h16* P = WSP(h16, OFF_PROJ); float* SE = WSP(float, SCR_SE); float* LP = WSP(float, SCR_LP);
    for (int it = F.wave * F.G + F.bid; it < 8 * NSS; it += NGW) { const int ss = it % NSS, hd = it / NSS, dir = hd & 1, h = hd >> 1;
        float lb[4][4], lp[4][4]; h16x4 ident; f32x4 S[4][4]; hg_setup(F, layer, h, lb, ident);
#pragma unroll
        for (int kt = 0; kt < 4; ++kt)
#pragma unroll
            for (int j = 0; j < 4; ++j) { lp[kt][j] = 0.f; S[kt][j] = (f32x4){0.f, 0.f, 0.f, 0.f}; }
#pragma unroll 1
        for (int ci = 0; ci < NCH; ++ci) hg_chunk<false>(P, h, dir, ss * SSEG + (dir ? NCH - 1 - ci : ci) * 16, F.lane, lb, S, lp, nullptr, ident);
        int l2 = F.lane; asm volatile("" : "+v"(l2));
        float* se = SE + (size_t)it * 4096 + (4 * (l2 >> 4)) * 64 + (l2 & 15);
#pragma unroll
        for (int kt = 0; kt < 4; ++kt)
#pragma unroll
            for (int j = 0; j < 4; ++j) {
#pragma unroll
                for (int dt = 0; dt < 4; ++dt) se[(16 * kt + j) * 64 + 16 * dt] = S[kt][dt][j]; }
        if ((l2 & 15) == 0) {
#pragma unroll
            for (int kt = 0; kt < 4; ++kt)
#pragma unroll
                for (int j = 0; j < 4; ++j) LP[(size_t)it * 64 + 16 * kt + 4 * (l2 >> 4) + j] = lp[kt][j]; }
    }
}
__device__ __forceinline__ void att_unit(Frame& F, int u, int layer);
__device__ __forceinline__ void step_hg2(Frame& F, int layer) {
    const float* SE = WSP(float, SCR_SE); const float* LP = WSP(float, SCR_LP); float* SI = WSP(float, SCR_SI);
    if (F.wave > 0) {
        const int widx = F.bid * 7 + (F.wave - 1), wcnt = F.G * 7;
#pragma unroll 1
        for (int u = 4096 + widx; u < 8192; u += wcnt) att_unit(F, u, layer);
        return;
    }
    for (int e = F.bid * 32 + (F.tid & 31) + (F.tid >> 5) * 32 * F.G; e < 8 * 1024; e += 32 * F.G * 2) { const int hd = e >> 10, cd4 = e & 1023, c = cd4 >> 4;
        f32x4 st = {0.f, 0.f, 0.f, 0.f}; const int dir = hd & 1;
        for (int n0 = 0; n0 < NSS; n0 += 16) { f32x4 se[16]; float lpv[16];
#pragma unroll
            for (int u = 0; u < 16; ++u) { const int n = dir ? NSS - 1 - (n0 + u) : n0 + u; se[u] = *(const f32x4*)(SE + ((size_t)hd * NSS + n) * 4096 + cd4 * 4); lpv[u] = LP[((size_t)hd * NSS + n) * 64 + c]; }
#pragma unroll
            for (int u = 0; u < 16; ++u) { const int n = dir ? NSS - 1 - (n0 + u) : n0 + u; *(f32x4*)(SI + ((size_t)hd * NSS + n) * 4096 + cd4 * 4) = st; st = st * __expf(lpv[u]) + se[u]; } }
    }
}
__device__ __forceinline__ void step_hg3(Frame& F, int layer) {
    if (F.wave >= 4) {
        moe_xpose_range(F, F.bid * 4 + (F.wave - 4), F.G * 4, layer == 0 ? 0 : MOE_TILES / 2, layer == 0 ? MOE_TILES / 2 : MOE_TILES);
        return;
    }
    const int gw = F.bid * NWAVES + F.wave, NGW = F.G * NWAVES; const int tau = F.lane & 15, g = F.lane >> 4;
    const h16* P = WSP(h16, OFF_PROJ); const float* SI = WSP(float, SCR_SI);
    for (int it = F.wave * F.G + F.bid; it < 8 * NSS; it += NGW) { const int ss = it % NSS, hd = it / NSS, dir = hd & 1, h = hd >> 1;
        float lb[4][4], lp[4][4]; h16x4 ident; f32x4 S[4][4]; hg_setup(F, layer, h, lb, ident);
        const float* si = SI + (size_t)it * 4096 + (4 * g) * 64 + tau;
#pragma unroll
        for (int kt = 0; kt < 4; ++kt)
#pragma unroll
            for (int dt = 0; dt < 4; ++dt) {
#pragma unroll
                for (int j = 0; j < 4; ++j) S[kt][dt][j] = si[(16 * kt + j) * 64 + 16 * dt];
                lp[kt][dt] = 0.f; }
        float* OAdir = WSP(float, SCR_OA) + (size_t)dir * M * 256;
#pragma unroll 1
        for (int ci = 0; ci < NCH; ++ci) hg_chunk<true>(P, h, dir, ss * SSEG + (dir ? NCH - 1 - ci : ci) * 16, F.lane, lb, S, lp, OAdir, ident);
    }
}
__device__ __forceinline__ void conv_item(Frame& F, int item, int layer) {
    const Params& p = *F.pp;
    float* U = (float*)F.lds;
    float* Yt = U + 62 * 256;
    const h16* P = WSP(h16, OFF_PROJ);
    const int t0 = item * 32;
    { h16x8 vv[4], gg[4];
#pragma unroll
      for (int n = 0; n < 4; ++n) { const int ch = F.tid + NTHREADS * n, r = ch >> 5, c8 = (ch & 31) * 8; int t = t0 - 15 + r; t = t < 0 ? 0 : (t > M - 1 ? M - 1 : t);
          const h16* row = P + (size_t)t * INW; vv[n] = *(const h16x8*)(row + PB_V + c8); gg[n] = *(const h16x8*)(row + PB_G + c8); }
#pragma unroll
      for (int n = 0; n < 4; ++n) { const int ch = F.tid + NTHREADS * n, r = ch >> 5, c8 = (ch & 31) * 8; const int t = t0 - 15 + r; const bool ok = (t >= 0) && (t < M) && (r < 62);
          if (r < 62) {
#pragma unroll
              for (int e = 0; e < 8; ++e) U[r * 256 + c8 + e] = ok ? (float)vv[n][e] * sigmoidf_((float)gg[n][e]) : 0.f; } } }
    __syncthreads();
    { const int c = F.tid & 255, tg = F.tid >> 8;
      float w[31];
#pragma unroll
      for (int j = 0; j < 31; ++j) w[j] = p.cw[(size_t)layer * 31 * 256 + j * 256 + c];
      const float bias = p.cb[layer * 256 + c];
      for (int tt = tg * 16; tt < tg * 16 + 16; ++tt) { float a = bias;
#pragma unroll
          for (int j = 0; j < 31; ++j) a += w[j] * U[(tt + j) * 256 + c];
          Yt[tt * 256 + c] = a; } }
    __syncthreads();
    { h16* Y = WSP(h16, OFF_Y);
      for (int r = F.wave * 4; r < F.wave * 4 + 4; ++r) {
          const f32x4 v = *(const f32x4*)(Yt + r * 256 + F.lane * 4);
          const float mean = wave_sum((v.x + v.y) + (v.z + v.w)) * (1.f / 256.f);
          const f32x4 d = v - mean;
          const float var = wave_sum((d.x * d.x + d.y * d.y) + (d.z * d.z + d.w * d.w)) * (1.f / 256.f);
          const float rstd = 1.0f / sqrtf(var + LN_EPS);
          const f32x4 nw = *(const f32x4*)(p.cnw + layer * 256 + F.lane * 4), nb = *(const f32x4*)(p.cnb + layer * 256 + F.lane * 4);
          const f32x4 o = d * rstd * nw + nb;
          u32x2 w2; w2.x = pk2(siluf_(o.x), siluf_(o.y)); w2.y = pk2(siluf_(o.z), siluf_(o.w));
          *(u32x2*)(Y + (size_t)(t0 + r) * D + 256 + F.lane * 4) = w2; } }
    __syncthreads();
}
#define ATT_KEY(sidx) do { const int s_ = (sidx); if (s_ >= 0 && s_ < M) { const h16* kr = Pk + (size_t)s_ * INW; const h16* vr = Pv + (size_t)s_ * INW; float sc = 0.f; \
    _Pragma("unroll") for (int c8 = 0; c8 < 8; ++c8) { const h16x8 kk = *(const h16x8*)(kr + 8 * c8); _Pragma("unroll") for (int e = 0; e < 4; ++e) sc = __builtin_amdgcn_fdot2((h16x2){qv[c8][2 * e], qv[c8][2 * e + 1]}, (h16x2){kk[2 * e], kk[2 * e + 1]}, sc, false); } \
    const float mn = fmaxf(m, sc), corr = __expf(m - mn), pw = __expf(sc - mn); l = l * corr + pw; m = mn; \
    _Pragma("unroll") for (int c8 = 0; c8 < 8; ++c8) { const h16x8 vv = *(const h16x8*)(vr + 8 * c8); _Pragma("unroll") for (int e = 0; e < 8; ++e) acc[8 * c8 + e] = acc[8 * c8 + e] * corr + pw * (float)vv[e]; } } } while (0)
__device__ __forceinline__ void attn_naive_item(Frame& F, int item, int layer, int which  ) {
    const int idx = item * NTHREADS + F.tid; const int h = idx >> 14, t = idx & (M - 1);
    const h16* P = WSP(h16, OFF_PROJ);
    const h16* Pq = P + (size_t)t * INW + (which ? PD_Q : PC_Q) + h * 64;
    const h16* Pk = P + (which ? PD_K + (h >> 1) * 64 : PC_K + h * 64);
    const h16* Pv = P + (which ? PD_V + (h >> 1) * 64 : PC_V + h * 64);
    h16x8 qv[8]; float acc[64]; float m = -1e30f, l = 0.f;
#pragma unroll
    for (int c8 = 0; c8 < 8; ++c8) { qv[c8] = *(const h16x8*)(Pq + 8 * c8) * (h16)0.125f;
#pragma unroll
        for (int e = 0; e < 8; ++e) acc[8 * c8 + e] = 0.f; }
    h16* Y = WSP(h16, OFF_Y) + (size_t)t * D + (which ? 768 : 512) + h * 64;
    float scale;
    if (which == 0) {
        for (int j = -64; j <= 64; ++j) ATT_KEY(t + j);
        for (int j = -64; j <= 64; ++j) ATT_KEY(t + 4 * j);
        for (int j = -64; j <= 64; ++j) ATT_KEY(t + 16 * j);
        scale = 1.0f / l;
    } else {
        for (int j = -128; j <= 128; ++j) ATT_KEY(t + j);
        const float sk = F.pp->sink[layer * 4 + h]; const float mt = fmaxf(m, sk), w = __expf(m - mt), den = l * w + __expf(sk - mt);
        scale = w / den;
    }
#pragma unroll
    for (int c8 = 0; c8 < 8; ++c8) { u32x4 w; w.x = pk2(acc[8 * c8] * scale, acc[8 * c8 + 1] * scale); w.y = pk2(acc[8 * c8 + 2] * scale, acc[8 * c8 + 3] * scale);
        w.z = pk2(acc[8 * c8 + 4] * scale, acc[8 * c8 + 5] * scale); w.w = pk2(acc[8 * c8 + 6] * scale, acc[8 * c8 + 7] * scale); *(u32x4*)(Y + 8 * c8) = w; }
}
typedef __attribute__((__vector_size__(4 * sizeof(short)))) short vs4;
typedef __attribute__((address_space(3))) vs4 lds_vs4;
constexpr int ATT_PITCH = 144, ATT_WAVE_LDS = 32 * ATT_PITCH;
struct AttLoad { h16x8 kf[2][2]; u32x4 vc[4]; };
__device__ __forceinline__ void att_load(AttLoad& L, const h16* __restrict__ Kp, const h16* __restrict__ Vp, int tkb, int st, int lane) {
    const int r = lane & 15, g = lane >> 4;
#pragma unroll
    for (int sb = 0; sb < 2; ++sb) { int tk = tkb + (16 * sb + r) * st; tk = tk < 0 ? 0 : (tk > M - 1 ? M - 1 : tk); const h16* kr = Kp + (size_t)tk * INW + 8 * g;
        L.kf[sb][0] = *(const h16x8*)kr; L.kf[sb][1] = *(const h16x8*)(kr + 32); }
#pragma unroll
    for (int n = 0; n < 4; ++n) { int tk = tkb + ((lane >> 3) + 8 * n) * st; tk = tk < 0 ? 0 : (tk > M - 1 ? M - 1 : tk); L.vc[n] = *(const u32x4*)(Vp + (size_t)tk * INW + 8 * (lane & 7)); }
}
template <int WIN>
__device__ __forceinline__ void att_seg(const h16* __restrict__ Kp, const h16* __restrict__ Vp, const int tk0, const int st, const int nblk, const int qo, const h16x8 (&Qf)[2],
                                        float& m, float& l, f32x4 (&O)[4], unsigned char* vlds, const int lane) {
    const int g = lane >> 4;
    AttLoad cur, nxt; att_load(cur, Kp, Vp, tk0, st, lane);
    const f32x4 zero4 = {0.f, 0.f, 0.f, 0.f};
#pragma unroll 1
    for (int blk = 0; blk < nblk; ++blk) {
        const int nb = blk + 1 < nblk ? blk + 1 : blk;
        att_load(nxt, Kp, Vp, tk0 + 32 * nb * st, st, lane);
        LDS_WAIT();
#pragma unroll
        for (int n = 0; n < 4; ++n) *(u32x4*)(vlds + ((lane >> 3) + 8 * n) * ATT_PITCH + 16 * (lane & 7)) = cur.vc[n];
        f32x4 sa = __builtin_amdgcn_mfma_f32_16x16x32_f16(cur.kf[0][0], Qf[0], zero4, 0, 0, 0); sa = __builtin_amdgcn_mfma_f32_16x16x32_f16(cur.kf[0][1], Qf[1], sa, 0, 0, 0);
        f32x4 sb = __builtin_amdgcn_mfma_f32_16x16x32_f16(cur.kf[1][0], Qf[0], zero4, 0, 0, 0); sb = __builtin_amdgcn_mfma_f32_16x16x32_f16(cur.kf[1][1], Qf[1], sb, 0, 0, 0);
        float sv[8]; bool ok[8]; float bm = -1e30f;
#pragma unroll
        for (int e = 0; e < 8; ++e) { const int kk = 32 * blk + 16 * (e >> 2) + 4 * g + (e & 3); const int tk = tk0 + kk * st;
            ok[e] = ((unsigned)(kk - qo) <= (unsigned)WIN) && ((unsigned)tk < (unsigned)M); sv[e] = e < 4 ? sa[e & 3] : sb[e & 3]; bm = ok[e] ? fmaxf(bm, sv[e]) : bm; }
        bm = fmaxf(bm, __shfl_xor(bm, 16)); bm = fmaxf(bm, __shfl_xor(bm, 32));
        const float mn = fmaxf(m, bm), corr = __expf(m - mn); m = mn;
        float ps = 0.f; h16x8 pf;
#pragma unroll
        for (int e = 0; e < 8; ++e) { const float pe = ok[e] ? __expf(sv[e] - mn) : 0.f; ps += pe; pf[e] = (h16)pe; }
        l = l * corr + ps;
        LDS_WAIT();
#pragma unroll
        for (int dt = 0; dt < 4; ++dt) {
            const int q4 = (lane >> 2) & 3, p4 = lane & 3;
            const vs4 r0 = __builtin_amdgcn_ds_read_tr16_b64_v4i16((lds_vs4*)(vlds + (4 * g + q4) * ATT_PITCH + (16 * dt + 4 * p4) * 2));
            const vs4 r1 = __builtin_amdgcn_ds_read_tr16_b64_v4i16((lds_vs4*)(vlds + (16 + 4 * g + q4) * ATT_PITCH + (16 * dt + 4 * p4) * 2));
            typedef short s16x8 __attribute__((ext_vector_type(8)));
            s16x8 vv; vv[0] = r0[0]; vv[1] = r0[1]; vv[2] = r0[2]; vv[3] = r0[3]; vv[4] = r1[0]; vv[5] = r1[1]; vv[6] = r1[2]; vv[7] = r1[3];
            f32x4 o = O[dt]; o[0] *= corr; o[1] *= corr; o[2] *= corr; o[3] *= corr;
            O[dt] = __builtin_amdgcn_mfma_f32_16x16x32_f16(__builtin_bit_cast(h16x8, vv), pf, o, 0, 0, 0); }
        cur = nxt;
    }
}
__device__ __forceinline__ void att_unit(Frame& F, int u, int layer) {
    const int lane = F.lane, i = lane & 15, g = lane >> 4;
    const h16* P = WSP(h16, OFF_PROJ); h16* Y = WSP(h16, OFF_Y);
    unsigned char* vlds = F.lds + F.wave * ATT_WAVE_LDS;
    float m = -1e30f, l = 0.f; f32x4 O[4];
#pragma unroll
    for (int dt = 0; dt < 4; ++dt) O[dt] = (f32x4){0.f, 0.f, 0.f, 0.f};
    h16x8 Qf[2]; int tq, h; float scale;
    if (u < 4096) {
        const int r = u & 15; h = (u >> 4) & 3; const int b = u >> 6; const int tq0 = 256 * b + r; tq = tq0 + 16 * i;
        const h16* qp = P + (size_t)tq * INW + PC_Q + h * 64 + 8 * g; Qf[0] = *(const h16x8*)qp * (h16)0.125f; Qf[1] = *(const h16x8*)(qp + 32) * (h16)0.125f;
        const h16* Kp = P + PC_K + h * 64; const h16* Vp = P + PC_V + h * 64;
        att_seg<128>(Kp, Vp, tq0 - 64 * 16, 16, 5, i, Qf, m, l, O, vlds, lane);
        att_seg<128>(Kp, Vp, tq0 - 64 * 4, 4, 6, 4 * i, Qf, m, l, O, vlds, lane);
        att_seg<128>(Kp, Vp, tq0 - 64, 1, 12, 16 * i, Qf, m, l, O, vlds, lane);
        l += __shfl_xor(l, 16); l += __shfl_xor(l, 32);
        scale = 1.0f / l;
    } else {
        const int v = u - 4096; h = v >> 10; const int tq0 = (v & 1023) * 16; tq = tq0 + i;
        const h16* qp = P + (size_t)tq * INW + PD_Q + h * 64 + 8 * g; Qf[0] = *(const h16x8*)qp * (h16)0.125f; Qf[1] = *(const h16x8*)(qp + 32) * (h16)0.125f;
        const h16* Kp = P + PD_K + (h >> 1) * 64; const h16* Vp = P + PD_V + (h >> 1) * 64;
        att_seg<256>(Kp, Vp, tq0 - 128, 1, 9, i, Qf, m, l, O, vlds, lane);
        l += __shfl_xor(l, 16); l += __shfl_xor(l, 32);
        const float sk = F.pp->sink[layer * 4 + h]; const float mt = fmaxf(m, sk), w = __expf(m - mt), den = l * w + __expf(sk - mt);
        scale = w / den;
    }
    h16* yo = Y + (size_t)tq * D + (u < 4096 ? 512 : 768) + h * 64 + 4 * g;
#pragma unroll
    for (int dt = 0; dt < 4; ++dt) { u32x2 w2; w2.x = pk2(O[dt][0] * scale, O[dt][1] * scale); w2.y = pk2(O[dt][2] * scale, O[dt][3] * scale); *(u32x2*)(yo + 16 * dt) = w2; }
}
__device__ __forceinline__ void step_mix(Frame& F, int layer) {
    constexpr int N_CONV = M / 32;
    hg_pass1(F, layer);
    for (int it = F.bid; it < N_CONV; it += F.G) conv_item(F, it, layer);
#if ATT_NAIVE
    for (int it = F.bid; it < 256; it += F.G) attn_naive_item(F, it & 127, layer, it >> 7);
#else
    { const int gw = F.bid * NWAVES + F.wave, NGW = F.G * NWAVES;
#pragma unroll 1
      for (int u = gw; u < 4096; u += NGW) att_unit(F, u, layer); }
#endif
}
__device__ __forceinline__ void step_afin(Frame& F, int layer) {
    const float* OA = WSP(float, SCR_OA); const h16* P = WSP(h16, OFF_PROJ); h16* Y = WSP(h16, OFF_Y);
    const int gw = F.bid * NWAVES + F.wave, NGW = F.G * NWAVES;
    const f32x4 nw = *(const f32x4*)(F.pp->anw + layer * 64 + (F.lane & 15) * 4);
    for (int r0 = gw * 4; r0 < M; r0 += NGW * 4) {
        f32x4 of[4], ob[4]; h16x4 gg[4];
#pragma unroll
        for (int u = 0; u < 4; ++u) { const size_t t = (size_t)(r0 + u); of[u] = *(const f32x4*)(OA + t * 256 + F.lane * 4); ob[u] = *(const f32x4*)(OA + (size_t)M * 256 + t * 256 + F.lane * 4); gg[u] = *(const h16x4*)(P + t * INW + PA_G + F.lane * 4); }
#pragma unroll
        for (int u = 0; u < 4; ++u) { const f32x4 o = of[u] + ob[u]; float ss = (o.x * o.x + o.y * o.y) + (o.z * o.z + o.w * o.w);
            ss += __shfl_xor(ss, 1); ss += __shfl_xor(ss, 2); ss += __shfl_xor(ss, 4); ss += __shfl_xor(ss, 8);
            const float rs = 1.0f / sqrtf(ss * (1.f / 64.f) + RMS_EPS);
            u32x2 w2; w2.x = pk2(o.x * rs * nw.x * siluf_((float)gg[u][0]), o.y * rs * nw.y * siluf_((float)gg[u][1])); w2.y = pk2(o.z * rs * nw.z * siluf_((float)gg[u][2]), o.w * rs * nw.w * siluf_((float)gg[u][3]));
            *(u32x2*)(Y + (size_t)(r0 + u) * D + F.lane * 4) = w2; }
    }
}

struct LnArgs { const float* xin; const float* gate; const float* lw; const float* lb; const float* nscale; const float* nshift; float* xout; h16* hout; };
__device__ __forceinline__ void ln_core(const Frame& F, const LnArgs& a, int row, const f32x4 (&fv)[4], f32x4 (&hv)[4]) {
    f32x4 tv[4]; float s = 0.f;
#pragma unroll
    for (int j = 0; j < 4; ++j) { const int col = F.lane * 4 + 256 * j; const f32x4 xi = *(const f32x4*)(a.xin + (size_t)row * D + col), g = *(const f32x4*)(a.gate + col);
        tv[j] = xi * ALPHA + (g + 1.0f) * fv[j]; s += (tv[j].x + tv[j].y) + (tv[j].z + tv[j].w); }
    const float mean = wave_sum(s) * (1.f / D); float s2 = 0.f;
#pragma unroll
    for (int j = 0; j < 4; ++j) { tv[j] = tv[j] - mean; s2 += (tv[j].x * tv[j].x + tv[j].y * tv[j].y) + (tv[j].z * tv[j].z + tv[j].w * tv[j].w); }
    const float rstd = 1.0f / sqrtf(wave_sum(s2) * (1.f / D) + LN_EPS);
#pragma unroll
    for (int j = 0; j < 4; ++j) { const int col = F.lane * 4 + 256 * j; const f32x4 w = *(const f32x4*)(a.lw + col), b = *(const f32x4*)(a.lb + col);
        const f32x4 xo = tv[j] * rstd * w + b;
        *(f32x4*)(a.xout + (size_t)row * D + col) = xo;
        if (a.hout) { const f32x4 sc = *(const f32x4*)(a.nscale + col), sh = *(const f32x4*)(a.nshift + col); hv[j] = xo * (sc + 1.0f) + sh;
            u32x2 w2; w2.x = pk2(hv[j].x, hv[j].y); w2.y = pk2(hv[j].z, hv[j].w); *(u32x2*)(a.hout + (size_t)row * D + col) = w2; } }
}
__device__ __forceinline__ void step_ln_dense(Frame& F, const LnArgs& a, const float* Z, bool router) {
    const int gw = F.bid * NWAVES + F.wave, NGW = F.G * NWAVES;
    unsigned* cnt = (unsigned*)(F.ws + OFF_CTL) + CW_CNT; unsigned* tok = WSP(unsigned, OFF_TOK);
    unsigned* lcnt = (unsigned*)F.lds;
    if (router) { if (F.tid < 8) lcnt[F.tid] = 0u; __syncthreads(); }
    for (int row = gw; row < M; row += NGW) {
        f32x4 fv[4], hv[4];
#pragma unroll
        for (int j = 0; j < 4; ++j) fv[j] = *(const f32x4*)(Z + (size_t)row * D + F.lane * 4 + 256 * j);
        ln_core(F, a, row, fv, hv);
        if (router) {
            float lg[8];
#pragma unroll
            for (int e = 0; e < 8; ++e) lg[e] = 0.f;
#pragma unroll
            for (int j = 0; j < 4; ++j)
#pragma unroll
                for (int i = 0; i < 4; ++i) { const int col = F.lane * 4 + 256 * j + i; const f32x4 w0 = *(const f32x4*)(F.pp->rout + (size_t)col * 8), w1 = *(const f32x4*)(F.pp->rout + (size_t)col * 8 + 4); const float hval = hv[j][i];
                    lg[0] += hval * w0.x; lg[1] += hval * w0.y; lg[2] += hval * w0.z; lg[3] += hval * w0.w; lg[4] += hval * w1.x; lg[5] += hval * w1.y; lg[6] += hval * w1.z; lg[7] += hval * w1.w; }
#pragma unroll
            for (int e = 0; e < 8; ++e) lg[e] = wave_sum(lg[e]);
            int e1 = 0; float l1 = lg[0];
#pragma unroll
            for (int e = 1; e < 8; ++e) if (lg[e] > l1) { l1 = lg[e]; e1 = e; }
            int e2 = -1; float l2 = -3.0e38f;
#pragma unroll
            for (int e = 0; e < 8; ++e) if (e != e1 && lg[e] > l2) { l2 = lg[e]; e2 = e; }
            const float g1 = 1.0f / (1.0f + __expf(l2 - l1)), g2 = 1.0f - g1;
            if (F.lane == 0) { tok[row * 8 + 0] = (unsigned)e1; tok[row * 8 + 1] = (unsigned)e2; tok[row * 8 + 2] = __float_as_uint(g1); tok[row * 8 + 3] = __float_as_uint(g2);
                atomicAdd(lcnt + e1, 1u); atomicAdd(lcnt + e2, 1u); }
        }
    }
    if (router) { __syncthreads(); if (F.tid < 8) atomicAdd(cnt + F.tid, lcnt[F.tid]); }
}
__device__ __forceinline__ void step_slot(Frame& F) {
    const unsigned* cnt = (const unsigned*)(F.ws + OFF_CTL) + CW_CNT; unsigned* cur = (unsigned*)(F.ws + OFF_CTL) + CW_CUR; unsigned* tok = WSP(unsigned, OFF_TOK);
    const h16* H = WSP(h16, OFF_H); h16* HG = WSP(h16, OFF_PROJ);
    unsigned off[8]; { unsigned o = 0;
#pragma unroll
        for (int e = 0; e < 8; ++e) { off[e] = o; o += ((cnt[e] + 255u) >> 8) << 8; } }
    const int gw = F.bid * NWAVES + F.wave, NGW = F.G * NWAVES;
    unsigned* lw = (unsigned*)F.lds;
    if (F.tid < 16) lw[F.tid] = 0u;
    __syncthreads();
    for (int row = gw; row < M; row += NGW) if (F.lane == 0) { atomicAdd(lw + tok[row * 8 + 0], 1u); atomicAdd(lw + tok[row * 8 + 1], 1u); }
    __syncthreads();
    if (F.tid < 8) { unsigned o = 0;
#pragma unroll
        for (int e = 0; e < 8; ++e) o = ((unsigned)F.tid == (unsigned)e) ? off[e] : o;
        lw[8 + F.tid] = o + atomicAdd(cur + F.tid, lw[F.tid]); }
    __syncthreads();
    for (int row = gw; row < M; row += NGW) {
        const unsigned e1 = tok[row * 8 + 0], e2 = tok[row * 8 + 1];
        unsigned s1 = 0, s2 = 0;
        if (F.lane == 0) { s1 = atomicAdd(lw + 8 + e1, 1u); s2 = atomicAdd(lw + 8 + e2, 1u); tok[row * 8 + 4] = s1; tok[row * 8 + 5] = s2; }
        s1 = __shfl(s1, 0); s2 = __shfl(s2, 0);
        const u32x4 a = *(const u32x4*)(H + (size_t)row * D + F.lane * 8), b = *(const u32x4*)(H + (size_t)row * D + 512 + F.lane * 8);
        *(u32x4*)(HG + (size_t)s1 * D + F.lane * 8) = a; *(u32x4*)(HG + (size_t)s1 * D + 512 + F.lane * 8) = b;
        *(u32x4*)(HG + (size_t)s2 * D + F.lane * 8) = a; *(u32x4*)(HG + (size_t)s2 * D + 512 + F.lane * 8) = b;
    }
    __syncthreads();
}
__device__ __forceinline__ void step_ln_moe(Frame& F, const LnArgs& a) {
    const int gw = F.bid * NWAVES + F.wave, NGW = F.G * NWAVES;
    const unsigned* tok = WSP(unsigned, OFF_TOK); const float* YS = WSP(float, OFF_PROJ);
    for (int row = gw; row < M; row += NGW) {
        const float g1 = __uint_as_float(tok[row * 8 + 2]), g2 = __uint_as_float(tok[row * 8 + 3]); const unsigned s1 = tok[row * 8 + 4], s2 = tok[row * 8 + 5];
        f32x4 fv[4], hv[4];
#pragma unroll
        for (int j = 0; j < 4; ++j) { const int col = F.lane * 4 + 256 * j; fv[j] = *(const f32x4*)(YS + (size_t)s1 * D + col) * g1 + *(const f32x4*)(YS + (size_t)s2 * D + col) * g2; }
        ln_core(F, a, row, fv, hv);
    }
}

constexpr int N_STEPS = 25;
#ifndef KMASK
#define KMASK 0xFFFFF
#endif
#define KON(k) ((KMASK >> (k)) & 1)
__global__ void __launch_bounds__(NTHREADS, 2) fwd_kernel(Params kp) {
    extern __shared__ __attribute__((aligned(16))) unsigned char lds[];
    Frame F; F.lds = lds; F.tid = threadIdx.x; F.lane = F.tid & 63; F.wave = __builtin_amdgcn_readfirstlane(F.tid >> 6); F.G = gridDim.x; F.bid = blockIdx.x; F.ws = kp.ws;
    LAS unsigned char* ldsl = (LAS unsigned char*)lds;
    const int lo = kp.lo, hi = kp.hi; int rep1 = 0;
    if (threadIdx.x < 4) ((LAS unsigned*)(ldsl + LDS_BARST))[threadIdx.x] = 0u;
    __syncthreads();
    const XcdBarrier xbar = xcd_barrier_post((unsigned*)(kp.ws + OFF_CTL) + CW_BAR, (volatile LAS unsigned*)(ldsl + LDS_BARST));
    for (int s = lo; s < hi; ++s) {
        { const Params* pp_ = (const Params*)__builtin_amdgcn_kernarg_segment_ptr(); asm volatile("" : "+s"(pp_) :: "memory"); F.pp = pp_; unsigned char* ws_ = kp.ws; asm volatile("" : "+s"(ws_)); F.ws = ws_; }
        const Params& p = *F.pp;
        { int tid_ = threadIdx.x; asm volatile("" : "+v"(tid_)); F.tid = tid_; F.lane = tid_ & 63; F.wave = __builtin_amdgcn_readfirstlane(tid_ >> 6); }
        int layer = 0, kind = s;
        if (s >= 13) { layer = 1; kind = s - 11; }
        const float* mod = (const float*)(F.ws + OFF_CTL) + CW_MOD;
        const float* modl = mod + layer * 6144;
        if (KON(0) && s == 0) step_pre(F);
        else if (KON(1) && s == 1) { step_h0(F); if (PROBE_DUP & 32) step_h0(F); }
        else if (KON(2) && kind == 2) { g8::DenseOrder S; S.init(WSP(h16, OFF_H), WSP(h16, OFF_WT_IN) + (size_t)layer * INW * D, M, INW, D, F.G, F.bid); g8::EpiF16 E{WSP(h16, OFF_PROJ), INW}; g8::gemm_phase(ldsl, F.tid, D, S, E); }
        else if (KON(3) && kind == 3) step_rot(F, layer);
        else if (KON(4) && kind == 4) { step_mix(F, layer); if (PROBE_DUP & 4) { __syncthreads(); step_mix(F, layer); } }
        else if (KON(5) && kind == 5) { step_hg2(F, layer); if (PROBE_DUP & 4) step_hg2(F, layer); }
        else if (KON(6) && kind == 6) { step_hg3(F, layer); if (PROBE_DUP & 4) step_hg3(F, layer); }
        else if (KON(7) && kind == 7) { step_afin(F, layer); if (PROBE_DUP & 4) step_afin(F, layer); }
        else if (KON(8) && kind == 8) { g8::DenseOrder S; S.init(WSP(h16, OFF_Y), WSP(h16, OFF_WT_OUT) + (size_t)layer * D * D, M, D, D, F.G, F.bid); g8::EpiF32 E{WSP(float, OFF_Z), D}; g8::gemm_phase(ldsl, F.tid, D, S, E); }
        else if (KON(9) && kind == 9) { LnArgs a{layer == 0 ? p.x : WSP(float, OFF_X), modl + 2048, p.lnw + (size_t)(layer * 2) * D, p.lnb + (size_t)(layer * 2) * D, modl + 4096, modl + 3072, WSP(float, OFF_X), WSP(h16, OFF_H)};
            step_ln_dense(F, a, WSP(float, OFF_Z), layer == 1); if ((PROBE_DUP & 16) && layer == 0) step_ln_dense(F, a, WSP(float, OFF_Z), false); }
        else if (KON(10) && layer == 0 && kind == 10) { g8::DenseOrder S; S.init(WSP(h16, OFF_H), WSP(h16, OFF_WT_UP), M, 2 * FFN, D, F.G, F.bid); g8::EpiSwiGLU E{WSP(h16, OFF_PROJ), FFN}; g8::gemm_phase(ldsl, F.tid, D, S, E); }
        else if (KON(11) && layer == 0 && kind == 11) { g8::DenseOrder S; S.init(WSP(h16, OFF_PROJ), WSP(h16, OFF_WT_DOWN), M, D, FFN, F.G, F.bid); g8::EpiF32 E{WSP(float, OFF_Z), D}; g8::gemm_phase(ldsl, F.tid, FFN, S, E); }
        else if (KON(12) && layer == 0 && kind == 12) { LnArgs a{WSP(float, OFF_X), modl + 5120, p.lnw + (size_t)1 * D, p.lnb + (size_t)1 * D, mod + 6144 + 1024, mod + 6144 + 0, WSP(float, OFF_X), WSP(h16, OFF_H)};
            step_ln_dense(F, a, WSP(float, OFF_Z), false); }
        else if (KON(13) && layer == 1 && kind == 10) step_slot(F);
        else if (KON(14) && layer == 1 && kind == 11) { g8::MoeOrder S; S.init(WSP(h16, OFF_PROJ), WSP(h16, OFF_WT_MUP), (size_t)2 * EDIM * D * 2, 2 * EDIM, D, F.G, F.bid, (const unsigned*)(F.ws + OFF_CTL) + CW_CNT);
            g8::EpiSwiGLU E{WSP(h16, OFF_BIG), EDIM}; g8::gemm_phase(ldsl, F.tid, D, S, E); }
        else if (KON(15) && layer == 1 && kind == 12) { g8::MoeOrder S; S.init(WSP(h16, OFF_BIG), WSP(h16, OFF_WT_MDOWN), (size_t)D * EDIM * 2, D, EDIM, F.G, F.bid, (const unsigned*)(F.ws + OFF_CTL) + CW_CNT);
            g8::EpiF32 E{WSP(float, OFF_PROJ), D}; g8::gemm_phase(ldsl, F.tid, EDIM, S, E); }
        else if (KON(16) && layer == 1 && kind == 13) { LnArgs a{WSP(float, OFF_X), modl + 5120, p.lnw + (size_t)3 * D, p.lnb + (size_t)3 * D, nullptr, nullptr, p.out, nullptr}; step_ln_moe(F, a); }
        if (s + 1 < hi) { if (s == lo) cg::this_grid().sync(); else xcd_barrier(xbar); if (PROBE_DUP & 2) xcd_barrier(xbar); }
        if (PROBE_DUP & 1) { const bool isg = (kind == 2 || kind == 8 || (layer == 0 && (kind == 10 || kind == 11)) || (layer == 1 && (kind == 11 || kind == 12))) && s >= 2; if (isg && rep1 == 0) { rep1 = 1; --s; } else rep1 = 0; }
    }
}

extern "C" void kernel_launch(void* const* d_in, const int* in_sizes, int n_in, void* d_out, int out_size, void* d_ws, size_t ws_size, hipStream_t stream) {
    static int grid = 0;
    if (grid == 0) {
        if (n_in != 21 || in_sizes[0] != M * D || out_size != M * D || ws_size < OFF_END) { fprintf(stderr, "kernel_launch: unexpected shapes / workspace (%d inputs, ws %zu, need %zu)\n", n_in, ws_size, (size_t)OFF_END); grid = -1; return; }
        int dev = 0, cus = 0, per_cu = 0;
        hipGetDevice(&dev); hipDeviceGetAttribute(&cus, hipDeviceAttributeMultiprocessorCount, dev);
        hipFuncSetAttribute((const void*)fwd_kernel, hipFuncAttributeMaxDynamicSharedMemorySize, LDS_BYTES);
        hipOccupancyMaxActiveBlocksPerMultiprocessor(&per_cu, (const void*)fwd_kernel, NTHREADS, LDS_BYTES);
        if (per_cu < 1) { fprintf(stderr, "kernel_launch: occupancy query says %d blocks per CU\n", per_cu); per_cu = 1; }
        grid = cus * 1;
        fprintf(stderr, "kernel_launch: grid %d (cus %d, per_cu %d), ws %zu\n", grid, cus, per_cu, ws_size);
    }
    if (grid < 0) return;
    hipMemsetAsync((char*)d_ws + OFF_CTL, 0, CTL_BYTES, stream);
    Params p{};
    p.x = (const float*)d_in[0]; p.c = (const float*)d_in[1]; p.pos = (const int*)d_in[2]; p.w_ada = (const float*)d_in[3]; p.b_ada = (const float*)d_in[4];
    p.w_in = (const float*)d_in[5]; p.w_out = (const float*)d_in[6]; p.alb = (const float*)d_in[7]; p.anw = (const float*)d_in[8]; p.cw = (const float*)d_in[9];
    p.cb = (const float*)d_in[10]; p.cnw = (const float*)d_in[11]; p.cnb = (const float*)d_in[12]; p.sink = (const float*)d_in[13]; p.lnw = (const float*)d_in[14];
    p.lnb = (const float*)d_in[15]; p.fup = (const float*)d_in[16]; p.fdown = (const float*)d_in[17]; p.rout = (const float*)d_in[18]; p.mup = (const float*)d_in[19];
    p.mdown = (const float*)d_in[20]; p.out = (float*)d_out; p.ws = (unsigned char*)d_ws;
#if MK_ONE_LAUNCH
    p.lo = 0; p.hi = N_STEPS;
    { void* args[] = {&p}; hipError_t e = hipLaunchCooperativeKernel((const void*)fwd_kernel, dim3(grid), dim3(NTHREADS), args, LDS_BYTES, stream);
      if (e != hipSuccess) fprintf(stderr, "cooperative launch failed: %s\n", hipGetErrorString(e)); }
#else
    for (int s = 0; s < N_STEPS; ++s) { p.lo = s; p.hi = s + 1;
        void* args[] = {&p}; hipError_t e = hipLaunchCooperativeKernel((const void*)fwd_kernel, dim3(grid), dim3(NTHREADS), args, LDS_BYTES, stream);
        if (e != hipSuccess) { fprintf(stderr, "launch %d failed: %s\n", s, hipGetErrorString(e)); break; } }
#endif
}
```
